# Optimizing an MI355X kernel written in HIP

```python
import math
import jax, jax.numpy as jnp
from jax import lax
import numpy as np


D_MODEL = 2048
BATCH = 8
SEQ = 2048
DEPTH = 2

GRID_W = 64
CTX_LEN = 256
HEAD_DIM = 128
D_CONV = 1536
D_SSM = 512
CONV_HEADS = D_CONV // HEAD_DIM
SSM_HEADS = D_SSM // HEAD_DIM
CONV_W = 3
SSM_GROUP = 16
N_SSM_GROUPS = D_SSM // SSM_GROUP
SSM_STATE = 64
D_IN_PROJ = 3 * D_CONV + D_SSM
N_EXPERTS = 16
D_EXPERT = 2048
EC_FACTOR = 2
N_MOD = 6
EPS = 1e-6
DT_MIN = 0.001
DT_MAX = 0.1

kernel_name = 'hybrid_conv_s5_ec_moe_diffusion_trunk'


def rmsnorm(x, g):
    xf = x.astype(jnp.float32)
    y = xf * lax.rsqrt(jnp.mean(xf * xf, axis=-1, keepdims=True) + EPS)
    return (y * g.astype(jnp.float32)).astype(x.dtype)


def head_rmsnorm(y, g, n_heads):
    shp = y.shape
    yf = y.astype(jnp.float32).reshape(shp[:-1] + (n_heads, shp[-1] // n_heads))
    yf = yf * lax.rsqrt(jnp.mean(yf * yf, axis=-1, keepdims=True) + EPS)
    return (yf.reshape(shp) * g.astype(jnp.float32)).astype(y.dtype)


def modulate(h, shift, scale):
    return h * (1.0 + scale) + shift


def centred_conv3(v, w, axis):
    n = v.shape[axis]
    pad = [(0, 0)] * v.ndim
    pad[axis] = (1, 1)
    vp = jnp.pad(v, pad)
    out = w[0] * lax.slice_in_dim(vp, 0, n, axis=axis)
    for k in range(1, CONV_W):
        out = out + w[k] * lax.slice_in_dim(vp, k, k + n, axis=axis)
    return out


def conv_mixer(p, w_conv, on_grid):
    b_g, c_g, v = jnp.split(p, 3, axis=-1)
    z = c_g * v
    if on_grid:
        bsz, n, ch = z.shape
        rows = n // GRID_W
        z = centred_conv3(z.reshape(bsz, rows, GRID_W, ch), w_conv, axis=2).reshape(bsz, n, ch)
    else:
        z = centred_conv3(z, w_conv, axis=1)
    return b_g * z


def _complex_affine_combine(e1, e2):
    ar1, ai1, br1, bi1 = e1
    ar2, ai2, br2, bi2 = e2
    return (ar2 * ar1 - ai2 * ai1,
            ar2 * ai1 + ai2 * ar1,
            ar2 * br1 - ai2 * bi1 + br2,
            ar2 * bi1 + ai2 * br1 + bi2)


def s5_discretise(lam_re, lam_im, log_dt, b_re, b_im):
    lr = lam_re.astype(jnp.float32)
    li = lam_im.astype(jnp.float32)
    dt = jnp.exp(log_dt.astype(jnp.float32))[:, None]
    mag = jnp.exp(lr * dt)
    ar = mag * jnp.cos(li * dt)
    ai = mag * jnp.sin(li * dt)
    den = lr * lr + li * li
    nr = ar - 1.0
    kr = (nr * lr + ai * li) / den
    ki = (ai * lr - nr * li) / den
    br = b_re.astype(jnp.float32)
    bi = b_im.astype(jnp.float32)
    bbr = kr[..., None] * br - ki[..., None] * bi
    bbi = kr[..., None] * bi + ki[..., None] * br
    return dt, lr, li, ar, ai, bbr, bbi


def s5_scan(u, disc, h0, reverse):
    dt, lr, li, ar, ai, bbr, bbi = disc
    if reverse:
        u = jnp.flip(u, axis=1)
    n = u.shape[1]
    bu_re = jnp.einsum('blgh,gph->lbgp', u, bbr)
    bu_im = jnp.einsum('blgh,gph->lbgp', u, bbi)
    a_shape = (n, 1) + ar.shape
    a_re = jnp.broadcast_to(ar, a_shape)
    a_im = jnp.broadcast_to(ai, a_shape)
    _, _, h_re, h_im = lax.associative_scan(_complex_affine_combine, (a_re, a_im, bu_re, bu_im), axis=0)
    if h0 is not None:
        h0r, h0i = h0
        t = jnp.arange(1, n + 1, dtype=jnp.float32)[:, None, None, None]
        pm = jnp.exp(t * dt * lr)
        pr = pm * jnp.cos(t * dt * li)
        pi = pm * jnp.sin(t * dt * li)
        h_re = h_re + pr * h0r[None] - pi * h0i[None]
        h_im = h_im + pr * h0i[None] + pi * h0r[None]
    return (h_re, h_im), (h_re[-1], h_im[-1])


def s5_readout(h, c_re, c_im, reverse):
    h_re, h_im = h
    y = (jnp.einsum('lbgp,ghp->blgh', h_re, c_re.astype(jnp.float32))
         - jnp.einsum('lbgp,ghp->blgh', h_im, c_im.astype(jnp.float32)))
    if reverse:
        y = jnp.flip(y, axis=1)
    return y


def s5_mixer(u_ctx, u_lat, lam_re, lam_im, log_dt, b_re, b_im, c_re, c_im, d_skip, w_glu, ctx_out):
    dtype = u_lat.dtype

    def groups(u):
        return u.astype(jnp.float32).reshape(u.shape[0], u.shape[1], N_SSM_GROUPS, SSM_GROUP)

    uc = groups(u_ctx)
    ul = groups(u_lat)
    d = d_skip.astype(jnp.float32).reshape(N_SSM_GROUPS, SSM_GROUP)
    y_lat = d * ul
    y_ctx = d * uc if ctx_out else None
    for direction in range(2):
        rev = direction == 1
        disc = s5_discretise(lam_re[direction], lam_im[direction], log_dt[direction],
                             b_re[direction], b_im[direction])
        h_c, fin_c = s5_scan(uc, disc, None, rev)
        h_l, _ = s5_scan(ul, disc, fin_c, rev)
        y_lat = y_lat + s5_readout(h_l, c_re[direction], c_im[direction], rev)
        if ctx_out:
            y_ctx = y_ctx + s5_readout(h_c, c_re[direction], c_im[direction], rev)

    def glu(y):
        y = jax.nn.gelu(y.reshape(y.shape[0], y.shape[1], D_SSM))
        return (y * jax.nn.sigmoid(y @ w_glu.astype(jnp.float32))).astype(dtype)

    return glu(y_lat), (glu(y_ctx) if ctx_out else None)


def ec_moe(h, router_w, w_gate, w_up, w_down):
    bsz, n, dm = h.shape
    cap = EC_FACTOR * n // N_EXPERTS
    logits = jnp.einsum('bnd,de->bne', h, router_w).astype(jnp.float32)
    aff = jnp.swapaxes(jax.nn.softmax(logits, axis=-1), 1, 2)
    vals, idx = lax.top_k(aff, cap)
    xs = jax.vmap(lambda hb, ib: hb[ib])(h, idx)
    g = jnp.einsum('becd,edf->becf', xs, w_gate)
    u = jnp.einsum('becd,edf->becf', xs, w_up)
    y = jnp.einsum('becf,efd->becd', jax.nn.silu(g) * u, w_down)
    y = y * vals[..., None].astype(y.dtype)
    return jax.vmap(lambda yb, ib: jnp.zeros((n, dm), yb.dtype).at[ib.reshape(-1)].add(yb.reshape(-1, dm)))(y, idx)


def setup_inputs(seed: int = 0) -> dict:
    key = jax.random.key(seed)
    ks = jax.random.split(key, 32)
    f32 = jnp.float32

    def nrm(k, shape, scale):
        return jax.random.normal(k, shape, f32) * scale

    G, P, H = N_SSM_GROUPS, SSM_STATE, SSM_GROUP
    lam_im_base = jnp.pi * jnp.arange(P, dtype=f32)
    return {
        'x': nrm(ks[0], (BATCH, SEQ, D_MODEL), 1.0),
        'c': nrm(ks[1], (BATCH, D_MODEL), 1.0),
        'ctx': nrm(ks[2], (BATCH, CTX_LEN, D_MODEL), 1.0),
        'c_ctx': nrm(ks[3], (D_MODEL,), 1.0),
        'ada_w': nrm(ks[4], (DEPTH, D_MODEL, N_MOD * D_MODEL), 0.5 * D_MODEL ** -0.5),
        'ada_b': nrm(ks[5], (DEPTH, N_MOD * D_MODEL), 0.02),
        'norm1_g': 1.0 + nrm(ks[6], (DEPTH, D_MODEL), 0.02),
        'w_in': nrm(ks[7], (DEPTH, D_MODEL, D_IN_PROJ), D_MODEL ** -0.5),
        'conv_w': nrm(ks[8], (DEPTH, CONV_W, D_CONV), CONV_W ** -0.5),
        'ssm_lam_re': -0.5 + nrm(ks[9], (DEPTH, 2, G, P), 0.01),
        'ssm_lam_im': lam_im_base + nrm(ks[10], (DEPTH, 2, G, P), 0.01),
        'ssm_log_dt': jax.random.uniform(ks[11], (DEPTH, 2, G), f32, math.log(DT_MIN), math.log(DT_MAX)),
        'ssm_b_re': nrm(ks[12], (DEPTH, 2, G, P, H), (2.0 * H) ** -0.5),
        'ssm_b_im': nrm(ks[13], (DEPTH, 2, G, P, H), (2.0 * H) ** -0.5),
        'ssm_c_re': nrm(ks[14], (DEPTH, 2, G, H, P), (2.0 * P) ** -0.5),
        'ssm_c_im': nrm(ks[15], (DEPTH, 2, G, H, P), (2.0 * P) ** -0.5),
        'ssm_d': nrm(ks[16], (DEPTH, D_SSM), 1.0),
        'ssm_w_glu': nrm(ks[17], (DEPTH, D_SSM, D_SSM), D_SSM ** -0.5),
        'out_norm_conv_g': 1.0 + nrm(ks[18], (DEPTH, D_CONV), 0.02),
        'out_norm_ssm_g': 1.0 + nrm(ks[19], (DEPTH, D_SSM), 0.02),
        'w_out': nrm(ks[20], (DEPTH, D_CONV + D_SSM, D_MODEL), (D_CONV + D_SSM) ** -0.5),
        'norm2_g': 1.0 + nrm(ks[21], (DEPTH, D_MODEL), 0.02),
        'router_w': nrm(ks[22], (DEPTH, D_MODEL, N_EXPERTS), D_MODEL ** -0.5),
        'exp_w_gate': nrm(ks[23], (DEPTH, N_EXPERTS, D_MODEL, D_EXPERT), D_MODEL ** -0.5),
        'exp_w_up': nrm(ks[24], (DEPTH, N_EXPERTS, D_MODEL, D_EXPERT), D_MODEL ** -0.5),
        'exp_w_down': nrm(ks[25], (DEPTH, N_EXPERTS, D_EXPERT, D_MODEL), D_EXPERT ** -0.5),
        'final_norm_g': 1.0 + nrm(ks[26], (D_MODEL,), 0.02),
    }


def reference(x, c, ctx, c_ctx, ada_w, ada_b, norm1_g, w_in, conv_w, ssm_lam_re, ssm_lam_im,
              ssm_log_dt, ssm_b_re, ssm_b_im, ssm_c_re, ssm_c_im, ssm_d, ssm_w_glu,
              out_norm_conv_g, out_norm_ssm_g, w_out, norm2_g, router_w, exp_w_gate, exp_w_up,
              exp_w_down, final_norm_g):
    xl = x
    xc = ctx
    sc = jax.nn.silu(c)
    scc = jax.nn.silu(c_ctx)
    for l in range(DEPTH):
        last = l == DEPTH - 1
        mod_l = (sc @ ada_w[l] + ada_b[l])[:, None, :]
        mod_c = scc @ ada_w[l] + ada_b[l]
        sh1, sc1, g1, sh2, sc2, g2 = jnp.split(mod_l, N_MOD, axis=-1)
        csh1, csc1, cg1, csh2, csc2, cg2 = jnp.split(mod_c, N_MOD, axis=-1)

        h = modulate(rmsnorm(xl, norm1_g[l]), sh1, sc1)
        hc = modulate(rmsnorm(xc, norm1_g[l]), csh1, csc1)
        proj = h @ w_in[l]
        if last:
            u_ctx = hc @ w_in[l][:, 3 * D_CONV:]
        else:
            proj_c = hc @ w_in[l]
            u_ctx = proj_c[..., 3 * D_CONV:]
        conv_l = conv_mixer(proj[..., :3 * D_CONV], conv_w[l], on_grid=True)
        ssm_l, ssm_c = s5_mixer(u_ctx, proj[..., 3 * D_CONV:], ssm_lam_re[l], ssm_lam_im[l], ssm_log_dt[l],
                                ssm_b_re[l], ssm_b_im[l], ssm_c_re[l], ssm_c_im[l], ssm_d[l], ssm_w_glu[l],
                                ctx_out=not last)
        mix_l = jnp.concatenate([head_rmsnorm(conv_l, out_norm_conv_g[l], CONV_HEADS),
                                 head_rmsnorm(ssm_l, out_norm_ssm_g[l], SSM_HEADS)], axis=-1) @ w_out[l]
        xl = xl + g1 * mix_l
        h2 = modulate(rmsnorm(xl, norm2_g[l]), sh2, sc2)
        xl = xl + g2 * ec_moe(h2, router_w[l], exp_w_gate[l], exp_w_up[l], exp_w_down[l])

        if not last:
            conv_c = conv_mixer(proj_c[..., :3 * D_CONV], conv_w[l], on_grid=False)
            mix_c = jnp.concatenate([head_rmsnorm(conv_c, out_norm_conv_g[l], CONV_HEADS),
                                     head_rmsnorm(ssm_c, out_norm_ssm_g[l], SSM_HEADS)], axis=-1) @ w_out[l]
            xc = xc + cg1 * mix_c
            hc2 = modulate(rmsnorm(xc, norm2_g[l]), csh2, csc2)
            xc = xc + cg2 * ec_moe(hc2, router_w[l], exp_w_gate[l], exp_w_up[l], exp_w_down[l])
    return rmsnorm(xl, final_norm_g)
```

```cpp
#include <hip/hip_runtime.h>
#include <cstdio>
#include <cstdint>
#include <utility>

#define GAS __attribute__((address_space(1)))
#define LAS __attribute__((address_space(3)))
typedef unsigned short bf16;
typedef unsigned v4u __attribute__((ext_vector_type(4)));
typedef unsigned v2u __attribute__((ext_vector_type(2)));
typedef float f32x4 __attribute__((ext_vector_type(4)));
typedef float f32x2 __attribute__((ext_vector_type(2)));
typedef short bf16x8 __attribute__((ext_vector_type(8)));
typedef GAS unsigned gu32;

#ifndef MK_N_LAUNCHES
#define MK_N_LAUNCHES 1
#endif

constexpr int NB = 8, SEQL = 2048, CTXL = 256, DM = 2048;
constexpr int ML = NB * SEQL, MC = NB * CTXL, MT = ML + MC;
constexpr int DCONV = 1536, DSSM = 512, DINP = 3 * DCONV + DSSM;
constexpr int NG = 32, SG = 16, SP = 64, TCH = 64;
constexpr int NE = 16, DF = 2048, CAPL = 256, CAPC = 32;
constexpr int NINST = 512, KS2 = 1280;
constexpr int YROWS = NE * NB * CAPL + NE * NB * CAPC;
constexpr float EPS = 1e-6f;

constexpr size_t MiB = 1u << 20;
constexpr size_t WS_CTL = 0, CTL_ZERO_BYTES = 1 * MiB;
constexpr size_t WS_MOD = 1 * MiB;
constexpr size_t WS_RWT = 2 * MiB;
constexpr size_t WS_LT = 2 * MiB + 512 * 1024;
constexpr size_t WS_AFF = 3 * MiB;
constexpr size_t WS_AFFC = 4 * MiB;
constexpr size_t WS_IDX = 5 * MiB;
constexpr size_t WS_VALS = 5 * MiB + 256 * 1024;
constexpr size_t WS_SEL = 6 * MiB;
constexpr size_t WS_WGLU = 8 * MiB;
constexpr size_t WS_WOUT = 9 * MiB;
constexpr size_t WS_WIN = 25 * MiB;
constexpr size_t WS_WF = 65 * MiB;
constexpr size_t WS_W2 = 97 * MiB;
constexpr size_t WS_WGU = 257 * MiB;
constexpr size_t WS_WDN = 769 * MiB;
constexpr size_t WS_XL = 1025 * MiB;
constexpr size_t WS_XM = 1169 * MiB;
constexpr size_t WS_H = 1313 * MiB;
constexpr size_t WS_F = 1385 * MiB;
constexpr size_t WS_R1 = 1401 * MiB;
constexpr size_t WS_R2 = 1563 * MiB;
constexpr size_t WS_U2 = WS_R2 + 72 * MiB;
constexpr size_t WS_Z = WS_R2 + 112 * MiB;
constexpr size_t WS_END = 1707 * MiB;
constexpr int CW_BAR = 4096;

constexpr int RING_BYTES = 131072;
constexpr int LDSCTL_OFF = RING_BYTES, MISC_OFF = LDSCTL_OFF + 320;
constexpr int LDS_BYTES = 147456;
constexpr int NWAVES = 8;

#define LDS_WAIT() asm volatile("s_waitcnt lgkmcnt(0)" ::: "memory")
#define VM_WAIT() asm volatile("s_waitcnt vmcnt(0)" ::: "memory")
__device__ __forceinline__ unsigned f2bf(float f) { unsigned u = __builtin_bit_cast(unsigned, f); return (u + 0x7fffu + ((u >> 16) & 1u)) >> 16; }
__device__ __forceinline__ unsigned pk2(float lo, float hi) { return f2bf(lo) | (f2bf(hi) << 16); }
__device__ __forceinline__ float bflo(unsigned w) { return __builtin_bit_cast(float, w << 16); }
__device__ __forceinline__ float bfhi(unsigned w) { return __builtin_bit_cast(float, w & 0xffff0000u); }
__device__ __forceinline__ float wave_sum(float v) {
#pragma unroll
    for (int o = 1; o < 64; o <<= 1) v += __shfl_xor(v, o);
    return v;
}
__device__ __forceinline__ float sigmoidf_(float x) { return 1.0f / (1.0f + __expf(-x)); }
__device__ __forceinline__ float gelu_tanh(float y) { const float a = 1.5957691216f * (y + 0.044715f * y * y * y); return y * sigmoidf_(a); }

namespace pg8 {
constexpr int BM = 256, BK = 64, HALF = 128, HTB = HALF * BK * 2, STAGE_BYTES = 8 * HTB;
__host__ __device__ __forceinline__ int lds_byte(int r, int c) { const int st = (r >> 4) * 2 + (c >> 5), rr = r & 15, cc = c & 31, ob = rr * 64 + cc * 2; return st * 1024 + (ob ^ (((ob >> 9) & 1) << 5)); }
__host__ __device__ __forceinline__ void stage_rc(int b, int& R, int& C) { const int st = b / 1024, sb = b % 1024, swz = sb ^ (((sb >> 9) & 1) << 5); R = (st >> 1) * 16 + swz / 64; C = (st & 1) * 32 + (swz % 64) / 2; }
__host__ __device__ __forceinline__ int perm32(int rho) { const int n = rho >> 4, i = rho & 15; return 8 * (i >> 2) + 4 * n + (i & 3); }
__device__ __forceinline__ unsigned cvt_pk_bf16(float lo, float hi) { unsigned r; asm volatile("v_cvt_pk_bf16_f32 %0, %1, %2" : "=v"(r) : "v"(lo), "v"(hi)); return r; }

struct Unit { const char* a; const char* b; int pm, pn, aux; };
struct Dims { int lda, ldb, K; };

template <class Epi, class Sched, bool ALIGN_EPI>
__device__ __forceinline__ void gemm_phase(LAS unsigned char* lds, const int tid, const Dims g, const Sched& S, const Epi& E) {
    const int wid = __builtin_amdgcn_readfirstlane(tid >> 6), lane = tid & 63, wr = wid >> 2, wc = wid & 3, fr = lane & 15, fq = lane >> 4;
    const int K = g.K, nt = K / BK;
    unsigned voffA[2], voffB[2];
#pragma unroll
    for (int i = 0; i < 2; ++i) { int R, C; stage_rc(tid * 16 + i * 8192, R, C); const int Rb = Epi::PERM ? ((R & ~31) + perm32(R & 31)) : R;
        voffA[i] = (unsigned)(R * g.lda + C) * 2u; voffB[i] = (unsigned)(Rb * g.ldb + C) * 2u; }
    const size_t kstep = (size_t)(BK * 2);
    const size_t hstepA = (size_t)HALF * g.lda * 2, hstepB = (size_t)HALF * g.ldb * 2;
    const unsigned ldsw = (unsigned)wid * 1024u;
    const int aoff = lds_byte(wr * 64 + fr, fq * 8), boff = lds_byte(wc * 32 + fr, fq * 8);
#define PG8_SA(b, h) (((b) * 2 + (h)) * HTB)
#define PG8_SB(b, h) ((4 + (b) * 2 + (h)) * HTB)
#define PG8_STAGE(bufoff, gbase, voff) do { _Pragma("unroll") for (int _i = 0; _i < 2; ++_i) \
        __builtin_amdgcn_global_load_lds((const unsigned*)((const char*)(gbase) + (voff)[_i]), (LAS unsigned*)(lds + (bufoff) + ldsw + _i * 8192), 16, 0, 0); } while (0)
#define PG8_LDA(dst, b, h) do { _Pragma("unroll") for (int m = 0; m < 4; ++m) _Pragma("unroll") for (int k = 0; k < 2; ++k) dst[m][k] = *(const LAS bf16x8*)(lds + PG8_SA(b, h) + aoff + m * 2048 + k * 1024); } while (0)
#define PG8_LDB(dst, b, h) do { _Pragma("unroll") for (int n = 0; n < 2; ++n) _Pragma("unroll") for (int k = 0; k < 2; ++k) dst[n][k] = *(const LAS bf16x8*)(lds + PG8_SB(b, h) + boff + n * 2048 + k * 1024); } while (0)
#define PG8_MMA(ai, bj, At, Bt) do { __builtin_amdgcn_s_setprio(1); _Pragma("unroll") for (int m = 0; m < 4; ++m) _Pragma("unroll") for (int n = 0; n < 2; ++n) _Pragma("unroll") for (int k = 0; k < 2; ++k) \
        acc[ai][bj][m][n] = __builtin_amdgcn_mfma_f32_16x16x32_bf16(Bt[n][k], At[m][k], acc[ai][bj][m][n], 0, 0, 0); __builtin_amdgcn_s_setprio(0); } while (0)
#define PG8_WAIT_V(n) asm volatile("s_waitcnt vmcnt(" #n ")" ::: "memory")
#define PG8_WAIT_L(n) asm volatile("s_waitcnt lgkmcnt(" #n ")" ::: "memory")
#define PG8_BAR __builtin_amdgcn_s_barrier()
#define PG8_SCHED __builtin_amdgcn_sched_barrier(0)
    Unit cur, nxt; int ui = 0;
    if (!S.next(0, cur)) return;
    f32x4 acc[2][2][4][2];
#pragma unroll
    for (int a = 0; a < 2; ++a)
#pragma unroll
        for (int b = 0; b < 2; ++b)
#pragma unroll
            for (int m = 0; m < 4; ++m)
#pragma unroll
                for (int n = 0; n < 2; ++n) acc[a][b][m][n] = (f32x4){0.f, 0.f, 0.f, 0.f};
    bf16x8 At[4][2], B0[2][2], B1[2][2];
    const char* cA = cur.a; const char* cB = cur.b;
    PG8_STAGE(PG8_SB(0, 0), cB, voffB); PG8_STAGE(PG8_SB(0, 1), cB + hstepB, voffB); PG8_STAGE(PG8_SA(0, 0), cA, voffA); PG8_STAGE(PG8_SA(0, 1), cA + hstepA, voffA);
    if (wr == 1) PG8_BAR;
    PG8_WAIT_V(2); PG8_BAR;
    PG8_STAGE(PG8_SB(1, 0), cB + kstep, voffB); PG8_STAGE(PG8_SA(1, 0), cA + kstep, voffA); PG8_STAGE(PG8_SB(1, 1), cB + hstepB + kstep, voffB);
    PG8_WAIT_V(6); PG8_BAR;
    for (;;) {
        const bool has_next = S.next(ui + 1, nxt);
        const char* nA = has_next ? nxt.a : cA; const char* nB = has_next ? nxt.b : cB;
        for (int t = 0; t < nt; t += 2) {
            const bool last = (t == nt - 2);
            const char* a1 = cA + (size_t)(t + 1) * kstep;
            const char* a2 = last ? nA : cA + (size_t)(t + 2) * kstep; const char* b2 = last ? nB : cB + (size_t)(t + 2) * kstep;
            const char* a3 = a2 + kstep; const char* b3 = b2 + kstep;
            PG8_LDB(B0, 0, 0); PG8_LDB(B1, 0, 1); PG8_SCHED; PG8_LDA(At, 0, 0); PG8_STAGE(PG8_SA(1, 1), a1 + hstepA, voffA);
            PG8_WAIT_V(8); PG8_WAIT_L(0); PG8_BAR; PG8_MMA(0, 0, At, B0); PG8_MMA(0, 1, At, B1); PG8_BAR; PG8_SCHED;
            PG8_LDA(At, 0, 1); PG8_STAGE(PG8_SB(0, 0), b2, voffB); PG8_STAGE(PG8_SB(0, 1), b2 + hstepB, voffB); PG8_STAGE(PG8_SA(0, 0), a2, voffA);
            PG8_WAIT_V(8); PG8_WAIT_L(0); PG8_BAR; PG8_MMA(1, 0, At, B0); PG8_MMA(1, 1, At, B1); PG8_BAR; PG8_SCHED;
            PG8_LDB(B0, 1, 0); PG8_LDB(B1, 1, 1); PG8_SCHED; PG8_LDA(At, 1, 0); PG8_STAGE(PG8_SA(0, 1), a2 + hstepA, voffA);
            PG8_WAIT_V(8); PG8_WAIT_L(0); PG8_BAR; PG8_MMA(0, 0, At, B0); PG8_MMA(0, 1, At, B1); PG8_BAR; PG8_SCHED;
            PG8_LDA(At, 1, 1); PG8_STAGE(PG8_SB(1, 0), b3, voffB); PG8_STAGE(PG8_SB(1, 1), b3 + hstepB, voffB); PG8_STAGE(PG8_SA(1, 0), a3, voffA);
            PG8_WAIT_V(8); PG8_WAIT_L(0); PG8_BAR; PG8_MMA(1, 0, At, B0); PG8_MMA(1, 1, At, B1); PG8_BAR; PG8_SCHED;
        }
        if constexpr (ALIGN_EPI) { if (wr == 0) PG8_BAR; }
        if constexpr (!Epi::AFTER_DRAIN) { E(acc, cur, wr, wc, fr, fq); }
        if (!has_next) break;
#pragma unroll
        for (int a = 0; a < 2; ++a)
#pragma unroll
            for (int b = 0; b < 2; ++b)
#pragma unroll
                for (int m = 0; m < 4; ++m)
#pragma unroll
                    for (int n = 0; n < 2; ++n) acc[a][b][m][n] = (f32x4){0.f, 0.f, 0.f, 0.f};
        cur = nxt; cA = nA; cB = nB; ++ui;
        if constexpr (ALIGN_EPI) { if (wr == 1) PG8_BAR; }
    }
    PG8_WAIT_V(0);
    if constexpr (!ALIGN_EPI) { if (wr == 0) PG8_BAR; }
    PG8_BAR;
    if constexpr (Epi::AFTER_DRAIN) { E.fused(acc, cur, wr, wc, fr, fq, lds, wid, lane); }
#undef PG8_SA
#undef PG8_SB
#undef PG8_STAGE
#undef PG8_LDA
#undef PG8_LDB
#undef PG8_MMA
#undef PG8_WAIT_V
#undef PG8_WAIT_L
#undef PG8_BAR
#undef PG8_SCHED
}
}

#define XB_TMO      128
#define XB_XCNT(j)  (256  + 64 * (j))
#define XB_XSUB(j)  (1280 + 64 * (j))
#define XB_XGEN(j)  (2304 + 64 * (j))
#define XB_TOP      3328
#define XB_TOPGEN   3392
#define XCD_BAR_WORDS 3456
#define XB_SPIN_CAP (1u << 18)

__device__ __forceinline__ unsigned xb_ld(unsigned* p)              { return __hip_atomic_load(p, __ATOMIC_RELAXED, __HIP_MEMORY_SCOPE_AGENT); }
__device__ __forceinline__ unsigned xb_add(unsigned* p, unsigned v) { return __hip_atomic_fetch_add(p, v, __ATOMIC_RELAXED, __HIP_MEMORY_SCOPE_AGENT); }
__device__ __forceinline__ unsigned xb_xcc_id() { return (unsigned)__builtin_amdgcn_s_getreg((3 << 11) | 20) & 0xFu; }
#define XB_SPIN(cond, bar) do { unsigned _sp = 0; while (cond) { __builtin_amdgcn_s_sleep(1); \
    if ((++_sp & 255u) == 0u) { if (xb_ld(&(bar)[XB_TMO])) break; if (_sp > XB_SPIN_CAP) { atomicAdd(&(bar)[XB_TMO], 1u); break; } } } } while (0)

struct XcdBarrier {
    unsigned* bar; unsigned x;
    volatile LAS unsigned* st;
};
__device__ __forceinline__ XcdBarrier xcd_barrier_post(unsigned* bar, volatile LAS unsigned* st) {
    XcdBarrier b; b.bar = bar; b.x = xb_xcc_id(); b.st = st;
    if (threadIdx.x == 0) (void)xb_add(&bar[XB_XCNT(b.x)], 1u);
    return b;
}
__device__ __forceinline__ void xcd_barrier_complete(unsigned* bar, unsigned x, unsigned& nloc, unsigned& nx) {
    const unsigned G = gridDim.x * gridDim.y * gridDim.z;
    unsigned sum, cnt, mine, sp = 0u;
    for (;;) {
        sum = 0u; cnt = 0u; mine = 0u;
#pragma unroll
        for (unsigned j = 0; j < 16; ++j) { const unsigned c = xb_ld(&bar[XB_XCNT(j)]); sum += c; cnt += (c > 0u) ? 1u : 0u; mine = (j == x) ? c : mine; }
        if (sum == G) break;
        __builtin_amdgcn_s_sleep(1);
        if ((++sp & 255u) == 0u) { if (xb_ld(&bar[XB_TMO])) break; if (sp > XB_SPIN_CAP) { atomicAdd(&bar[XB_TMO], 1u); break; } }
    }
    nloc = mine > 0u ? mine : 1u; nx = cnt > 0u ? cnt : 1u;
}
__device__ __forceinline__ void xcd_barrier(const XcdBarrier& b) {
    asm volatile("s_waitcnt vmcnt(0)" ::: "memory");
    __syncthreads();
    if (threadIdx.x == 0) {
        unsigned* bar = b.bar;
        __builtin_amdgcn_s_waitcnt(0);
        unsigned nloc = b.st[0], nx = b.st[1];
        if (nloc == 0u) { xcd_barrier_complete(bar, b.x, nloc, nx); b.st[0] = nloc; b.st[1] = nx; }
        const unsigned old = xb_add(&bar[XB_XSUB(b.x)], 1u);
        const unsigned gen = old / nloc;
        if (old + 1u == (gen + 1u) * nloc) {
            __builtin_amdgcn_fence(__ATOMIC_RELEASE, "agent");
            asm volatile("s_waitcnt vmcnt(0)" ::: "memory");
            const unsigned og = xb_add(&bar[XB_TOP], 1u);
            const unsigned tg = og / nx;
            if (og + 1u == (tg + 1u) * nx) xb_add(&bar[XB_TOPGEN], 1u);
            else XB_SPIN(xb_ld(&bar[XB_TOPGEN]) == tg, bar);
            __builtin_amdgcn_fence(__ATOMIC_ACQUIRE, "agent");
            xb_add(&bar[XB_XGEN(b.x)], 1u);
            asm volatile("s_waitcnt vmcnt(0)" ::: "memory");
        } else {
            XB_SPIN(xb_ld(&bar[XB_XGEN(b.x)]) == gen, bar);
            __builtin_amdgcn_fence(__ATOMIC_ACQUIRE, "agent");
            asm volatile("s_waitcnt vmcnt(0)" ::: "memory");
        }
    }
    __syncthreads();
}

struct Frame {
    LAS unsigned char* lds;
    int tid, lane, wave, vcu, G;
    unsigned char* ws;
    const float* const* in;
    float* out;
};
#define WSP(T, off) ((T*)(F.ws + (off)))
enum InIdx { I_X = 0, I_C, I_CTX, I_CCTX, I_ADAW, I_ADAB, I_N1G, I_WIN, I_CONVW, I_LRE, I_LIM, I_LDT, I_BRE, I_BIM, I_CRE, I_CIM, I_SSMD, I_WGLU, I_ONCG, I_ONSG, I_WOUT, I_N2G, I_RW, I_WG, I_WU, I_WD, I_FNG };

using pg8::Unit;
struct EpiProj {
    static constexpr bool PERM = true, AFTER_DRAIN = false;
    bf16* proj; bf16* u2;
    __device__ __forceinline__ void operator()(const f32x4 (&acc)[2][2][4][2], const Unit& u, int wr, int wc, int fr, int fq) const {
        const int row0 = u.pm * 256 + wr * 64 + fr, col0 = u.pn * 256 + wc * 32 + 8 * fq;
#pragma unroll
        for (int ai = 0; ai < 2; ++ai)
#pragma unroll
            for (int m = 0; m < 4; ++m) { const int row = row0 + ai * 128 + m * 16;
#pragma unroll
                for (int bj = 0; bj < 2; ++bj) { const f32x4 v0 = acc[ai][bj][m][0], v1 = acc[ai][bj][m][1]; const int col = col0 + bj * 128;
                    v4u w; w.x = pg8::cvt_pk_bf16(v0[0], v0[1]); w.y = pg8::cvt_pk_bf16(v0[2], v0[3]); w.z = pg8::cvt_pk_bf16(v1[0], v1[1]); w.w = pg8::cvt_pk_bf16(v1[2], v1[3]);
                    bf16* dst;
                    if (u.pn < 18) dst = proj + (size_t)row * (3 * DCONV) + col;
                    else { const int cc = col - 3 * DCONV, g = cc >> 4, i0 = cc & 15; dst = u2 + ((size_t)(g * NINST + (row >> 6)) * KS2 + (row & 63) * 16 + i0); }
                    *(GAS v4u*)dst = w; } }
    }
};
struct EpiF32 {
    static constexpr bool PERM = false, AFTER_DRAIN = false;
    float* C; int ldc; size_t cstride;
    __device__ __forceinline__ void operator()(const f32x4 (&acc)[2][2][4][2], const Unit& u, int wr, int wc, int fr, int fq) const {
        float* base = C + (size_t)u.aux * cstride; const int row0 = u.pm * 256 + wr * 64 + fr, col0 = u.pn * 256 + wc * 32 + 4 * fq;
#pragma unroll
        for (int ai = 0; ai < 2; ++ai)
#pragma unroll
            for (int m = 0; m < 4; ++m) { float* rowp = base + (size_t)(row0 + ai * 128 + m * 16) * ldc + col0;
#pragma unroll
                for (int bj = 0; bj < 2; ++bj)
#pragma unroll
                    for (int n = 0; n < 2; ++n) *(GAS f32x4*)(rowp + bj * 128 + n * 16) = acc[ai][bj][m][n]; }
    }
};
struct EpiS2 {
    static constexpr bool PERM = true, AFTER_DRAIN = false;
    const bf16* u2; const float* dsk; bf16* z;
    __device__ __forceinline__ void operator()(const f32x4 (&acc)[2][2][4][2], const Unit& u, int wr, int wc, int fr, int fq) const {
        const int g = u.aux, inst0 = u.pm * 256 + wr * 64 + fr, c0 = u.pn * 256 + wc * 32 + 8 * fq;
#pragma unroll
        for (int bj = 0; bj < 2; ++bj) { const int cidx = c0 + bj * 128, t = cidx >> 4, o0 = cidx & 15;
            const f32x4 d0 = *(const GAS f32x4*)(dsk + g * 16 + o0), d1 = *(const GAS f32x4*)(dsk + g * 16 + o0 + 4);
#pragma unroll
            for (int ai = 0; ai < 2; ++ai)
#pragma unroll
                for (int m = 0; m < 4; ++m) { const int inst = inst0 + ai * 128 + m * 16;
                    if (inst < MT / 64) {
                        const v4u uu = *(const GAS v4u*)(u2 + ((size_t)(g * NINST + inst) * KS2 + cidx));
                        const f32x4 a0 = acc[ai][bj][m][0], a1 = acc[ai][bj][m][1];
                        const float y0 = a0[0] + d0[0] * bflo(uu.x), y1 = a0[1] + d0[1] * bfhi(uu.x), y2 = a0[2] + d0[2] * bflo(uu.y), y3 = a0[3] + d0[3] * bfhi(uu.y);
                        const float y4 = a1[0] + d1[0] * bflo(uu.z), y5 = a1[1] + d1[1] * bfhi(uu.z), y6 = a1[2] + d1[2] * bflo(uu.w), y7 = a1[3] + d1[3] * bfhi(uu.w);
                        v4u w; w.x = pg8::cvt_pk_bf16(gelu_tanh(y0), gelu_tanh(y1)); w.y = pg8::cvt_pk_bf16(gelu_tanh(y2), gelu_tanh(y3));
                        w.z = pg8::cvt_pk_bf16(gelu_tanh(y4), gelu_tanh(y5)); w.w = pg8::cvt_pk_bf16(gelu_tanh(y6), gelu_tanh(y7));
                        *(GAS v4u*)(z + ((size_t)(inst * 64 + t) * DSSM + g * 16 + o0)) = w; } } }
    }
};
struct EpiGlu {
    static constexpr bool PERM = true, AFTER_DRAIN = true;
    const bf16* z; const float* gain; bf16* concat;
    __device__ __forceinline__ void operator()(const f32x4 (&)[2][2][4][2], const Unit&, int, int, int, int) const {}
    __device__ __forceinline__ void fused(f32x4 (&acc)[2][2][4][2], const Unit& u, int wr, int wc, int fr, int fq, LAS unsigned char* lds, int wid, int lane) const {
        LAS float* P = (LAS float*)lds;
        const int row0 = u.pm * 256 + wr * 64 + fr, col0 = u.pn * 256 + wc * 32 + 8 * fq;
#pragma unroll
        for (int ai = 0; ai < 2; ++ai)
#pragma unroll
            for (int m = 0; m < 4; ++m) { const int row = row0 + ai * 128 + m * 16, rt = ai * 128 + wr * 64 + m * 16 + fr;
#pragma unroll
                for (int bj = 0; bj < 2; ++bj) { const v4u zz = *(const GAS v4u*)(z + (size_t)row * DSSM + col0 + bj * 128);
                    f32x4 a0 = acc[ai][bj][m][0], a1 = acc[ai][bj][m][1];
                    a0[0] = bflo(zz.x) * sigmoidf_(a0[0]); a0[1] = bfhi(zz.x) * sigmoidf_(a0[1]); a0[2] = bflo(zz.y) * sigmoidf_(a0[2]); a0[3] = bfhi(zz.y) * sigmoidf_(a0[3]);
                    a1[0] = bflo(zz.z) * sigmoidf_(a1[0]); a1[1] = bfhi(zz.z) * sigmoidf_(a1[1]); a1[2] = bflo(zz.w) * sigmoidf_(a1[2]); a1[3] = bfhi(zz.w) * sigmoidf_(a1[3]);
                    acc[ai][bj][m][0] = a0; acc[ai][bj][m][1] = a1;
                    float s = (a0[0] * a0[0] + a0[1] * a0[1]) + (a0[2] * a0[2] + a0[3] * a0[3]) + (a1[0] * a1[0] + a1[1] * a1[1]) + (a1[2] * a1[2] + a1[3] * a1[3]);
                    s += __shfl_xor(s, 16); s += __shfl_xor(s, 32);
                    if (fq == 0) P[(rt * 2 + bj) * 4 + wc] = s; } }
        LDS_WAIT(); __builtin_amdgcn_s_barrier(); asm volatile("" ::: "memory");
#pragma unroll
        for (int bj = 0; bj < 2; ++bj) { const int col = col0 + bj * 128;
            const f32x4 g0 = *(const GAS f32x4*)(gain + col), g1 = *(const GAS f32x4*)(gain + col + 4);
#pragma unroll
            for (int ai = 0; ai < 2; ++ai)
#pragma unroll
                for (int m = 0; m < 4; ++m) { const int row = row0 + ai * 128 + m * 16, rt = ai * 128 + wr * 64 + m * 16 + fr;
                    const f32x4 p = *(const LAS f32x4*)(P + (rt * 2 + bj) * 4);
                    const float rs = 1.0f / sqrtf(((p[0] + p[1]) + (p[2] + p[3])) * (1.0f / 128.0f) + EPS);
                    const f32x4 a0 = acc[ai][bj][m][0] * rs * g0, a1 = acc[ai][bj][m][1] * rs * g1;
                    v4u w; w.x = pg8::cvt_pk_bf16(a0[0], a0[1]); w.y = pg8::cvt_pk_bf16(a0[2], a0[3]); w.z = pg8::cvt_pk_bf16(a1[0], a1[1]); w.w = pg8::cvt_pk_bf16(a1[2], a1[3]);
                    *(GAS v4u*)(concat + (size_t)row * DM + DCONV + col) = w; } }
    }
};
struct EpiOut {
    static constexpr bool PERM = false, AFTER_DRAIN = false;
    const float* xlat; const float* xctx; const float* mod; float* xm;
    __device__ __forceinline__ void operator()(const f32x4 (&acc)[2][2][4][2], const Unit& u, int wr, int wc, int fr, int fq) const {
        const int rb = u.pm < 64 ? (u.pm >> 3) : 8; const float* g1 = mod + (size_t)(rb * 6 + 2) * DM;
        const float* xp = u.pm < 64 ? xlat + (size_t)u.pm * 256 * DM : xctx + (size_t)(u.pm - 64) * 256 * DM;
        float* xo = xm + (size_t)u.pm * 256 * DM;
        const int r0 = wr * 64 + fr, col0 = u.pn * 256 + wc * 32 + 4 * fq;
        f32x4 gv[2][2];
#pragma unroll
        for (int bj = 0; bj < 2; ++bj)
#pragma unroll
            for (int n = 0; n < 2; ++n) gv[bj][n] = *(const GAS f32x4*)(g1 + col0 + bj * 128 + n * 16);
#pragma unroll
        for (int ai = 0; ai < 2; ++ai)
#pragma unroll
            for (int m = 0; m < 4; ++m) { const size_t off = (size_t)(r0 + ai * 128 + m * 16) * DM + col0;
#pragma unroll
                for (int bj = 0; bj < 2; ++bj)
#pragma unroll
                    for (int n = 0; n < 2; ++n) { const f32x4 xv = *(const GAS f32x4*)(xp + off + bj * 128 + n * 16);
                        *(GAS f32x4*)(xo + off + bj * 128 + n * 16) = xv + gv[bj][n] * acc[ai][bj][m][n]; }
                asm volatile("" ::: "memory"); }
    }
};
struct EpiMoe1 {
    static constexpr bool PERM = true, AFTER_DRAIN = false;
    bf16* act;
    __device__ __forceinline__ void operator()(const f32x4 (&acc)[2][2][4][2], const Unit& u, int wr, int wc, int fr, int fq) const {
        const int row0 = u.pm * 256 + wr * 64 + fr, f0 = u.pn * 128 + wc * 32 + 8 * fq;
#pragma unroll
        for (int ai = 0; ai < 2; ++ai)
#pragma unroll
            for (int m = 0; m < 4; ++m) { const f32x4 g0 = acc[ai][0][m][0], g1 = acc[ai][0][m][1], u0 = acc[ai][1][m][0], u1 = acc[ai][1][m][1];
                float r[8];
#pragma unroll
                for (int j = 0; j < 4; ++j) { r[j] = g0[j] * sigmoidf_(g0[j]) * u0[j]; r[4 + j] = g1[j] * sigmoidf_(g1[j]) * u1[j]; }
                v4u w; w.x = pg8::cvt_pk_bf16(r[0], r[1]); w.y = pg8::cvt_pk_bf16(r[2], r[3]); w.z = pg8::cvt_pk_bf16(r[4], r[5]); w.w = pg8::cvt_pk_bf16(r[6], r[7]);
                *(GAS v4u*)(act + (size_t)(row0 + ai * 128 + m * 16) * DF + f0) = w; }
    }
};
struct EpiBf16 {
    static constexpr bool PERM = true, AFTER_DRAIN = false;
    bf16* O; int ldc;
    __device__ __forceinline__ void operator()(const f32x4 (&acc)[2][2][4][2], const Unit& u, int wr, int wc, int fr, int fq) const {
        const int row0 = u.pm * 256 + wr * 64 + fr, col0 = u.pn * 256 + wc * 32 + 8 * fq;
#pragma unroll
        for (int ai = 0; ai < 2; ++ai)
#pragma unroll
            for (int m = 0; m < 4; ++m) { bf16* rowp = O + (size_t)(row0 + ai * 128 + m * 16) * ldc + col0;
#pragma unroll
                for (int bj = 0; bj < 2; ++bj) { const f32x4 v0 = acc[ai][bj][m][0], v1 = acc[ai][bj][m][1];
                    v4u w; w.x = pg8::cvt_pk_bf16(v0[0], v0[1]); w.y = pg8::cvt_pk_bf16(v0[2], v0[3]); w.z = pg8::cvt_pk_bf16(v1[0], v1[1]); w.w = pg8::cvt_pk_bf16(v1[2], v1[3]);
                    *(GAS v4u*)(rowp + bj * 128) = w; } }
    }
};

struct SchedProj {
    const char* A; const char* B; int G, c, layer;
    __device__ __forceinline__ bool next(int i, Unit& u) const {
        const int L = i * G + c; int rt, ct;
        if (layer == 0) { if (L >= 1440) return false; rt = (L / 160) * 8 + (L & 7); ct = (L % 160) >> 3; }
        else { if (L >= 1296) return false; if (L < 1280) { rt = (L / 160) * 8 + (L & 7); ct = (L % 160) >> 3; } else { const int j = L - 1280; rt = 64 + (j & 7); ct = 18 + (j >> 3); } }
        u.pm = rt; u.pn = ct; u.aux = 0; u.a = A + (size_t)rt * 256 * DM * 2; u.b = B + (size_t)ct * 256 * DM * 2; return true; }
};
struct SchedF {
    const char* A; const char* B; int G, c;
    __device__ __forceinline__ bool next(int i, Unit& u) const {
        const int j = c - (G - 64); if (i != 0 || j < 0) return false;
        const int g = j >> 1, rt = j & 1; u.pm = rt; u.pn = 0; u.aux = g; u.a = A + (size_t)(g * NINST + rt * 256) * KS2 * 2; u.b = B + (size_t)g * 256 * 1024 * 2; return true; }
};
struct SchedS2 {
    const char* A; const char* B; int G, c, layer;
    __device__ __forceinline__ bool next(int i, Unit& u) const {
        const int L = i * G + c; int g, rt, ct;
        if (layer == 0) { if (L >= 256) return false; g = L >> 3; rt = (L >> 2) & 1; ct = L & 3; } else { if (L >= 128) return false; g = L >> 2; rt = 0; ct = L & 3; }
        u.pm = rt; u.pn = ct; u.aux = g; u.a = A + (size_t)(g * NINST + rt * 256) * KS2 * 2; u.b = B + (size_t)(g * 1024 + ct * 256) * KS2 * 2; return true; }
};
struct SchedGlu {
    const char* A; const char* B; int G, c, nrt;
    __device__ __forceinline__ bool next(int i, Unit& u) const {
        const int L = i * G + c; if (L >= nrt * 2) return false;
        u.pm = L >> 1; u.pn = L & 1; u.aux = 0; u.a = A + (size_t)u.pm * 256 * DSSM * 2; u.b = B + (size_t)u.pn * 256 * DSSM * 2; return true; }
};
struct SchedOut {
    const char* A; const char* B; int G, c, nrt;
    __device__ __forceinline__ bool next(int i, Unit& u) const {
        const int L = i * G + c; if (L >= nrt * 8) return false;
        u.pm = (L >> 6) * 8 + (L & 7); u.pn = (L & 63) >> 3; u.aux = 0; u.a = A + (size_t)u.pm * 256 * DM * 2; u.b = B + (size_t)u.pn * 256 * DM * 2; return true; }
};
struct SchedMoe {
    const char* A; const char* B; int G, c, nct, layer;
    __device__ __forceinline__ bool next(int i, Unit& u) const {
        const int L = i * G + c, per = 8 * nct, nlat = NE * per; int e, rtile, ct;
        if (L < nlat) { e = L / per; const int w = L % per; ct = (w >> 5) * 4 + (w & 3); rtile = e * 8 + ((w & 31) >> 2); }
        else { const int j = L - nlat; if (layer != 0 || j >= NE * nct) return false; e = j / nct; ct = j % nct; rtile = NE * 8 + e; }
        u.pm = rtile; u.pn = ct; u.aux = e; u.a = A + (size_t)rtile * 256 * 2048 * 2; u.b = B + ((size_t)e * nct + ct) * 256 * 2048 * 2; return true; }
};

__device__ __forceinline__ void p0_transpose_item(const float* W, int N, bf16* WT, int ldwt, int orow0, int k0, int n0, LAS float* scr, int lane) {
#pragma unroll 8
    for (int i = 0; i < 32; ++i) { const int kk = 2 * i + (lane >> 5); scr[kk * 33 + (lane & 31)] = *(const GAS float*)(W + (size_t)(k0 + kk) * N + n0 + (lane & 31)); }
    LDS_WAIT(); asm volatile("" ::: "memory");
    const int c = lane & 7;
#pragma unroll
    for (int j = 0; j < 4; ++j) { const int n = (lane >> 3) + 8 * j; const LAS float* s = scr + (8 * c) * 33 + n;
        v4u o; o.x = pk2(s[0 * 33], s[1 * 33]); o.y = pk2(s[2 * 33], s[3 * 33]); o.z = pk2(s[4 * 33], s[5 * 33]); o.w = pk2(s[6 * 33], s[7 * 33]);
        *(GAS v4u*)(WT + (size_t)(orow0 + n) * ldwt + k0 + 8 * c) = o; }
    LDS_WAIT(); asm volatile("" ::: "memory");
}
__device__ __forceinline__ void p0_convert_weights(Frame& F) {
    LAS float* scr = (LAS float*)(F.lds + F.wave * 16384);
    const long gw = (long)F.vcu * NWAVES + F.wave, NGW = (long)F.G * NWAVES;
    constexpr long I_EXP = 32 * 64;
    constexpr long N_GATE = 2L * NE * I_EXP, N_WIN = 2L * 32 * 160, N_WOUT = 2L * I_EXP, N_GLU = 2L * 8 * 16;
    constexpr long NITEMS = 3 * N_GATE + N_WIN + N_WOUT + N_GLU;
    for (long it = gw; it < NITEMS; it += NGW) {
        long r = it;
        if (r < 2 * N_GATE) {
            const int kind = r >= N_GATE; if (kind) r -= N_GATE;
            const int le = (int)(r / I_EXP), q = (int)(r % I_EXP), kb = q >> 6, nb = q & 63, n0 = nb * 32;
            const float* W = F.in[kind ? I_WU : I_WG] + (size_t)le * DM * DF;
            bf16* WT = WSP(bf16, WS_WGU) + (size_t)le * 4096 * DM;
            p0_transpose_item(W, DF, WT, DM, (n0 >> 7) * 256 + kind * 128 + (n0 & 127), kb * 64, n0, scr, F.lane); continue; }
        r -= 2 * N_GATE;
        if (r < N_GATE) { const int le = (int)(r / I_EXP), q = (int)(r % I_EXP), kb = q >> 6, nb = q & 63;
            p0_transpose_item(F.in[I_WD] + (size_t)le * DF * DM, DM, WSP(bf16, WS_WDN) + (size_t)le * DM * DF, DF, nb * 32, kb * 64, nb * 32, scr, F.lane); continue; }
        r -= N_GATE;
        if (r < N_WIN) { const int l = (int)(r / (32 * 160)), q = (int)(r % (32 * 160)), kb = q / 160, nb = q % 160;
            p0_transpose_item(F.in[I_WIN] + (size_t)l * DM * DINP, DINP, WSP(bf16, WS_WIN) + (size_t)l * DINP * DM, DM, nb * 32, kb * 64, nb * 32, scr, F.lane); continue; }
        r -= N_WIN;
        if (r < N_WOUT) { const int l = (int)(r / I_EXP), q = (int)(r % I_EXP), kb = q >> 6, nb = q & 63;
            p0_transpose_item(F.in[I_WOUT] + (size_t)l * DM * DM, DM, WSP(bf16, WS_WOUT) + (size_t)l * DM * DM, DM, nb * 32, kb * 64, nb * 32, scr, F.lane); continue; }
        r -= N_WOUT;
        { const int l = (int)(r / 128), q = (int)(r % 128), kb = q >> 4, nb = q & 15;
            p0_transpose_item(F.in[I_WGLU] + (size_t)l * DSSM * DSSM, DSSM, WSP(bf16, WS_WGLU) + (size_t)l * DSSM * DSSM, DSSM, nb * 32, kb * 64, nb * 32, scr, F.lane); }
    }
}
__device__ __forceinline__ void p0_mod_task(Frame& F, int task) {
    const int l = task / 96, n0 = (task % 96) * 128;
    LAS float* sc = (LAS float*)F.lds;
    LAS float* red = (LAS float*)(F.lds + 9 * 2048 * 4);
    for (int i = F.tid; i < 9 * DM; i += 512) { const int r = i >> 11, k = i & 2047; const float v = r < 8 ? F.in[I_C][r * DM + k] : F.in[I_CCTX][k]; sc[i] = v * sigmoidf_(v); }
    __syncthreads();
    const float* W = F.in[I_ADAW] + (size_t)l * DM * 6 * DM + n0 + 2 * F.lane;
    float acc[9][2];
#pragma unroll
    for (int r = 0; r < 9; ++r) { acc[r][0] = 0.f; acc[r][1] = 0.f; }
    const int kbase = F.wave * 256;
#pragma unroll 4
    for (int kk = 0; kk < 256; ++kk) { const int k = kbase + kk; const f32x2 w = *(const GAS f32x2*)(W + (size_t)k * (6 * DM));
#pragma unroll
        for (int r = 0; r < 9; ++r) { const float s = sc[r * DM + k]; acc[r][0] += s * w.x; acc[r][1] += s * w.y; } }
#pragma unroll
    for (int r = 0; r < 9; ++r) { red[(F.wave * 9 + r) * 128 + 2 * F.lane] = acc[r][0]; red[(F.wave * 9 + r) * 128 + 2 * F.lane + 1] = acc[r][1]; }
    __syncthreads();
    float* mod = WSP(float, WS_MOD) + (size_t)l * 9 * 6 * DM;
    for (int i = F.tid; i < 9 * 128; i += 512) { const int r = i >> 7, n = i & 127; float s = F.in[I_ADAB][(size_t)l * 6 * DM + n0 + n];
#pragma unroll
        for (int w = 0; w < 8; ++w) s += red[(w * 9 + r) * 128 + n];
        mod[(size_t)r * 6 * DM + n0 + n] = s; }
    __syncthreads();
}
__device__ __forceinline__ void p0_s5_task(Frame& F, int task) {
    const int l = task >> 5, g = task & 31;
    LAS f32x2* PW = (LAS f32x2*)F.lds;
    LAS f32x2* BB = (LAS f32x2*)(F.lds + 33280);
    LAS f32x2* CC = (LAS f32x2*)(F.lds + 41472);
    LAS float* KD = (LAS float*)(F.lds + 49664);
    LAS bf16* KT = (LAS bf16*)(F.lds + 50688);
    bf16* WF = WSP(bf16, WS_WF) + (size_t)(l * NG + g) * 256 * 1024;
    bf16* W2 = WSP(bf16, WS_W2) + (size_t)(l * NG + g) * 1024 * KS2;
    for (int d = 0; d < 2; ++d) {
        const int ldg = (l * 2 + d) * NG + g;
        if (F.tid < 64) { const int p = F.tid;
            const double lr = (double)F.in[I_LRE][ldg * SP + p], li = (double)F.in[I_LIM][ldg * SP + p], dt = exp((double)F.in[I_LDT][ldg]);
            const double mag = exp(lr * dt), ar = mag * cos(li * dt), ai = mag * sin(li * dt), den = lr * lr + li * li, nr = ar - 1.0;
            const double kr = (nr * lr + ai * li) / den, ki = (ai * lr - nr * li) / den;
            double pr = 1.0, pi = 0.0;
            for (int e = 0; e <= 64; ++e) { PW[e * 64 + p] = (f32x2){(float)pr, (float)pi}; const double t = pr * ar - pi * ai; pi = pr * ai + pi * ar; pr = t; }
            if (true) { const f32x2 lt = PW[64 * 64 + p]; WSP(f32x2, WS_LT)[((l * NG + g) * 2 + d) * 64 + p] = lt; }
            for (int i = 0; i < SG; ++i) { const double br = (double)F.in[I_BRE][((size_t)ldg * SP + p) * SG + i], bi = (double)F.in[I_BIM][((size_t)ldg * SP + p) * SG + i];
                BB[p * 16 + i] = (f32x2){(float)(kr * br - ki * bi), (float)(kr * bi + ki * br)}; } }
        for (int i = F.tid; i < 1024; i += 512) CC[i] = (f32x2){F.in[I_CRE][(size_t)ldg * 1024 + i], F.in[I_CIM][(size_t)ldg * 1024 + i]};
        __syncthreads();
        { const int ph = F.tid & 1, q = F.tid >> 1, o = q >> 4, i = q & 15;
            float cbr[32], cbi[32];
#pragma unroll
            for (int p = 0; p < 32; ++p) { const f32x2 c = CC[o * 64 + ph * 32 + p], b = BB[(ph * 32 + p) * 16 + i]; cbr[p] = c.x * b.x - c.y * b.y; cbi[p] = c.x * b.y + c.y * b.x; }
#pragma unroll 1
            for (int j = 0; j < 64; ++j) { float s = 0.f;
#pragma unroll
                for (int p = 0; p < 32; ++p) { const f32x2 P = PW[j * 64 + ph * 32 + p]; s += cbr[p] * P.x - cbi[p] * P.y; }
                s += __shfl_xor(s, 1);
                if (ph == 0) { if (j == 0) { if (d == 0) KD[q] = s; else { s += KD[q]; KT[q] = (bf16)f2bf(s); } }
                               else KT[(d * 64 + j) * 256 + q] = (bf16)f2bf(s); } } }
        for (int it = F.tid; it < 128 * 128; it += 512) { const int n = it >> 7, k8 = it & 127, ri = n >> 6, p = n & 63, s = k8 >> 1, i0 = (k8 & 1) * 8, e = d == 0 ? 63 - s : s;
            const f32x2 P = PW[e * 64 + p]; float v[8];
#pragma unroll
            for (int j = 0; j < 8; ++j) { const f32x2 b = BB[p * 16 + i0 + j]; v[j] = ri == 0 ? (P.x * b.x - P.y * b.y) : (P.x * b.y + P.y * b.x); }
            v4u o; o.x = pk2(v[0], v[1]); o.y = pk2(v[2], v[3]); o.z = pk2(v[4], v[5]); o.w = pk2(v[6], v[7]);
            *(GAS v4u*)(WF + (size_t)(d * 128 + n) * 1024 + k8 * 8) = o; }
        for (int it = F.tid; it < 1024 * 16; it += 512) { const int n = it >> 4, c8 = it & 15, ri = c8 >> 3, p0 = (c8 & 7) * 8, t = n >> 4, o = n & 15, e = d == 0 ? t + 1 : 64 - t; float v[8];
#pragma unroll
            for (int j = 0; j < 8; ++j) { const f32x2 c = CC[o * 64 + p0 + j], P = PW[e * 64 + p0 + j]; v[j] = ri == 0 ? (c.x * P.x - c.y * P.y) : -(c.x * P.y + c.y * P.x); }
            v4u ov; ov.x = pk2(v[0], v[1]); ov.y = pk2(v[2], v[3]); ov.z = pk2(v[4], v[5]); ov.w = pk2(v[6], v[7]);
            *(GAS v4u*)(W2 + (size_t)n * KS2 + 1024 + d * 128 + c8 * 8) = ov; }
        __syncthreads();
    }
    for (int it = F.tid; it < 1024 * 128; it += 512) { const int n = it >> 7, k8 = it & 127, t = n >> 4, o = n & 15, s = k8 >> 1, i0 = (k8 & 1) * 8;
        const int dsel = s <= t ? 0 : 1, j = s <= t ? t - s : s - t;
        const v4u kv = *(const LAS v4u*)(KT + (dsel * 64 + j) * 256 + o * 16 + i0);
        *(GAS v4u*)(W2 + (size_t)n * KS2 + k8 * 8) = kv; }
    __syncthreads();
}
__device__ __forceinline__ void p0_router_t(Frame& F) {
    for (int i = (F.vcu * 512 + F.tid); i < 2 * 16 * DM; i += F.G * 512) { const int l = i >> 15, e = (i >> 11) & 15, k = i & 2047; WSP(float, WS_RWT)[i] = F.in[I_RW][((size_t)l * DM + k) * NE + e]; }
}

__device__ __forceinline__ int mbcnt64(unsigned long long m) { return (int)__builtin_amdgcn_mbcnt_hi((unsigned)(m >> 32), __builtin_amdgcn_mbcnt_lo((unsigned)m, 0u)); }
__device__ __forceinline__ void combine_row(Frame& F, int r, const float* g2, f32x4 (&x)[8]) {
    const int* sel = WSP(int, WS_SEL) + (size_t)r * NE; const float* vals = WSP(float, WS_VALS); const bf16* Y = WSP(bf16, WS_R1);
    const int mysel = F.lane < NE ? *(const GAS int*)(sel + F.lane) : -1;
    unsigned long long m = __ballot(mysel >= 0);
    f32x4 macc[8];
#pragma unroll
    for (int j = 0; j < 8; ++j) macc[j] = (f32x4){0.f, 0.f, 0.f, 0.f};
    while (m) { const int e = __builtin_ctzll(m); m &= m - 1;
        const int y = __builtin_amdgcn_readlane(mysel, e); const float val = *(const GAS float*)(vals + y); const bf16* yr = Y + (size_t)y * DM + 4 * F.lane;
#pragma unroll
        for (int j = 0; j < 8; ++j) { const v2u w = *(const GAS v2u*)(yr + j * 256); macc[j] += val * (f32x4){bflo(w.x), bfhi(w.x), bflo(w.y), bfhi(w.y)}; } }
#pragma unroll
    for (int j = 0; j < 8; ++j) x[j] += *(const GAS f32x4*)(g2 + j * 256 + 4 * F.lane) * macc[j];
}
__device__ __forceinline__ float row_rs(const f32x4 (&x)[8]) {
    float s = 0.f;
#pragma unroll
    for (int j = 0; j < 8; ++j) s += (x[j][0] * x[j][0] + x[j][1] * x[j][1]) + (x[j][2] * x[j][2] + x[j][3] * x[j][3]);
    return 1.0f / sqrtf(wave_sum(s) * (1.0f / DM) + EPS);
}
__device__ __forceinline__ void phase_norm1(Frame& F, int l) {
    const float* modl = WSP(float, WS_MOD) + (size_t)l * 9 * 6 * DM; const float* gn = F.in[I_N1G] + (size_t)l * DM;
    for (int r = F.vcu * NWAVES + F.wave; r < MT; r += F.G * NWAVES) {
        const int rb = r < ML ? (r >> 11) : 8;
        const float* xr = l == 0 ? (r < ML ? F.in[I_X] + (size_t)r * DM : F.in[I_CTX] + (size_t)(r - ML) * DM) : WSP(float, WS_XM) + (size_t)r * DM;
        f32x4 x[8];
#pragma unroll
        for (int j = 0; j < 8; ++j) x[j] = *(const GAS f32x4*)(xr + j * 256 + 4 * F.lane);
        if (l == 1) { combine_row(F, r, WSP(float, WS_MOD) + (size_t)(rb * 6 + 5) * DM, x);
            float* xo = WSP(float, WS_XL) + (size_t)r * DM;
#pragma unroll
            for (int j = 0; j < 8; ++j) *(GAS f32x4*)(xo + j * 256 + 4 * F.lane) = x[j]; }
        const float rs = row_rs(x); const float* sh = modl + (size_t)(rb * 6 + 0) * DM; const float* sc = modl + (size_t)(rb * 6 + 1) * DM;
        bf16* ho = WSP(bf16, WS_H) + (size_t)r * DM;
#pragma unroll
        for (int j = 0; j < 8; ++j) { const int c = j * 256 + 4 * F.lane; const f32x4 g = *(const GAS f32x4*)(gn + c), s1 = *(const GAS f32x4*)(sc + c), s0 = *(const GAS f32x4*)(sh + c);
            const f32x4 h = x[j] * rs * g * (1.0f + s1) + s0; v2u w; w.x = pk2(h[0], h[1]); w.y = pk2(h[2], h[3]); *(GAS v2u*)(ho + c) = w; }
    }
}
__device__ __forceinline__ void phase_final(Frame& F) {
    const float* gn = F.in[I_FNG];
    for (int r = F.vcu * NWAVES + F.wave; r < ML; r += F.G * NWAVES) {
        const int rb = r >> 11; const float* xr = WSP(float, WS_XM) + (size_t)r * DM;
        f32x4 x[8];
#pragma unroll
        for (int j = 0; j < 8; ++j) x[j] = *(const GAS f32x4*)(xr + j * 256 + 4 * F.lane);
        combine_row(F, r, WSP(float, WS_MOD) + (size_t)((9 + rb) * 6 + 5) * DM, x);
        const float rs = row_rs(x); float* o = F.out + (size_t)r * DM;
#pragma unroll
        for (int j = 0; j < 8; ++j) { const int c = j * 256 + 4 * F.lane; *(GAS f32x4*)(o + c) = x[j] * rs * *(const GAS f32x4*)(gn + c); }
    }
}
__device__ __forceinline__ void phase_norm2(Frame& F, int l) {
    LAS float* rwt = (LAS float*)F.lds;
    { const float* src = WSP(float, WS_RWT) + (size_t)l * NE * DM;
        for (int i = F.tid; i < NE * DM / 4; i += 512) *(LAS f32x4*)(rwt + 4 * i) = *(const GAS f32x4*)(src + 4 * i); }
    __syncthreads();
    const float* modl = WSP(float, WS_MOD) + (size_t)l * 9 * 6 * DM; const float* gn = F.in[I_N2G] + (size_t)l * DM;
    const int nrows = l == 0 ? MT : ML;
    for (int r = F.vcu * NWAVES + F.wave; r < nrows; r += F.G * NWAVES) {
        const int rb = r < ML ? (r >> 11) : 8; const float* xr = WSP(float, WS_XM) + (size_t)r * DM;
        f32x4 x[8];
#pragma unroll
        for (int j = 0; j < 8; ++j) x[j] = *(const GAS f32x4*)(xr + j * 256 + 4 * F.lane);
        const float rs = row_rs(x); const float* sh = modl + (size_t)(rb * 6 + 3) * DM; const float* sc = modl + (size_t)(rb * 6 + 4) * DM;
        bf16* ho = WSP(bf16, WS_H) + (size_t)r * DM;
#pragma unroll
        for (int j = 0; j < 8; ++j) { const int c = j * 256 + 4 * F.lane; const f32x4 g = *(const GAS f32x4*)(gn + c), s1 = *(const GAS f32x4*)(sc + c), s0 = *(const GAS f32x4*)(sh + c);
            x[j] = x[j] * rs * g * (1.0f + s1) + s0; v2u w; w.x = pk2(x[j][0], x[j][1]); w.y = pk2(x[j][2], x[j][3]); *(GAS v2u*)(ho + c) = w; }
        float mine = -1e30f;
#pragma unroll 1
        for (int e = 0; e < NE; ++e) { float s = 0.f;
#pragma unroll
            for (int j = 0; j < 8; ++j) { const f32x4 w = *(const LAS f32x4*)(rwt + e * DM + j * 256 + 4 * F.lane); s += (x[j][0] * w[0] + x[j][1] * w[1]) + (x[j][2] * w[2] + x[j][3] * w[3]); }
            s = wave_sum(s); mine = (F.lane == e) ? s : mine; }
        float mx = mine;
        mx = fmaxf(mx, __shfl_xor(mx, 1)); mx = fmaxf(mx, __shfl_xor(mx, 2)); mx = fmaxf(mx, __shfl_xor(mx, 4)); mx = fmaxf(mx, __shfl_xor(mx, 8));
        const float ex = __expf(mine - mx); float den = ex;
        den += __shfl_xor(den, 1); den += __shfl_xor(den, 2); den += __shfl_xor(den, 4); den += __shfl_xor(den, 8);
        mine = ex / den;
        if (F.lane < NE) { if (r < ML) WSP(float, WS_AFF)[((size_t)(rb * NE + F.lane) << 11) + (r & 2047)] = mine;
                           else { const int q = r - ML; WSP(float, WS_AFFC)[((size_t)((q >> 8) * NE + F.lane) << 8) + (q & 255)] = mine; } }
    }
    __syncthreads();
}
__device__ __forceinline__ void phase_conv(Frame& F, int l, int nblk) {
    const bf16* P = WSP(bf16, WS_R1); bf16* cc = WSP(bf16, WS_R2);
    const float* cw = F.in[I_CONVW] + (size_t)l * 3 * DCONV; const float* gn = F.in[I_ONCG] + (size_t)l * DCONV;
    const int nrows = l == 0 ? MT : ML;
    for (int r = F.vcu * NWAVES + F.wave; r < nrows; r += nblk * NWAVES) {
        bool hp, hn; if (r < ML) { const int x = r & 63; hp = x > 0; hn = x < 63; } else { const int t = (r - ML) & 255; hp = t > 0; hn = t < 255; }
        const bf16* p0 = P + (size_t)r * (3 * DCONV);
#pragma unroll
        for (int ch = 0; ch < 3; ++ch) { const int c0 = ch * 512 + 8 * F.lane;
            const v4u bg = *(const GAS v4u*)(p0 + c0), cg = *(const GAS v4u*)(p0 + DCONV + c0), vv = *(const GAS v4u*)(p0 + 2 * DCONV + c0);
            v4u cgp = (v4u){0u, 0u, 0u, 0u}, vp = cgp, cgn = cgp, vn = cgp;
            if (hp) { cgp = *(const GAS v4u*)(p0 - 3 * DCONV + DCONV + c0); vp = *(const GAS v4u*)(p0 - 3 * DCONV + 2 * DCONV + c0); }
            if (hn) { cgn = *(const GAS v4u*)(p0 + 3 * DCONV + DCONV + c0); vn = *(const GAS v4u*)(p0 + 3 * DCONV + 2 * DCONV + c0); }
            float y[8]; float ss = 0.f;
#pragma unroll
            for (int q = 0; q < 4; ++q) {
                const unsigned b_ = bg[q], c_ = cg[q], v_ = vv[q], cp_ = cgp[q], vp_ = vp[q], cn_ = cgn[q], vn_ = vn[q];
                const f32x2 w0 = *(const GAS f32x2*)(cw + c0 + 2 * q), w1 = *(const GAS f32x2*)(cw + DCONV + c0 + 2 * q), w2 = *(const GAS f32x2*)(cw + 2 * DCONV + c0 + 2 * q);
                y[2 * q] = bflo(b_) * (w0.x * (bflo(cp_) * bflo(vp_)) + w1.x * (bflo(c_) * bflo(v_)) + w2.x * (bflo(cn_) * bflo(vn_)));
                y[2 * q + 1] = bfhi(b_) * (w0.y * (bfhi(cp_) * bfhi(vp_)) + w1.y * (bfhi(c_) * bfhi(v_)) + w2.y * (bfhi(cn_) * bfhi(vn_)));
                ss += y[2 * q] * y[2 * q] + y[2 * q + 1] * y[2 * q + 1]; }
            ss += __shfl_xor(ss, 1); ss += __shfl_xor(ss, 2); ss += __shfl_xor(ss, 4); ss += __shfl_xor(ss, 8);
            const float rs = 1.0f / sqrtf(ss * (1.0f / 128.0f) + EPS);
            const f32x4 g0 = *(const GAS f32x4*)(gn + c0), g1 = *(const GAS f32x4*)(gn + c0 + 4);
            v4u o; o.x = pk2(y[0] * rs * g0[0], y[1] * rs * g0[1]); o.y = pk2(y[2] * rs * g0[2], y[3] * rs * g0[3]); o.z = pk2(y[4] * rs * g1[0], y[5] * rs * g1[1]); o.w = pk2(y[6] * rs * g1[2], y[7] * rs * g1[3]);
            *(GAS v4u*)(cc + (size_t)r * DM + c0) = o; }
    }
}
__device__ __forceinline__ void phase_carry(Frame& F, int l) {
    const int gt = F.vcu * 512 + F.tid; if (gt >= NB * NG * 2 * SP) return;
    const int p = gt & 63, d = (gt >> 6) & 1, g = (gt >> 7) & 31, b = gt >> 12;
    const f32x2 lt = WSP(f32x2, WS_LT)[((l * NG + g) * 2 + d) * 64 + p];
    const float* Fb = WSP(float, WS_F); bf16* u2 = WSP(bf16, WS_U2);
    float hr = 0.f, hi = 0.f;
    for (int step = 0; step < 36; ++step) {
        int inst; if (step < 4) inst = 256 + b * 4 + (d == 0 ? step : 3 - step); else inst = b * 32 + (d == 0 ? step - 4 : 35 - step);
        const size_t row = (size_t)g * NINST + inst;
        u2[row * KS2 + 1024 + d * 128 + p] = (bf16)f2bf(hr); u2[row * KS2 + 1024 + d * 128 + 64 + p] = (bf16)f2bf(hi);
        const float fr = *(const GAS float*)(Fb + row * 256 + d * 128 + p), fi = *(const GAS float*)(Fb + row * 256 + d * 128 + 64 + p);
        const float nr = lt.x * hr - lt.y * hi + fr; hi = lt.x * hi + lt.y * hr + fi; hr = nr; }
}
template <int NJ>
__device__ __forceinline__ void topk_wave(Frame& F, const float* aff, int k, int srcrow0, int yrow0, int e, LAS int* idx_lds, LAS unsigned* av) {
#pragma unroll 1
    for (int j = 0; j < NJ; ++j) av[j * 64 + F.lane] = __builtin_bit_cast(unsigned, *(const GAS float*)(aff + j * 64 + F.lane));
    LDS_WAIT();
    unsigned T = 0u;
#pragma unroll 1
    for (int bit = 30; bit >= 0; --bit) { const unsigned cand = T | (1u << bit); int cnt = 0;
#pragma unroll 2
        for (int j = 0; j < NJ; ++j) cnt += (av[j * 64 + F.lane] >= cand) ? 1 : 0;
#pragma unroll
        for (int o = 1; o < 64; o <<= 1) cnt += __shfl_xor(cnt, o);
        if (cnt >= k) T = cand; }
    int ngt = 0, neq = 0;
#pragma unroll 2
    for (int j = 0; j < NJ; ++j) { const unsigned a = av[j * 64 + F.lane]; ngt += (a > T) ? 1 : 0; neq += (a == T) ? 1 : 0; }
    const int packed = (ngt << 16) | neq; int incl = packed;
#pragma unroll
    for (int o = 1; o < 64; o <<= 1) { const int t = __shfl_up(incl, o); incl += (F.lane >= o) ? t : 0; }
    const int excl = incl - packed, pgt = excl >> 16, peq = excl & 0xffff;
    const int need = k - (__builtin_amdgcn_readlane(incl, 63) >> 16);
    int slot = pgt + (peq < need ? peq : need), eqr = peq;
    int* IDX = WSP(int, WS_IDX); float* VALS = WSP(float, WS_VALS); int* SEL = WSP(int, WS_SEL);
#pragma unroll 1
    for (int j = 0; j < NJ; ++j) { const unsigned a = av[j * 64 + F.lane]; const bool gt = a > T, eq = a == T; const bool sl = gt || (eq && eqr < need); eqr += eq ? 1 : 0;
        const int src = srcrow0 + j * 64 + F.lane;
        if (sl) { IDX[yrow0 + slot] = src; VALS[yrow0 + slot] = __builtin_bit_cast(float, a); idx_lds[slot] = src; }
        SEL[(size_t)src * NE + e] = sl ? yrow0 + slot : -1;
        slot += sl ? 1 : 0; }
}
__device__ __forceinline__ void phase_topk(Frame& F, int l) {
    LAS int* idx_lds = (LAS int*)F.lds;
    const int ntask = l == 0 ? 256 : 128;
    for (int task = F.vcu; task < ntask; task += F.G) {
        const bool isctx = task >= 128; const int q = task & 127, b = q >> 4, e = q & 15;
        const int k = isctx ? CAPC : CAPL, yrow0 = isctx ? NE * NB * CAPL + e * (NB * CAPC) + b * CAPC : (e * NB + b) * CAPL;
        if (F.wave == 0) { if (isctx) topk_wave<4>(F, WSP(float, WS_AFFC) + (size_t)(b * NE + e) * CTXL, CAPC, ML + b * CTXL, yrow0, e, idx_lds, (LAS unsigned*)(F.lds + 4096));
                           else topk_wave<32>(F, WSP(float, WS_AFF) + (size_t)(b * NE + e) * SEQL, CAPL, b * SEQL, yrow0, e, idx_lds, (LAS unsigned*)(F.lds + 4096)); }
        LDS_WAIT(); __syncthreads();
        const bf16* H = WSP(bf16, WS_H); bf16* XS = WSP(bf16, WS_R1);
        for (int rr = F.wave; rr < k; rr += NWAVES) { const int src = idx_lds[rr]; const bf16* s = H + (size_t)src * DM + 8 * F.lane; bf16* dst = XS + (size_t)(yrow0 + rr) * DM + 8 * F.lane;
#pragma unroll
            for (int j = 0; j < 4; ++j) *(GAS v4u*)(dst + j * 512) = *(const GAS v4u*)(s + j * 512); }
        __syncthreads();
    }
}

template <class T> __device__ __forceinline__ T* opaque_ptr(T* p) { unsigned long long v = (unsigned long long)p; unsigned lo = (unsigned)v, hi = (unsigned)(v >> 32); asm volatile("" : "+v"(lo), "+v"(hi));
    lo = __builtin_amdgcn_readfirstlane(lo); hi = __builtin_amdgcn_readfirstlane(hi); return (T*)(((unsigned long long)hi << 32) | lo); }
__device__ __forceinline__ void launder(Frame& F) { F.ws = opaque_ptr(F.ws); F.out = opaque_ptr(F.out);
    int t = F.tid; asm volatile("" : "+v"(t)); F.tid = t; F.lane = t & 63; F.wave = __builtin_amdgcn_readfirstlane(t >> 6);
    int g = gridDim.x, bx = blockIdx.x; asm volatile("" : "+v"(g), "+v"(bx)); g = __builtin_amdgcn_readfirstlane(g); bx = __builtin_amdgcn_readfirstlane(bx);
    F.G = g; F.vcu = (g % 8 == 0) ? (bx % 8) * (g / 8) + bx / 8 : bx; }
__device__ __forceinline__ void grid_seam(Frame& F) {
    XcdBarrier b; b.bar = (unsigned*)(F.ws + WS_CTL) + CW_BAR; b.x = xb_xcc_id(); b.st = (volatile LAS unsigned*)(F.lds + MISC_OFF) + 8;
    xcd_barrier(b);
}
constexpr int NPHASE = 24;
struct Args { const float* in[27]; float* out; unsigned char* ws; };
#define IN(k) (LO <= (k) && (k) < HI)
#define PHASE(k) if constexpr (IN(k))
#define SEAM(k) do { if constexpr (IN(k) && IN((k) + 1)) grid_seam(F); } while (0)
template <int LO, int HI, int l>
__device__ __forceinline__ void layer_phases(Frame& F) {
    constexpr int pb = 1 + 11 * l;
    PHASE(pb + 0) { launder(F); phase_norm1(F, l); }
    SEAM(pb + 0);
    PHASE(pb + 1) {
        launder(F);
        SchedProj S{(const char*)WSP(bf16, WS_H), (const char*)(WSP(bf16, WS_WIN) + (size_t)l * DINP * DM), F.G, F.vcu, l};
        EpiProj E{WSP(bf16, WS_R1), WSP(bf16, WS_U2)};
        pg8::gemm_phase<EpiProj, SchedProj, true>(F.lds, F.tid, pg8::Dims{DM, DM, DM}, S, E);
    }
    SEAM(pb + 1);
    PHASE(pb + 2) {
        launder(F);
        if (F.vcu < F.G - 64) phase_conv(F, l, F.G - 64);
        else { SchedF S{(const char*)WSP(bf16, WS_U2), (const char*)(WSP(bf16, WS_WF) + (size_t)l * NG * 256 * 1024), F.G, F.vcu};
            EpiF32 E{WSP(float, WS_F), 256, (size_t)NINST * 256};
            pg8::gemm_phase<EpiF32, SchedF, false>(F.lds, F.tid, pg8::Dims{KS2, 1024, 1024}, S, E); }
    }
    SEAM(pb + 2);
    PHASE(pb + 3) { launder(F); phase_carry(F, l); }
    SEAM(pb + 3);
    PHASE(pb + 4) {
        launder(F);
        SchedS2 S{(const char*)WSP(bf16, WS_U2), (const char*)(WSP(bf16, WS_W2) + (size_t)l * NG * 1024 * KS2), F.G, F.vcu, l};
        EpiS2 E{WSP(bf16, WS_U2), F.in[I_SSMD] + (size_t)l * DSSM, WSP(bf16, WS_Z)};
        pg8::gemm_phase<EpiS2, SchedS2, true>(F.lds, F.tid, pg8::Dims{KS2, KS2, KS2}, S, E);
    }
    SEAM(pb + 4);
    PHASE(pb + 5) {
        launder(F);
        SchedGlu S{(const char*)WSP(bf16, WS_Z), (const char*)(WSP(bf16, WS_WGLU) + (size_t)l * DSSM * DSSM), F.G, F.vcu, l == 0 ? 72 : 64};
        EpiGlu E{WSP(bf16, WS_Z), F.in[I_ONSG] + (size_t)l * DSSM, WSP(bf16, WS_R2)};
        if (F.G >= 144) pg8::gemm_phase<EpiGlu, SchedGlu, false>(F.lds, F.tid, pg8::Dims{DSSM, DSSM, DSSM}, S, E);
    }
    SEAM(pb + 5);
    PHASE(pb + 6) {
        launder(F);
        SchedOut S{(const char*)WSP(bf16, WS_R2), (const char*)(WSP(bf16, WS_WOUT) + (size_t)l * DM * DM), F.G, F.vcu, l == 0 ? 72 : 64};
        EpiOut E{l == 0 ? F.in[I_X] : WSP(float, WS_XL), l == 0 ? F.in[I_CTX] : WSP(float, WS_XL) + (size_t)ML * DM, WSP(float, WS_MOD) + (size_t)l * 9 * 6 * DM, WSP(float, WS_XM)};
        pg8::gemm_phase<EpiOut, SchedOut, true>(F.lds, F.tid, pg8::Dims{DM, DM, DM}, S, E);
    }
    SEAM(pb + 6);
    PHASE(pb + 7) { launder(F); phase_norm2(F, l); }
    SEAM(pb + 7);
    PHASE(pb + 8) { launder(F); phase_topk(F, l); }
    SEAM(pb + 8);
    PHASE(pb + 9) {
        launder(F);
        SchedMoe S{(const char*)WSP(bf16, WS_R1), (const char*)(WSP(bf16, WS_WGU) + (size_t)l * NE * 4096 * DM), F.G, F.vcu, 16, l};
        EpiMoe1 E{WSP(bf16, WS_R2)};
        pg8::gemm_phase<EpiMoe1, SchedMoe, true>(F.lds, F.tid, pg8::Dims{DM, DM, DM}, S, E);
    }
    SEAM(pb + 9);
    PHASE(pb + 10) {
        launder(F);
        SchedMoe S{(const char*)WSP(bf16, WS_R2), (const char*)(WSP(bf16, WS_WDN) + (size_t)l * NE * DM * DF), F.G, F.vcu, 8, l};
        EpiBf16 E{WSP(bf16, WS_R1), DM};
        pg8::gemm_phase<EpiBf16, SchedMoe, true>(F.lds, F.tid, pg8::Dims{DF, DF, DF}, S, E);
    }
    SEAM(pb + 10);
}
template <int LO, int HI>
__global__ void __launch_bounds__(NWAVES * 64, 2) trunk_fwd(Args args) {
    extern __shared__ __attribute__((aligned(16))) unsigned char lds[];
    Frame F;
    F.lds = (LAS unsigned char*)lds;
    F.tid = threadIdx.x; F.lane = F.tid & 63; F.wave = __builtin_amdgcn_readfirstlane(F.tid >> 6);
    F.G = gridDim.x; { const int bx = blockIdx.x; F.vcu = (F.G % 8 == 0) ? (bx % 8) * (F.G / 8) + bx / 8 : bx; }
    F.ws = args.ws; F.out = args.out; F.in = args.in;
    for (int u = F.tid; u < (LDS_BYTES - LDSCTL_OFF) / 4; u += NWAVES * 64) ((LAS unsigned*)(F.lds + LDSCTL_OFF))[u] = 0u;
    __syncthreads();
    if constexpr (HI - LO > 1) (void)xcd_barrier_post((unsigned*)(F.ws + WS_CTL) + CW_BAR, (volatile LAS unsigned*)(F.lds + MISC_OFF) + 8);

    PHASE(0) {
        launder(F);
        if (F.vcu < 192) { for (int t = F.vcu; t < 192; t += 192) p0_mod_task(F, t); }
        else { for (int t = F.vcu - 192; t < 64; t += F.G - 192) p0_s5_task(F, t); }
        p0_router_t(F);
        p0_convert_weights(F);
    }
    SEAM(0);
    layer_phases<LO, HI, 0>(F);
    layer_phases<LO, HI, 1>(F);
    PHASE(23) { launder(F); phase_final(F); }
}
#undef IN
#undef PHASE
#undef SEAM

template <int P> static void launch_phase(int grid, hipStream_t stream, const Args& a) {
    hipLaunchKernelGGL((trunk_fwd<P, P + 1>), dim3(grid), dim3(NWAVES * 64), LDS_BYTES, stream, a);
}
template <int P> static void set_attr_phase() { (void)hipFuncSetAttribute((const void*)trunk_fwd<P, P + 1>, hipFuncAttributeMaxDynamicSharedMemorySize, LDS_BYTES); }
template <int... Ps> static void launch_all(std::integer_sequence<int, Ps...>, int grid, hipStream_t stream, const Args& a) { (launch_phase<Ps>(grid, stream, a), ...); }
template <int... Ps> static void set_attr_all(std::integer_sequence<int, Ps...>) { (set_attr_phase<Ps>(), ...); }
extern "C" void kernel_launch(void* const* d_in, const int* in_sizes, int n_in, void* d_out, int out_size, void* d_ws, size_t ws_size, hipStream_t stream) {
    static int grid = 0;
    if (grid == 0) {
        if (n_in != 27 || out_size != ML * DM || ws_size < WS_END) { fprintf(stderr, "kernel_launch: expected 27 inputs, %d outputs, >= %zu workspace bytes; got %d, %d, %zu\n", ML * DM, (size_t)WS_END, n_in, out_size, ws_size); grid = -1; return; }
        int dev = 0, cus = 0, per_cu = 0;
        if (hipGetDevice(&dev) != hipSuccess || hipDeviceGetAttribute(&cus, hipDeviceAttributeMultiprocessorCount, dev) != hipSuccess) { grid = -1; return; }
#if MK_N_LAUNCHES == 1
        if (hipFuncSetAttribute((const void*)trunk_fwd<0, NPHASE>, hipFuncAttributeMaxDynamicSharedMemorySize, LDS_BYTES) != hipSuccess) { fprintf(stderr, "kernel_launch: hipFuncSetAttribute failed\n"); grid = -1; return; }
        if (hipOccupancyMaxActiveBlocksPerMultiprocessor(&per_cu, (const void*)trunk_fwd<0, NPHASE>, NWAVES * 64, LDS_BYTES) != hipSuccess || per_cu < 1) fprintf(stderr, "kernel_launch: occupancy query reports %d\n", per_cu);
#else
        set_attr_all(std::make_integer_sequence<int, NPHASE>{});
#endif
        (void)hipGetLastError();
        grid = cus;
        if (grid < 256 || grid % 8 != 0) { fprintf(stderr, "kernel_launch: unexpected CU count %d\n", cus); }
    }
    if (grid < 0) return;
    (void)hipMemsetAsync((char*)d_ws + WS_CTL, 0, CTL_ZERO_BYTES, stream);
    Args a{};
    for (int i = 0; i < 27; ++i) a.in[i] = (const float*)d_in[i];
    a.out = (float*)d_out; a.ws = (unsigned char*)d_ws;
#if MK_N_LAUNCHES == 1
    hipLaunchKernelGGL((trunk_fwd<0, NPHASE>), dim3(grid), dim3(NWAVES * 64), LDS_BYTES, stream, a);
#else
    launch_all(std::make_integer_sequence<int, NPHASE>{}, grid, stream, a);
#endif
    const hipError_t le = hipPeekAtLastError();
    if (le != hipSuccess) fprintf(stderr, "kernel_launch: launch failed: %s\n", hipGetErrorName(le));
}
```

```cpp
#include <hip/hip_runtime.h>
#include <cstdio>
#include <cstdint>
#include <utility>

#define GAS __attribute__((address_space(1)))
#define LAS __attribute__((address_space(3)))
typedef unsigned short bf16;
typedef unsigned v4u __attribute__((ext_vector_type(4)));
typedef unsigned v2u __attribute__((ext_vector_type(2)));
typedef float f32x4 __attribute__((ext_vector_type(4)));
typedef float f32x2 __attribute__((ext_vector_type(2)));
typedef short bf16x8 __attribute__((ext_vector_type(8)));
typedef GAS unsigned gu32;

#ifndef MK_N_LAUNCHES
#define MK_N_LAUNCHES 1
#endif

constexpr int NB = 8, SEQL = 2048, CTXL = 256, DM = 2048;
constexpr int ML = NB * SEQL, MC = NB * CTXL, MT = ML + MC;
constexpr int DCONV = 1536, DSSM = 512, DINP = 3 * DCONV + DSSM;
constexpr int NG = 32, SG = 16, SP = 64, TCH = 64;
constexpr int NE = 16, DF = 2048, CAPL = 256, CAPC = 32;
constexpr int NINST = 512, KS2 = 1280;
constexpr int YROWS = NE * NB * CAPL + NE * NB * CAPC;
constexpr float EPS = 1e-6f;

constexpr size_t MiB = 1u << 20;
constexpr size_t WS_CTL = 0, CTL_ZERO_BYTES = 1 * MiB;
constexpr size_t WS_MOD = 1 * MiB;
constexpr size_t WS_RWT = 2 * MiB;
constexpr size_t WS_LT = 2 * MiB + 512 * 1024;
constexpr size_t WS_AFF = 3 * MiB;
constexpr size_t WS_AFFC = 4 * MiB;
constexpr size_t WS_IDX = 5 * MiB;
constexpr size_t WS_VALS = 5 * MiB + 256 * 1024;
constexpr size_t WS_SEL = 6 * MiB;
constexpr size_t WS_WGLU = 8 * MiB;
constexpr size_t WS_WOUT = 9 * MiB;
constexpr size_t WS_WIN = 25 * MiB;
constexpr size_t WS_WF = 65 * MiB;
constexpr size_t WS_W2 = 97 * MiB;
constexpr size_t WS_WGU = 257 * MiB;
constexpr size_t WS_WDN = 769 * MiB;
constexpr size_t WS_XL = 1025 * MiB;
constexpr size_t WS_XM = 1169 * MiB;
constexpr size_t WS_H = 1313 * MiB;
constexpr size_t WS_F = 1385 * MiB;
constexpr size_t WS_R1 = 1401 * MiB;
constexpr size_t WS_R2 = 1563 * MiB;
constexpr size_t WS_U2 = WS_R2 + 72 * MiB;
constexpr size_t WS_Z = WS_R2 + 112 * MiB;
constexpr size_t WS_END = 1707 * MiB;
constexpr int CW_BAR = 4096;

constexpr int RING_BYTES = 131072;
constexpr int LDSCTL_OFF = RING_BYTES, MISC_OFF = LDSCTL_OFF + 320;
constexpr int LDS_BYTES = 147456;
constexpr int NWAVES = 8;

#define LDS_WAIT() asm volatile("s_waitcnt lgkmcnt(0)" ::: "memory")
#define VM_WAIT() asm volatile("s_waitcnt vmcnt(0)" ::: "memory")
__device__ __forceinline__ unsigned f2bf(float f) { unsigned u = __builtin_bit_cast(unsigned, f); return (u + 0x7fffu + ((u >> 16) & 1u)) >> 16; }
__device__ __forceinline__ unsigned pk2(float lo, float hi) { return f2bf(lo) | (f2bf(hi) << 16); }
__device__ __forceinline__ float bflo(unsigned w) { return __builtin_bit_cast(float, w << 16); }
__device__ __forceinline__ float bfhi(unsigned w) { return __builtin_bit_cast(float, w & 0xffff0000u); }
__device__ __forceinline__ float wave_sum(float v) {
#pragma unroll
    for (int o = 1; o < 64; o <<= 1) v += __shfl_xor(v, o);
    return v;
}
__device__ __forceinline__ float sigmoidf_(float x) { return 1.0f / (1.0f + __expf(-x)); }
__device__ __forceinline__ float gelu_tanh(float y) { const float a = 1.5957691216f * (y + 0.044715f * y * y * y); return y * sigmoidf_(a); }

#ifndef FP8_SCALE1
#define FP8_SCALE1 0x7f7f7f7f
#endif
namespace pg8 {
constexpr int BM = 256, BK = 64, HALF = 128, HTB = HALF * BK * 2, STAGE_BYTES = 8 * HTB;
__host__ __device__ __forceinline__ int lds_byte(int r, int c) { const int st = (r >> 4) * 2 + (c >> 5), rr = r & 15, cc = c & 31, ob = rr * 64 + cc * 2; return st * 1024 + (ob ^ (((ob >> 9) & 1) << 5)); }
__host__ __device__ __forceinline__ void stage_rc(int b, int& R, int& C) { const int st = b / 1024, sb = b % 1024, swz = sb ^ (((sb >> 9) & 1) << 5); R = (st >> 1) * 16 + swz / 64; C = (st & 1) * 32 + (swz % 64) / 2; }
__host__ __device__ __forceinline__ int perm32(int rho) { const int n = rho >> 4, i = rho & 15; return 8 * (i >> 2) + 4 * n + (i & 3); }
__device__ __forceinline__ unsigned cvt_pk_bf16(float lo, float hi) { unsigned r; asm volatile("v_cvt_pk_bf16_f32 %0, %1, %2" : "=v"(r) : "v"(lo), "v"(hi)); return r; }

struct Unit { const char* a; const char* b; int pm, pn, aux; };
struct Dims { int lda, ldb, K; };
typedef int v4i_t __attribute__((ext_vector_type(4)));
typedef int v8i_t __attribute__((ext_vector_type(8)));
template <bool FP8> struct Frag { bf16x8 k[2]; };
template <> struct Frag<true> { v8i_t v; };

template <class Epi, class Sched, bool ALIGN_EPI, bool FP8 = false>
__device__ __forceinline__ void gemm_phase(LAS unsigned char* lds, const int tid, const Dims g, const Sched& S, const Epi& E) {
    const int wid = __builtin_amdgcn_readfirstlane(tid >> 6), lane = tid & 63, wr = wid >> 2, wc = wid & 3, fr = lane & 15, fq = lane >> 4;
    const int nt = g.K / (BK * 2);
    unsigned voffA[2], voffB[2];
#pragma unroll
    for (int i = 0; i < 2; ++i) { int R, C; stage_rc(tid * 16 + i * 8192, R, C); const int Rb = Epi::PERM ? ((R & ~31) + perm32(R & 31)) : R;
        voffA[i] = (unsigned)(R * g.lda + C * 2); voffB[i] = (unsigned)(Rb * g.ldb + C * 2); }
    const size_t kstep = (size_t)(BK * 2);
    const size_t hstepA = (size_t)HALF * g.lda, hstepB = (size_t)HALF * g.ldb;
    const unsigned ldsw = (unsigned)wid * 1024u;
    const int aoff = lds_byte(wr * 64 + fr, fq * 8), boff = lds_byte(wc * 32 + fr, fq * 8);
#define PG8_SA(b, h) (((b) * 2 + (h)) * HTB)
#define PG8_SB(b, h) ((4 + (b) * 2 + (h)) * HTB)
#define PG8_STAGE(bufoff, gbase, voff) do { _Pragma("unroll") for (int _i = 0; _i < 2; ++_i) \
        __builtin_amdgcn_global_load_lds((const unsigned*)((const char*)(gbase) + (voff)[_i]), (LAS unsigned*)(lds + (bufoff) + ldsw + _i * 8192), 16, 0, 0); } while (0)
#define PG8_LD1(dst, p) do { if constexpr (FP8) { const v4i_t lo_ = *(const LAS v4i_t*)(p), hi_ = *(const LAS v4i_t*)((p) + 1024); dst.v = __builtin_shufflevector(lo_, hi_, 0, 1, 2, 3, 4, 5, 6, 7); } \
        else { dst.k[0] = *(const LAS bf16x8*)(p); dst.k[1] = *(const LAS bf16x8*)((p) + 1024); } } while (0)
#define PG8_LDA(dst, b, h) do { _Pragma("unroll") for (int m = 0; m < 4; ++m) PG8_LD1(dst[m], lds + PG8_SA(b, h) + aoff + m * 2048); } while (0)
#define PG8_LDB(dst, b, h) do { _Pragma("unroll") for (int n = 0; n < 2; ++n) PG8_LD1(dst[n], lds + PG8_SB(b, h) + boff + n * 2048); } while (0)
#define PG8_MMA(ai, bj, At, Bt) do { __builtin_amdgcn_s_setprio(1); _Pragma("unroll") for (int m = 0; m < 4; ++m) _Pragma("unroll") for (int n = 0; n < 2; ++n) { \
        if constexpr (FP8) asm volatile("v_mfma_f32_16x16x128_f8f6f4 %0, %1, %2, %0" : "+v"(acc[ai][bj][m][n]) : "v"(Bt[n].v), "v"(At[m].v)); \
        else { _Pragma("unroll") for (int k = 0; k < 2; ++k) acc[ai][bj][m][n] = __builtin_amdgcn_mfma_f32_16x16x32_bf16(Bt[n].k[k], At[m].k[k], acc[ai][bj][m][n], 0, 0, 0); } } __builtin_amdgcn_s_setprio(0); } while (0)
#define PG8_WAIT_V(n) asm volatile("s_waitcnt vmcnt(" #n ")" ::: "memory")
#define PG8_WAIT_L(n) asm volatile("s_waitcnt lgkmcnt(" #n ")" ::: "memory")
#define PG8_BAR __builtin_amdgcn_s_barrier()
#define PG8_SCHED __builtin_amdgcn_sched_barrier(0)
    Unit cur, nxt; int ui = 0;
    if (!S.next(0, cur)) return;
    f32x4 acc[2][2][4][2];
#pragma unroll
    for (int a = 0; a < 2; ++a)
#pragma unroll
        for (int b = 0; b < 2; ++b)
#pragma unroll
            for (int m = 0; m < 4; ++m)
#pragma unroll
                for (int n = 0; n < 2; ++n) acc[a][b][m][n] = (f32x4){0.f, 0.f, 0.f, 0.f};
    Frag<FP8> At[4], B0[2], B1[2];
    const char* cA = cur.a; const char* cB = cur.b;
    PG8_STAGE(PG8_SB(0, 0), cB, voffB); PG8_STAGE(PG8_SB(0, 1), cB + hstepB, voffB); PG8_STAGE(PG8_SA(0, 0), cA, voffA); PG8_STAGE(PG8_SA(0, 1), cA + hstepA, voffA);
    if (wr == 1) PG8_BAR;
    PG8_WAIT_V(2); PG8_BAR;
    PG8_STAGE(PG8_SB(1, 0), cB + kstep, voffB); PG8_STAGE(PG8_SA(1, 0), cA + kstep, voffA); PG8_STAGE(PG8_SB(1, 1), cB + hstepB + kstep, voffB);
    PG8_WAIT_V(6); PG8_BAR;
    for (;;) {
        const bool has_next = S.next(ui + 1, nxt);
        const char* nA = has_next ? nxt.a : cA; const char* nB = has_next ? nxt.b : cB;
        for (int t = 0; t < nt; t += 2) {
            const bool last = (t == nt - 2);
            const char* a1 = cA + (size_t)(t + 1) * kstep;
            const char* a2 = last ? nA : cA + (size_t)(t + 2) * kstep; const char* b2 = last ? nB : cB + (size_t)(t + 2) * kstep;
            const char* a3 = a2 + kstep; const char* b3 = b2 + kstep;
            PG8_LDB(B0, 0, 0); PG8_LDB(B1, 0, 1); PG8_SCHED; PG8_LDA(At, 0, 0); PG8_STAGE(PG8_SA(1, 1), a1 + hstepA, voffA);
            PG8_WAIT_V(8); PG8_WAIT_L(0); PG8_BAR; PG8_MMA(0, 0, At, B0); PG8_MMA(0, 1, At, B1); PG8_BAR; PG8_SCHED;
            PG8_LDA(At, 0, 1); PG8_STAGE(PG8_SB(0, 0), b2, voffB); PG8_STAGE(PG8_SB(0, 1), b2 + hstepB, voffB); PG8_STAGE(PG8_SA(0, 0), a2, voffA);
            PG8_WAIT_V(8); PG8_WAIT_L(0); PG8_BAR; PG8_MMA(1, 0, At, B0); PG8_MMA(1, 1, At, B1); PG8_BAR; PG8_SCHED;
            PG8_LDB(B0, 1, 0); PG8_LDB(B1, 1, 1); PG8_SCHED; PG8_LDA(At, 1, 0); PG8_STAGE(PG8_SA(0, 1), a2 + hstepA, voffA);
            PG8_WAIT_V(8); PG8_WAIT_L(0); PG8_BAR; PG8_MMA(0, 0, At, B0); PG8_MMA(0, 1, At, B1); PG8_BAR; PG8_SCHED;
            PG8_LDA(At, 1, 1); PG8_STAGE(PG8_SB(1, 0), b3, voffB); PG8_STAGE(PG8_SB(1, 1), b3 + hstepB, voffB); PG8_STAGE(PG8_SA(1, 0), a3, voffA);
            PG8_WAIT_V(8); PG8_WAIT_L(0); PG8_BAR; PG8_MMA(1, 0, At, B0); PG8_MMA(1, 1, At, B1); PG8_BAR; PG8_SCHED;
        }
        if constexpr (FP8) asm volatile("s_nop 15\n\ts_nop 7" ::: "memory");
        if constexpr (ALIGN_EPI) { if (wr == 0) PG8_BAR; }
        if constexpr (!Epi::AFTER_DRAIN) { E(acc, cur, wr, wc, fr, fq); }
        if (!has_next) break;
#pragma unroll
        for (int a = 0; a < 2; ++a)
#pragma unroll
            for (int b = 0; b < 2; ++b)
#pragma unroll
                for (int m = 0; m < 4; ++m)
#pragma unroll
                    for (int n = 0; n < 2; ++n) acc[a][b][m][n] = (f32x4){0.f, 0.f, 0.f, 0.f};
        cur = nxt; cA = nA; cB = nB; ++ui;
        if constexpr (ALIGN_EPI) { if (wr == 1) PG8_BAR; }
    }
    PG8_WAIT_V(0);
    if constexpr (!ALIGN_EPI) { if (wr == 0) PG8_BAR; }
    PG8_BAR;
    if constexpr (Epi::AFTER_DRAIN) { E.fused(acc, cur, wr, wc, fr, fq, lds, wid, lane); }
#undef PG8_SA
#undef PG8_SB
#undef PG8_STAGE
#undef PG8_LDA
#undef PG8_LDB
#undef PG8_MMA
#undef PG8_LD1
#undef PG8_WAIT_V
#undef PG8_WAIT_L
#undef PG8_BAR
#undef PG8_SCHED
}
}

#define XB_TMO      128
#define XB_XCNT(j)  (256  + 64 * (j))
#define XB_XSUB(j)  (1280 + 64 * (j))
#define XB_XGEN(j)  (2304 + 64 * (j))
#define XB_TOP      3328
#define XB_TOPGEN   3392
#define XCD_BAR_WORDS 3456
#define XB_SPIN_CAP (1u << 18)

__device__ __forceinline__ unsigned xb_ld(unsigned* p)              { return __hip_atomic_load(p, __ATOMIC_RELAXED, __HIP_MEMORY_SCOPE_AGENT); }
__device__ __forceinline__ unsigned xb_add(unsigned* p, unsigned v) { return __hip_atomic_fetch_add(p, v, __ATOMIC_RELAXED, __HIP_MEMORY_SCOPE_AGENT); }
__device__ __forceinline__ unsigned xb_xcc_id() { return (unsigned)__builtin_amdgcn_s_getreg((3 << 11) | 20) & 0xFu; }
#define XB_SPIN(cond, bar) do { unsigned _sp = 0; while (cond) { __builtin_amdgcn_s_sleep(1); \
    if ((++_sp & 255u) == 0u) { if (xb_ld(&(bar)[XB_TMO])) break; if (_sp > XB_SPIN_CAP) { atomicAdd(&(bar)[XB_TMO], 1u); break; } } } } while (0)

struct XcdBarrier {
    unsigned* bar; unsigned x;
    volatile LAS unsigned* st;
};
__device__ __forceinline__ XcdBarrier xcd_barrier_post(unsigned* bar, volatile LAS unsigned* st) {
    XcdBarrier b; b.bar = bar; b.x = xb_xcc_id(); b.st = st;
    if (threadIdx.x == 0) (void)xb_add(&bar[XB_XCNT(b.x)], 1u);
    return b;
}
__device__ __forceinline__ void xcd_barrier_complete(unsigned* bar, unsigned x, unsigned& nloc, unsigned& nx) {
    const unsigned G = gridDim.x * gridDim.y * gridDim.z;
    unsigned sum, cnt, mine, sp = 0u;
    for (;;) {
        sum = 0u; cnt = 0u; mine = 0u;
#pragma unroll
        for (unsigned j = 0; j < 16; ++j) { const unsigned c = xb_ld(&bar[XB_XCNT(j)]); sum += c; cnt += (c > 0u) ? 1u : 0u; mine = (j == x) ? c : mine; }
        if (sum == G) break;
        __builtin_amdgcn_s_sleep(1);
        if ((++sp & 255u) == 0u) { if (xb_ld(&bar[XB_TMO])) break; if (sp > XB_SPIN_CAP) { atomicAdd(&bar[XB_TMO], 1u); break; } }
    }
    nloc = mine > 0u ? mine : 1u; nx = cnt > 0u ? cnt : 1u;
}
__device__ __forceinline__ void xcd_barrier(const XcdBarrier& b) {
    asm volatile("s_waitcnt vmcnt(0)" ::: "memory");
    __syncthreads();
    if (threadIdx.x == 0) {
        unsigned* bar = b.bar;
        __builtin_amdgcn_s_waitcnt(0);
        unsigned nloc = b.st[0], nx = b.st[1];
        if (nloc == 0u) { xcd_barrier_complete(bar, b.x, nloc, nx); b.st[0] = nloc; b.st[1] = nx; }
        const unsigned old = xb_add(&bar[XB_XSUB(b.x)], 1u);
        const unsigned gen = old / nloc;
        if (old + 1u == (gen + 1u) * nloc) {
            __builtin_amdgcn_fence(__ATOMIC_RELEASE, "agent");
            asm volatile("s_waitcnt vmcnt(0)" ::: "memory");
            const unsigned og = xb_add(&bar[XB_TOP], 1u);
            const unsigned tg = og / nx;
            if (og + 1u == (tg + 1u) * nx) xb_add(&bar[XB_TOPGEN], 1u);
            else XB_SPIN(xb_ld(&bar[XB_TOPGEN]) == tg, bar);
            __builtin_amdgcn_fence(__ATOMIC_ACQUIRE, "agent");
            xb_add(&bar[XB_XGEN(b.x)], 1u);
            asm volatile("s_waitcnt vmcnt(0)" ::: "memory");
        } else {
            XB_SPIN(xb_ld(&bar[XB_XGEN(b.x)]) == gen, bar);
            __builtin_amdgcn_fence(__ATOMIC_ACQUIRE, "agent");
            asm volatile("s_waitcnt vmcnt(0)" ::: "memory");
        }
    }
    __syncthreads();
}

struct Frame {
    LAS unsigned char* lds;
    int tid, lane, wave, vcu, G;
    unsigned char* ws;
    const float* const* in;
    float* out;
};
#define WSP(T, off) ((T*)(F.ws + (off)))
enum InIdx { I_X = 0, I_C, I_CTX, I_CCTX, I_ADAW, I_ADAB, I_N1G, I_WIN, I_CONVW, I_LRE, I_LIM, I_LDT, I_BRE, I_BIM, I_CRE, I_CIM, I_SSMD, I_WGLU, I_ONCG, I_ONSG, I_WOUT, I_N2G, I_RW, I_WG, I_WU, I_WD, I_FNG };

using pg8::Unit;
struct EpiProj {
    static constexpr bool PERM = true, AFTER_DRAIN = false;
    bf16* proj; bf16* u2;
    __device__ __forceinline__ void operator()(const f32x4 (&acc)[2][2][4][2], const Unit& u, int wr, int wc, int fr, int fq) const {
        const int row0 = u.pm * 256 + wr * 64 + fr, col0 = u.pn * 256 + wc * 32 + 8 * fq;
#pragma unroll
        for (int ai = 0; ai < 2; ++ai)
#pragma unroll
            for (int m = 0; m < 4; ++m) { const int row = row0 + ai * 128 + m * 16;
#pragma unroll
                for (int bj = 0; bj < 2; ++bj) { const f32x4 v0 = acc[ai][bj][m][0], v1 = acc[ai][bj][m][1]; const int col = col0 + bj * 128;
                    v4u w; w.x = pg8::cvt_pk_bf16(v0[0], v0[1]); w.y = pg8::cvt_pk_bf16(v0[2], v0[3]); w.z = pg8::cvt_pk_bf16(v1[0], v1[1]); w.w = pg8::cvt_pk_bf16(v1[2], v1[3]);
                    bf16* dst;
                    if (u.pn < 18) dst = proj + (size_t)row * (3 * DCONV) + col;
                    else { const int cc = col - 3 * DCONV, g = cc >> 4, i0 = cc & 15; dst = u2 + ((size_t)(g * NINST + (row >> 6)) * KS2 + (row & 63) * 16 + i0); }
                    *(GAS v4u*)dst = w; } }
    }
};
struct EpiF32 {
    static constexpr bool PERM = false, AFTER_DRAIN = false;
    float* C; int ldc; size_t cstride;
    __device__ __forceinline__ void operator()(const f32x4 (&acc)[2][2][4][2], const Unit& u, int wr, int wc, int fr, int fq) const {
        float* base = C + (size_t)u.aux * cstride; const int row0 = u.pm * 256 + wr * 64 + fr, col0 = u.pn * 256 + wc * 32 + 4 * fq;
#pragma unroll
        for (int ai = 0; ai < 2; ++ai)
#pragma unroll
            for (int m = 0; m < 4; ++m) { float* rowp = base + (size_t)(row0 + ai * 128 + m * 16) * ldc + col0;
#pragma unroll
                for (int bj = 0; bj < 2; ++bj)
#pragma unroll
                    for (int n = 0; n < 2; ++n) *(GAS f32x4*)(rowp + bj * 128 + n * 16) = acc[ai][bj][m][n]; }
    }
};
struct EpiS2 {
    static constexpr bool PERM = true, AFTER_DRAIN = false;
    const bf16* u2; const float* dsk; bf16* z;
    __device__ __forceinline__ void operator()(const f32x4 (&acc)[2][2][4][2], const Unit& u, int wr, int wc, int fr, int fq) const {
        const int g = u.aux, inst0 = u.pm * 256 + wr * 64 + fr, c0 = u.pn * 256 + wc * 32 + 8 * fq;
#pragma unroll
        for (int bj = 0; bj < 2; ++bj) { const int cidx = c0 + bj * 128, t = cidx >> 4, o0 = cidx & 15;
            const f32x4 d0 = *(const GAS f32x4*)(dsk + g * 16 + o0), d1 = *(const GAS f32x4*)(dsk + g * 16 + o0 + 4);
#pragma unroll
            for (int ai = 0; ai < 2; ++ai)
#pragma unroll
                for (int m = 0; m < 4; ++m) { const int inst = inst0 + ai * 128 + m * 16;
                    if (inst < MT / 64) {
                        const v4u uu = *(const GAS v4u*)(u2 + ((size_t)(g * NINST + inst) * KS2 + cidx));
                        const f32x4 a0 = acc[ai][bj][m][0], a1 = acc[ai][bj][m][1];
                        const float y0 = a0[0] + d0[0] * bflo(uu.x), y1 = a0[1] + d0[1] * bfhi(uu.x), y2 = a0[2] + d0[2] * bflo(uu.y), y3 = a0[3] + d0[3] * bfhi(uu.y);
                        const float y4 = a1[0] + d1[0] * bflo(uu.z), y5 = a1[1] + d1[1] * bfhi(uu.z), y6 = a1[2] + d1[2] * bflo(uu.w), y7 = a1[3] + d1[3] * bfhi(uu.w);
                        v4u w; w.x = pg8::cvt_pk_bf16(gelu_tanh(y0), gelu_tanh(y1)); w.y = pg8::cvt_pk_bf16(gelu_tanh(y2), gelu_tanh(y3));
                        w.z = pg8::cvt_pk_bf16(gelu_tanh(y4), gelu_tanh(y5)); w.w = pg8::cvt_pk_bf16(gelu_tanh(y6), gelu_tanh(y7));
                        *(GAS v4u*)(z + ((size_t)(inst * 64 + t) * DSSM + g * 16 + o0)) = w; } } }
    }
};
struct EpiGlu {
    static constexpr bool PERM = true, AFTER_DRAIN = true;
    const bf16* z; const float* gain; bf16* concat;
    __device__ __forceinline__ void operator()(const f32x4 (&)[2][2][4][2], const Unit&, int, int, int, int) const {}
    __device__ __forceinline__ void fused(f32x4 (&acc)[2][2][4][2], const Unit& u, int wr, int wc, int fr, int fq, LAS unsigned char* lds, int wid, int lane) const {
        LAS float* P = (LAS float*)lds;
        const int row0 = u.pm * 256 + wr * 64 + fr, col0 = u.pn * 256 + wc * 32 + 8 * fq;
#pragma unroll
        for (int ai = 0; ai < 2; ++ai)
#pragma unroll
            for (int m = 0; m < 4; ++m) { const int row = row0 + ai * 128 + m * 16, rt = ai * 128 + wr * 64 + m * 16 + fr;
#pragma unroll
                for (int bj = 0; bj < 2; ++bj) { const v4u zz = *(const GAS v4u*)(z + (size_t)row * DSSM + col0 + bj * 128);
                    f32x4 a0 = acc[ai][bj][m][0], a1 = acc[ai][bj][m][1];
                    a0[0] = bflo(zz.x) * sigmoidf_(a0[0]); a0[1] = bfhi(zz.x) * sigmoidf_(a0[1]); a0[2] = bflo(zz.y) * sigmoidf_(a0[2]); a0[3] = bfhi(zz.y) * sigmoidf_(a0[3]);
                    a1[0] = bflo(zz.z) * sigmoidf_(a1[0]); a1[1] = bfhi(zz.z) * sigmoidf_(a1[1]); a1[2] = bflo(zz.w) * sigmoidf_(a1[2]); a1[3] = bfhi(zz.w) * sigmoidf_(a1[3]);
                    acc[ai][bj][m][0] = a0; acc[ai][bj][m][1] = a1;
                    float s = (a0[0] * a0[0] + a0[1] * a0[1]) + (a0[2] * a0[2] + a0[3] * a0[3]) + (a1[0] * a1[0] + a1[1] * a1[1]) + (a1[2] * a1[2] + a1[3] * a1[3]);
                    s += __shfl_xor(s, 16); s += __shfl_xor(s, 32);
                    if (fq == 0) P[(rt * 2 + bj) * 4 + wc] = s; } }
        LDS_WAIT(); __builtin_amdgcn_s_barrier(); asm volatile("" ::: "memory");
#pragma unroll
        for (int bj = 0; bj < 2; ++bj) { const int col = col0 + bj * 128;
            const f32x4 g0 = *(const GAS f32x4*)(gain + col), g1 = *(const GAS f32x4*)(gain + col + 4);
#pragma unroll
            for (int ai = 0; ai < 2; ++ai)
#pragma unroll
                for (int m = 0; m < 4; ++m) { const int row = row0 + ai * 128 + m * 16, rt = ai * 128 + wr * 64 + m * 16 + fr;
                    const f32x4 p = *(const LAS f32x4*)(P + (rt * 2 + bj) * 4);
                    const float rs = 1.0f / sqrtf(((p[0] + p[1]) + (p[2] + p[3])) * (1.0f / 128.0f) + EPS);
                    const f32x4 a0 = acc[ai][bj][m][0] * rs * g0, a1 = acc[ai][bj][m][1] * rs * g1;
                    v4u w; w.x = pg8::cvt_pk_bf16(a0[0], a0[1]); w.y = pg8::cvt_pk_bf16(a0[2], a0[3]); w.z = pg8::cvt_pk_bf16(a1[0], a1[1]); w.w = pg8::cvt_pk_bf16(a1[2], a1[3]);
                    *(GAS v4u*)(concat + (size_t)row * DM + DCONV + col) = w; } }
    }
};
struct EpiOut {
    static constexpr bool PERM = false, AFTER_DRAIN = false;
    const float* xlat; const float* xctx; const float* mod; float* xm;
    __device__ __forceinline__ void operator()(const f32x4 (&acc)[2][2][4][2], const Unit& u, int wr, int wc, int fr, int fq) const {
        const int rb = u.pm < 64 ? (u.pm >> 3) : 8; const float* g1 = mod + (size_t)(rb * 6 + 2) * DM;
        const float* xp = u.pm < 64 ? xlat + (size_t)u.pm * 256 * DM : xctx + (size_t)(u.pm - 64) * 256 * DM;
        float* xo = xm + (size_t)u.pm * 256 * DM;
        const int r0 = wr * 64 + fr, col0 = u.pn * 256 + wc * 32 + 4 * fq;
        f32x4 gv[2][2];
#pragma unroll
        for (int bj = 0; bj < 2; ++bj)
#pragma unroll
            for (int n = 0; n < 2; ++n) gv[bj][n] = *(const GAS f32x4*)(g1 + col0 + bj * 128 + n * 16);
#pragma unroll
        for (int ai = 0; ai < 2; ++ai)
#pragma unroll
            for (int m = 0; m < 4; ++m) { const size_t off = (size_t)(r0 + ai * 128 + m * 16) * DM + col0;
#pragma unroll
                for (int bj = 0; bj < 2; ++bj)
#pragma unroll
                    for (int n = 0; n < 2; ++n) { const f32x4 xv = *(const GAS f32x4*)(xp + off + bj * 128 + n * 16);
                        *(GAS f32x4*)(xo + off + bj * 128 + n * 16) = xv + gv[bj][n] * acc[ai][bj][m][n]; }
                asm volatile("" ::: "memory"); }
    }
};
constexpr float FP8_SW = 64.f, FP8_SH = 16.f, FP8_SA = 8.f;
__device__ __forceinline__ unsigned pk4_fp8(float a, float b, float c, float d) {
    a = __builtin_amdgcn_fmed3f(a, -448.f, 448.f); b = __builtin_amdgcn_fmed3f(b, -448.f, 448.f); c = __builtin_amdgcn_fmed3f(c, -448.f, 448.f); d = __builtin_amdgcn_fmed3f(d, -448.f, 448.f);
    unsigned w = (unsigned)__builtin_amdgcn_cvt_pk_fp8_f32(a, b, 0, false); return (unsigned)__builtin_amdgcn_cvt_pk_fp8_f32(c, d, (int)w, true); }
struct EpiMoe1 {
    static constexpr bool PERM = true, AFTER_DRAIN = false;
    unsigned char* act;
    __device__ __forceinline__ void operator()(const f32x4 (&acc)[2][2][4][2], const Unit& u, int wr, int wc, int fr, int fq) const {
        const int row0 = u.pm * 256 + wr * 64 + fr, f0 = u.pn * 128 + wc * 32 + 8 * fq; constexpr float sg = 1.0f / (FP8_SW * FP8_SH);
#pragma unroll
        for (int ai = 0; ai < 2; ++ai)
#pragma unroll
            for (int m = 0; m < 4; ++m) { const f32x4 g0 = acc[ai][0][m][0] * sg, g1 = acc[ai][0][m][1] * sg, u0 = acc[ai][1][m][0] * (sg * FP8_SA), u1 = acc[ai][1][m][1] * (sg * FP8_SA);
                float r[8];
#pragma unroll
                for (int j = 0; j < 4; ++j) { r[j] = g0[j] * sigmoidf_(g0[j]) * u0[j]; r[4 + j] = g1[j] * sigmoidf_(g1[j]) * u1[j]; }
                v2u w; w.x = pk4_fp8(r[0], r[1], r[2], r[3]); w.y = pk4_fp8(r[4], r[5], r[6], r[7]);
                *(GAS v2u*)(act + (size_t)(row0 + ai * 128 + m * 16) * DF + f0) = w; }
    }
};
struct EpiBf16 {
    static constexpr bool PERM = true, AFTER_DRAIN = false;
    bf16* O; int ldc; float scale;
    __device__ __forceinline__ void operator()(const f32x4 (&acc)[2][2][4][2], const Unit& u, int wr, int wc, int fr, int fq) const {
        const int row0 = u.pm * 256 + wr * 64 + fr, col0 = u.pn * 256 + wc * 32 + 8 * fq;
#pragma unroll
        for (int ai = 0; ai < 2; ++ai)
#pragma unroll
            for (int m = 0; m < 4; ++m) { bf16* rowp = O + (size_t)(row0 + ai * 128 + m * 16) * ldc + col0;
#pragma unroll
                for (int bj = 0; bj < 2; ++bj) { const f32x4 v0 = acc[ai][bj][m][0] * scale, v1 = acc[ai][bj][m][1] * scale;
                    v4u w; w.x = pg8::cvt_pk_bf16(v0[0], v0[1]); w.y = pg8::cvt_pk_bf16(v0[2], v0[3]); w.z = pg8::cvt_pk_bf16(v1[0], v1[1]); w.w = pg8::cvt_pk_bf16(v1[2], v1[3]);
                    *(GAS v4u*)(rowp + bj * 128) = w; } }
    }
};

struct SchedProj {
    const char* A; const char* B; int G, c, layer;
    __device__ __forceinline__ bool next(int i, Unit& u) const {
        const int L = i * G + c; int rt, ct;
        if (layer == 0) { if (L >= 1440) return false; rt = (L / 160) * 8 + (L & 7); ct = (L % 160) >> 3; }
        else { if (L >= 1296) return false; if (L < 1280) { rt = (L / 160) * 8 + (L & 7); ct = (L % 160) >> 3; } else { const int j = L - 1280; rt = 64 + (j & 7); ct = 18 + (j >> 3); } }
        u.pm = rt; u.pn = ct; u.aux = 0; u.a = A + (size_t)rt * 256 * DM * 2; u.b = B + (size_t)ct * 256 * DM * 2; return true; }
};
struct SchedF {
    const char* A; const char* B; int G, c;
    __device__ __forceinline__ bool next(int i, Unit& u) const {
        const int j = c - (G - 64); if (i != 0 || j < 0) return false;
        const int g = j >> 1, rt = j & 1; u.pm = rt; u.pn = 0; u.aux = g; u.a = A + (size_t)(g * NINST + rt * 256) * KS2 * 2; u.b = B + (size_t)g * 256 * 1024 * 2; return true; }
};
struct SchedS2 {
    const char* A; const char* B; int G, c, layer;
    __device__ __forceinline__ bool next(int i, Unit& u) const {
        const int L = i * G + c; int g, rt, ct;
        if (layer == 0) { if (L >= 256) return false; g = L >> 3; rt = (L >> 2) & 1; ct = L & 3; } else { if (L >= 128) return false; g = L >> 2; rt = 0; ct = L & 3; }
        u.pm = rt; u.pn = ct; u.aux = g; u.a = A + (size_t)(g * NINST + rt * 256) * KS2 * 2; u.b = B + (size_t)(g * 1024 + ct * 256) * KS2 * 2; return true; }
};
struct SchedGlu {
    const char* A; const char* B; int G, c, nrt;
    __device__ __forceinline__ bool next(int i, Unit& u) const {
        const int L = i * G + c; if (L >= nrt * 2) return false;
        u.pm = L >> 1; u.pn = L & 1; u.aux = 0; u.a = A + (size_t)u.pm * 256 * DSSM * 2; u.b = B + (size_t)u.pn * 256 * DSSM * 2; return true; }
};
struct SchedOut {
    const char* A; const char* B; int G, c, nrt;
    __device__ __forceinline__ bool next(int i, Unit& u) const {
        const int L = i * G + c; if (L >= nrt * 8) return false;
        u.pm = (L >> 6) * 8 + (L & 7); u.pn = (L & 63) >> 3; u.aux = 0; u.a = A + (size_t)u.pm * 256 * DM * 2; u.b = B + (size_t)u.pn * 256 * DM * 2; return true; }
};
struct SchedMoe {
    const char* A; const char* B; int G, c, nct, layer;
    __device__ __forceinline__ bool next(int i, Unit& u) const {
        const int L = i * G + c, per = 8 * nct, nlat = NE * per; int e, rtile, ct;
        if (L < nlat) { e = L / per; const int w = L % per; ct = (w >> 5) * 4 + (w & 3); rtile = e * 8 + ((w & 31) >> 2); }
        else { const int j = L - nlat; if (layer != 0 || j >= NE * nct) return false; e = j / nct; ct = j % nct; rtile = NE * 8 + e; }
        u.pm = rtile; u.pn = ct; u.aux = e; u.a = A + (size_t)rtile * 256 * 2048; u.b = B + ((size_t)e * nct + ct) * 256 * 2048; return true; }
};

__device__ __forceinline__ void p0_transpose_item(const float* W, int N, bf16* WT, int ldwt, int orow0, int k0, int n0, LAS float* scr, int lane) {
    float tmp[32];
    const float* src = W + (size_t)(k0 + (lane >> 5)) * N + n0 + (lane & 31);
#pragma unroll
    for (int i = 0; i < 32; ++i) tmp[i] = *(const GAS float*)(src + (size_t)(2 * i) * N);
#pragma unroll
    for (int i = 0; i < 32; ++i) scr[(2 * i + (lane >> 5)) * 33 + (lane & 31)] = tmp[i];
    LDS_WAIT(); asm volatile("" ::: "memory");
    const int c = lane & 7;
#pragma unroll
    for (int j = 0; j < 4; ++j) { const int n = (lane >> 3) + 8 * j; const LAS float* s = scr + (8 * c) * 33 + n;
        v4u o; o.x = pk2(s[0 * 33], s[1 * 33]); o.y = pk2(s[2 * 33], s[3 * 33]); o.z = pk2(s[4 * 33], s[5 * 33]); o.w = pk2(s[6 * 33], s[7 * 33]);
        *(GAS v4u*)(WT + (size_t)(orow0 + n) * ldwt + k0 + 8 * c) = o; }
    LDS_WAIT(); asm volatile("" ::: "memory");
}
__device__ __forceinline__ void p0_transpose_item_fp8(const float* W, int N, unsigned char* WT, int ldwt, int orow0, int k0, int n0, LAS float* scr, int lane) {
    float tmp[32];
    const float* src = W + (size_t)(k0 + (lane >> 5)) * N + n0 + (lane & 31);
#pragma unroll
    for (int i = 0; i < 32; ++i) tmp[i] = *(const GAS float*)(src + (size_t)(2 * i) * N);
#pragma unroll
    for (int i = 0; i < 32; ++i) scr[(2 * i + (lane >> 5)) * 33 + (lane & 31)] = tmp[i] * FP8_SW;
    LDS_WAIT(); asm volatile("" ::: "memory");
    const int c = lane & 7;
#pragma unroll
    for (int j = 0; j < 4; ++j) { const int n = (lane >> 3) + 8 * j; const LAS float* s = scr + (8 * c) * 33 + n;
        v2u o; o.x = pk4_fp8(s[0 * 33], s[1 * 33], s[2 * 33], s[3 * 33]); o.y = pk4_fp8(s[4 * 33], s[5 * 33], s[6 * 33], s[7 * 33]);
        *(GAS v2u*)(WT + (size_t)(orow0 + n) * ldwt + k0 + 8 * c) = o; }
    LDS_WAIT(); asm volatile("" ::: "memory");
}
__device__ __forceinline__ void p0_convert_weights(Frame& F) {
    LAS float* scr = (LAS float*)(F.lds + F.wave * 16384);
    const long gw = (long)F.vcu * NWAVES + F.wave, NGW = (long)F.G * NWAVES;
    constexpr long I_EXP = 32 * 64;
    constexpr long N_GATE = 2L * NE * I_EXP, N_WIN = 2L * 32 * 160, N_WOUT = 2L * I_EXP, N_GLU = 2L * 8 * 16;
    constexpr long NITEMS = 3 * N_GATE + N_WIN + N_WOUT + N_GLU;
    for (long it = gw; it < NITEMS; it += NGW) {
        long r = it;
        if (r < 2 * N_GATE) {
            const int kind = r >= N_GATE; if (kind) r -= N_GATE;
            const int le = (int)(r / I_EXP), q = (int)(r % I_EXP), kb = q >> 6, nb = q & 63, n0 = nb * 32;
            const float* W = F.in[kind ? I_WU : I_WG] + (size_t)le * DM * DF;
            unsigned char* WT = WSP(unsigned char, WS_WGU) + (size_t)le * 4096 * DM;
            p0_transpose_item_fp8(W, DF, WT, DM, (n0 >> 7) * 256 + kind * 128 + (n0 & 127), kb * 64, n0, scr, F.lane); continue; }
        r -= 2 * N_GATE;
        if (r < N_GATE) { const int le = (int)(r / I_EXP), q = (int)(r % I_EXP), kb = q >> 6, nb = q & 63;
            p0_transpose_item_fp8(F.in[I_WD] + (size_t)le * DF * DM, DM, WSP(unsigned char, WS_WDN) + (size_t)le * DM * DF, DF, nb * 32, kb * 64, nb * 32, scr, F.lane); continue; }
        r -= N_GATE;
        if (r < N_WIN) { const int l = (int)(r / (32 * 160)), q = (int)(r % (32 * 160)), kb = q / 160, nb = q % 160;
            p0_transpose_item(F.in[I_WIN] + (size_t)l * DM * DINP, DINP, WSP(bf16, WS_WIN) + (size_t)l * DINP * DM, DM, nb * 32, kb * 64, nb * 32, scr, F.lane); continue; }
        r -= N_WIN;
        if (r < N_WOUT) { const int l = (int)(r / I_EXP), q = (int)(r % I_EXP), kb = q >> 6, nb = q & 63;
            p0_transpose_item(F.in[I_WOUT] + (size_t)l * DM * DM, DM, WSP(bf16, WS_WOUT) + (size_t)l * DM * DM, DM, nb * 32, kb * 64, nb * 32, scr, F.lane); continue; }
        r -= N_WOUT;
        { const int l = (int)(r / 128), q = (int)(r % 128), kb = q >> 4, nb = q & 15;
            p0_transpose_item(F.in[I_WGLU] + (size_t)l * DSSM * DSSM, DSSM, WSP(bf16, WS_WGLU) + (size_t)l * DSSM * DSSM, DSSM, nb * 32, kb * 64, nb * 32, scr, F.lane); }
    }    __syncthreads();
}
__device__ __forceinline__ void p0_mod_task(Frame& F, int task) {
    const int l = task / 96, n0 = (task % 96) * 128;
    LAS float* sc = (LAS float*)F.lds;
    LAS float* red = (LAS float*)(F.lds + 9 * 2048 * 4);
    for (int i = F.tid; i < 9 * DM; i += 512) { const int r = i >> 11, k = i & 2047; const float v = r < 8 ? F.in[I_C][r * DM + k] : F.in[I_CCTX][k]; sc[i] = v * sigmoidf_(v); }
    __syncthreads();
    const float* W = F.in[I_ADAW] + (size_t)l * DM * 6 * DM + n0 + 2 * F.lane;
    float acc[9][2];
#pragma unroll
    for (int r = 0; r < 9; ++r) { acc[r][0] = 0.f; acc[r][1] = 0.f; }
    const int kbase = F.wave * 256;
#pragma unroll 4
    for (int kk = 0; kk < 256; ++kk) { const int k = kbase + kk; const f32x2 w = *(const GAS f32x2*)(W + (size_t)k * (6 * DM));
#pragma unroll
        for (int r = 0; r < 9; ++r) { const float s = sc[r * DM + k]; acc[r][0] += s * w.x; acc[r][1] += s * w.y; } }
#pragma unroll
    for (int r = 0; r < 9; ++r) { red[(F.wave * 9 + r) * 128 + 2 * F.lane] = acc[r][0]; red[(F.wave * 9 + r) * 128 + 2 * F.lane + 1] = acc[r][1]; }
    __syncthreads();
    float* mod = WSP(float, WS_MOD) + (size_t)l * 9 * 6 * DM;
    for (int i = F.tid; i < 9 * 128; i += 512) { const int r = i >> 7, n = i & 127; float s = F.in[I_ADAB][(size_t)l * 6 * DM + n0 + n];
#pragma unroll
        for (int w = 0; w < 8; ++w) s += red[(w * 9 + r) * 128 + n];
        mod[(size_t)r * 6 * DM + n0 + n] = s; }
    __syncthreads();
}
__device__ __forceinline__ void p0_s5_task(Frame& F, int task) {
    const int l = task >> 5, g = task & 31;
    LAS f32x2* PW = (LAS f32x2*)F.lds;
    LAS f32x2* BB = (LAS f32x2*)(F.lds + 33280);
    LAS f32x2* CC = (LAS f32x2*)(F.lds + 41472);
    LAS float* KD = (LAS float*)(F.lds + 49664);
    LAS bf16* KT = (LAS bf16*)(F.lds + 50688);
    bf16* WF = WSP(bf16, WS_WF) + (size_t)(l * NG + g) * 256 * 1024;
    bf16* W2 = WSP(bf16, WS_W2) + (size_t)(l * NG + g) * 1024 * KS2;
    for (int d = 0; d < 2; ++d) {
        const int ldg = (l * 2 + d) * NG + g;
        if (F.tid < 64) { const int p = F.tid;
            const double lr = (double)F.in[I_LRE][ldg * SP + p], li = (double)F.in[I_LIM][ldg * SP + p], dt = exp((double)F.in[I_LDT][ldg]);
            const double mag = exp(lr * dt), ar = mag * cos(li * dt), ai = mag * sin(li * dt), den = lr * lr + li * li, nr = ar - 1.0;
            const double kr = (nr * lr + ai * li) / den, ki = (ai * lr - nr * li) / den;
            double pr = 1.0, pi = 0.0;
            for (int e = 0; e <= 64; ++e) { PW[e * 64 + p] = (f32x2){(float)pr, (float)pi}; const double t = pr * ar - pi * ai; pi = pr * ai + pi * ar; pr = t; }
            if (true) { const f32x2 lt = PW[64 * 64 + p]; WSP(f32x2, WS_LT)[((l * NG + g) * 2 + d) * 64 + p] = lt; }
            for (int i = 0; i < SG; ++i) { const double br = (double)F.in[I_BRE][((size_t)ldg * SP + p) * SG + i], bi = (double)F.in[I_BIM][((size_t)ldg * SP + p) * SG + i];
                BB[p * 16 + i] = (f32x2){(float)(kr * br - ki * bi), (float)(kr * bi + ki * br)}; } }
        for (int i = F.tid; i < 1024; i += 512) CC[i] = (f32x2){F.in[I_CRE][(size_t)ldg * 1024 + i], F.in[I_CIM][(size_t)ldg * 1024 + i]};
        __syncthreads();
        { const int ph = F.tid & 1, q = F.tid >> 1, o = q >> 4, i = q & 15;
            float cbr[32], cbi[32];
#pragma unroll
            for (int p = 0; p < 32; ++p) { const f32x2 c = CC[o * 64 + ph * 32 + p], b = BB[(ph * 32 + p) * 16 + i]; cbr[p] = c.x * b.x - c.y * b.y; cbi[p] = c.x * b.y + c.y * b.x; }
#pragma unroll 1
            for (int j = 0; j < 64; ++j) { float s = 0.f;
#pragma unroll
                for (int p = 0; p < 32; ++p) { const f32x2 P = PW[j * 64 + ph * 32 + p]; s += cbr[p] * P.x - cbi[p] * P.y; }
                s += __shfl_xor(s, 1);
                if (ph == 0) { if (j == 0) { if (d == 0) KD[q] = s; else { s += KD[q]; KT[q] = (bf16)f2bf(s); } }
                               else KT[(d * 64 + j) * 256 + q] = (bf16)f2bf(s); } } }
        for (int it = F.tid; it < 128 * 128; it += 512) { const int n = it >> 7, k8 = it & 127, ri = n >> 6, p = n & 63, s = k8 >> 1, i0 = (k8 & 1) * 8, e = d == 0 ? 63 - s : s;
            const f32x2 P = PW[e * 64 + p]; float v[8];
#pragma unroll
            for (int j = 0; j < 8; ++j) { const f32x2 b = BB[p * 16 + i0 + j]; v[j] = ri == 0 ? (P.x * b.x - P.y * b.y) : (P.x * b.y + P.y * b.x); }
            v4u o; o.x = pk2(v[0], v[1]); o.y = pk2(v[2], v[3]); o.z = pk2(v[4], v[5]); o.w = pk2(v[6], v[7]);
            *(GAS v4u*)(WF + (size_t)(d * 128 + n) * 1024 + k8 * 8) = o; }
        for (int it = F.tid; it < 1024 * 16; it += 512) { const int n = it >> 4, c8 = it & 15, ri = c8 >> 3, p0 = (c8 & 7) * 8, t = n >> 4, o = n & 15, e = d == 0 ? t + 1 : 64 - t; float v[8];
#pragma unroll
            for (int j = 0; j < 8; ++j) { const f32x2 c = CC[o * 64 + p0 + j], P = PW[e * 64 + p0 + j]; v[j] = ri == 0 ? (c.x * P.x - c.y * P.y) : -(c.x * P.y + c.y * P.x); }
            v4u ov; ov.x = pk2(v[0], v[1]); ov.y = pk2(v[2], v[3]); ov.z = pk2(v[4], v[5]); ov.w = pk2(v[6], v[7]);
            *(GAS v4u*)(W2 + (size_t)n * KS2 + 1024 + d * 128 + c8 * 8) = ov; }
        __syncthreads();
    }
    for (int it = F.tid; it < 1024 * 128; it += 512) { const int n = it >> 7, k8 = it & 127, t = n >> 4, o = n & 15, s = k8 >> 1, i0 = (k8 & 1) * 8;
        const int dsel = s <= t ? 0 : 1, j = s <= t ? t - s : s - t;
        const v4u kv = *(const LAS v4u*)(KT + (dsel * 64 + j) * 256 + o * 16 + i0);
        *(GAS v4u*)(W2 + (size_t)n * KS2 + k8 * 8) = kv; }
    __syncthreads();
}
__device__ __forceinline__ void p0_router_t(Frame& F) {
    for (int i = (F.vcu * 512 + F.tid); i < 2 * 16 * DM; i += F.G * 512) { const int l = i >> 15, e = (i >> 11) & 15, k = i & 2047; WSP(float, WS_RWT)[i] = F.in[I_RW][((size_t)l * DM + k) * NE + e]; }
}

__device__ __forceinline__ int mbcnt64(unsigned long long m) { return (int)__builtin_amdgcn_mbcnt_hi((unsigned)(m >> 32), __builtin_amdgcn_mbcnt_lo((unsigned)m, 0u)); }
__device__ __forceinline__ void combine_row(Frame& F, int r, const float* g2, f32x4 (&x)[8]) {
    const int* sel = WSP(int, WS_SEL) + (size_t)r * NE; const float* vals = WSP(float, WS_VALS); const bf16* Y = WSP(bf16, WS_R1);
    const int mysel = F.lane < NE ? *(const GAS int*)(sel + F.lane) : -1;
    unsigned long long m = __ballot(mysel >= 0);
    f32x4 macc[8];
#pragma unroll
    for (int j = 0; j < 8; ++j) macc[j] = (f32x4){0.f, 0.f, 0.f, 0.f};
    while (m) { const int e = __builtin_ctzll(m); m &= m - 1;
        const int y = __builtin_amdgcn_readlane(mysel, e); const float val = *(const GAS float*)(vals + y); const bf16* yr = Y + (size_t)y * DM + 4 * F.lane;
#pragma unroll
        for (int j = 0; j < 8; ++j) { const v2u w = *(const GAS v2u*)(yr + j * 256); macc[j] += val * (f32x4){bflo(w.x), bfhi(w.x), bflo(w.y), bfhi(w.y)}; } }
#pragma unroll
    for (int j = 0; j < 8; ++j) x[j] += *(const GAS f32x4*)(g2 + j * 256 + 4 * F.lane) * macc[j];
}
__device__ __forceinline__ float row_rs(const f32x4 (&x)[8]) {
    float s = 0.f;
#pragma unroll
    for (int j = 0; j < 8; ++j) s += (x[j][0] * x[j][0] + x[j][1] * x[j][1]) + (x[j][2] * x[j][2] + x[j][3] * x[j][3]);
    return 1.0f / sqrtf(wave_sum(s) * (1.0f / DM) + EPS);
}
__device__ __forceinline__ void phase_norm1(Frame& F, int l) {
    const float* modl = WSP(float, WS_MOD) + (size_t)l * 9 * 6 * DM; const float* gn = F.in[I_N1G] + (size_t)l * DM;
    for (int r = F.vcu * NWAVES + F.wave; r < MT; r += F.G * NWAVES) {
        const int rb = r < ML ? (r >> 11) : 8;
        const float* xr = l == 0 ? (r < ML ? F.in[I_X] + (size_t)r * DM : F.in[I_CTX] + (size_t)(r - ML) * DM) : WSP(float, WS_XM) + (size_t)r * DM;
        f32x4 x[8];
#pragma unroll
        for (int j = 0; j < 8; ++j) x[j] = *(const GAS f32x4*)(xr + j * 256 + 4 * F.lane);
        if (l == 1) { combine_row(F, r, WSP(float, WS_MOD) + (size_t)(rb * 6 + 5) * DM, x);
            float* xo = WSP(float, WS_XL) + (size_t)r * DM;
#pragma unroll
            for (int j = 0; j < 8; ++j) *(GAS f32x4*)(xo + j * 256 + 4 * F.lane) = x[j]; }
        const float rs = row_rs(x); const float* sh = modl + (size_t)(rb * 6 + 0) * DM; const float* sc = modl + (size_t)(rb * 6 + 1) * DM;
        bf16* ho = WSP(bf16, WS_H) + (size_t)r * DM;
#pragma unroll
        for (int j = 0; j < 8; ++j) { const int c = j * 256 + 4 * F.lane; const f32x4 g = *(const GAS f32x4*)(gn + c), s1 = *(const GAS f32x4*)(sc + c), s0 = *(const GAS f32x4*)(sh + c);
            const f32x4 h = x[j] * rs * g * (1.0f + s1) + s0; v2u w; w.x = pk2(h[0], h[1]); w.y = pk2(h[2], h[3]); *(GAS v2u*)(ho + c) = w; }
    }
}
__device__ __forceinline__ void phase_final(Frame& F) {
    const float* gn = F.in[I_FNG];
    for (int r = F.vcu * NWAVES + F.wave; r < ML; r += F.G * NWAVES) {
        const int rb = r >> 11; const float* xr = WSP(float, WS_XM) + (size_t)r * DM;
        f32x4 x[8];
#pragma unroll
        for (int j = 0; j < 8; ++j) x[j] = *(const GAS f32x4*)(xr + j * 256 + 4 * F.lane);
        combine_row(F, r, WSP(float, WS_MOD) + (size_t)((9 + rb) * 6 + 5) * DM, x);
        const float rs = row_rs(x); float* o = F.out + (size_t)r * DM;
#pragma unroll
        for (int j = 0; j < 8; ++j) { const int c = j * 256 + 4 * F.lane; *(GAS f32x4*)(o + c) = x[j] * rs * *(const GAS f32x4*)(gn + c); }
    }
}
__device__ __forceinline__ void phase_norm2(Frame& F, int l) {
    LAS float* rwt = (LAS float*)F.lds;
    { const float* src = WSP(float, WS_RWT) + (size_t)l * NE * DM;
        for (int i = F.tid; i < NE * DM / 4; i += 512) *(LAS f32x4*)(rwt + 4 * i) = *(const GAS f32x4*)(src + 4 * i); }
    __syncthreads();
    const float* modl = WSP(float, WS_MOD) + (size_t)l * 9 * 6 * DM; const float* gn = F.in[I_N2G] + (size_t)l * DM;
    const int nrows = l == 0 ? MT : ML;
    for (int r = F.vcu * NWAVES + F.wave; r < nrows; r += F.G * NWAVES) {
        const int rb = r < ML ? (r >> 11) : 8; const float* xr = WSP(float, WS_XM) + (size_t)r * DM;
        f32x4 x[8];
#pragma unroll
        for (int j = 0; j < 8; ++j) x[j] = *(const GAS f32x4*)(xr + j * 256 + 4 * F.lane);
        const float rs = row_rs(x); const float* sh = modl + (size_t)(rb * 6 + 3) * DM; const float* sc = modl + (size_t)(rb * 6 + 4) * DM;
        unsigned char* ho = WSP(unsigned char, WS_H) + (size_t)r * DM;
#pragma unroll
        for (int j = 0; j < 8; ++j) { const int c = j * 256 + 4 * F.lane; const f32x4 g = *(const GAS f32x4*)(gn + c), s1 = *(const GAS f32x4*)(sc + c), s0 = *(const GAS f32x4*)(sh + c);
            x[j] = x[j] * rs * g * (1.0f + s1) + s0; *(GAS unsigned*)(ho + c) = pk4_fp8(x[j][0] * FP8_SH, x[j][1] * FP8_SH, x[j][2] * FP8_SH, x[j][3] * FP8_SH); }
        float mine = -1e30f;
#pragma unroll 1
        for (int e = 0; e < NE; ++e) { float s = 0.f;
#pragma unroll
            for (int j = 0; j < 8; ++j) { const f32x4 w = *(const LAS f32x4*)(rwt + e * DM + j * 256 + 4 * F.lane); s += (x[j][0] * w[0] + x[j][1] * w[1]) + (x[j][2] * w[2] + x[j][3] * w[3]); }
            s = wave_sum(s); mine = (F.lane == e) ? s : mine; }
        float mx = mine;
        mx = fmaxf(mx, __shfl_xor(mx, 1)); mx = fmaxf(mx, __shfl_xor(mx, 2)); mx = fmaxf(mx, __shfl_xor(mx, 4)); mx = fmaxf(mx, __shfl_xor(mx, 8));
        const float ex = __expf(mine - mx); float den = ex;
        den += __shfl_xor(den, 1); den += __shfl_xor(den, 2); den += __shfl_xor(den, 4); den += __shfl_xor(den, 8);
        mine = ex / den;
        if (F.lane < NE) { if (r < ML) WSP(float, WS_AFF)[((size_t)(rb * NE + F.lane) << 11) + (r & 2047)] = mine;
                           else { const int q = r - ML; WSP(float, WS_AFFC)[((size_t)((q >> 8) * NE + F.lane) << 8) + (q & 255)] = mine; } }
    }
    __syncthreads();
}
__device__ __forceinline__ void phase_conv(Frame& F, int l, int nblk) {
    const bf16* P = WSP(bf16, WS_R1); bf16* cc = WSP(bf16, WS_R2);
    const float* cw = F.in[I_CONVW] + (size_t)l * 3 * DCONV; const float* gn = F.in[I_ONCG] + (size_t)l * DCONV;
    const int nrows = l == 0 ? MT : ML;
    for (int r = F.vcu * NWAVES + F.wave; r < nrows; r += nblk * NWAVES) {
        bool hp, hn; if (r < ML) { const int x = r & 63; hp = x > 0; hn = x < 63; } else { const int t = (r - ML) & 255; hp = t > 0; hn = t < 255; }
        const bf16* p0 = P + (size_t)r * (3 * DCONV);
#pragma unroll
        for (int ch = 0; ch < 3; ++ch) { const int c0 = ch * 512 + 8 * F.lane;
            const v4u bg = *(const GAS v4u*)(p0 + c0), cg = *(const GAS v4u*)(p0 + DCONV + c0), vv = *(const GAS v4u*)(p0 + 2 * DCONV + c0);
            v4u cgp = (v4u){0u, 0u, 0u, 0u}, vp = cgp, cgn = cgp, vn = cgp;
            if (hp) { cgp = *(const GAS v4u*)(p0 - 3 * DCONV + DCONV + c0); vp = *(const GAS v4u*)(p0 - 3 * DCONV + 2 * DCONV + c0); }
            if (hn) { cgn = *(const GAS v4u*)(p0 + 3 * DCONV + DCONV + c0); vn = *(const GAS v4u*)(p0 + 3 * DCONV + 2 * DCONV + c0); }
            float y[8]; float ss = 0.f;
#pragma unroll
            for (int q = 0; q < 4; ++q) {
                const unsigned b_ = bg[q], c_ = cg[q], v_ = vv[q], cp_ = cgp[q], vp_ = vp[q], cn_ = cgn[q], vn_ = vn[q];
                const f32x2 w0 = *(const GAS f32x2*)(cw + c0 + 2 * q), w1 = *(const GAS f32x2*)(cw + DCONV + c0 + 2 * q), w2 = *(const GAS f32x2*)(cw + 2 * DCONV + c0 + 2 * q);
                y[2 * q] = bflo(b_) * (w0.x * (bflo(cp_) * bflo(vp_)) + w1.x * (bflo(c_) * bflo(v_)) + w2.x * (bflo(cn_) * bflo(vn_)));
                y[2 * q + 1] = bfhi(b_) * (w0.y * (bfhi(cp_) * bfhi(vp_)) + w1.y * (bfhi(c_) * bfhi(v_)) + w2.y * (bfhi(cn_) * bfhi(vn_)));
                ss += y[2 * q] * y[2 * q] + y[2 * q + 1] * y[2 * q + 1]; }
            ss += __shfl_xor(ss, 1); ss += __shfl_xor(ss, 2); ss += __shfl_xor(ss, 4); ss += __shfl_xor(ss, 8);
            const float rs = 1.0f / sqrtf(ss * (1.0f / 128.0f) + EPS);
            const f32x4 g0 = *(const GAS f32x4*)(gn + c0), g1 = *(const GAS f32x4*)(gn + c0 + 4);
            v4u o; o.x = pk2(y[0] * rs * g0[0], y[1] * rs * g0[1]); o.y = pk2(y[2] * rs * g0[2], y[3] * rs * g0[3]); o.z = pk2(y[4] * rs * g1[0], y[5] * rs * g1[1]); o.w = pk2(y[6] * rs * g1[2], y[7] * rs * g1[3]);
            *(GAS v4u*)(cc + (size_t)r * DM + c0) = o; }
    }
}
__device__ __forceinline__ void phase_carry(Frame& F, int l) {
    const int gt = F.vcu * 512 + F.tid; if (gt >= NB * NG * 2 * SP) return;
    const int p = gt & 63, d = (gt >> 6) & 1, g = (gt >> 7) & 31, b = gt >> 12;
    const f32x2 lt = WSP(f32x2, WS_LT)[((l * NG + g) * 2 + d) * 64 + p];
    const float* Fb = WSP(float, WS_F); bf16* u2 = WSP(bf16, WS_U2);
    float hr = 0.f, hi = 0.f;
    for (int step = 0; step < 36; ++step) {
        int inst; if (step < 4) inst = 256 + b * 4 + (d == 0 ? step : 3 - step); else inst = b * 32 + (d == 0 ? step - 4 : 35 - step);
        const size_t row = (size_t)g * NINST + inst;
        u2[row * KS2 + 1024 + d * 128 + p] = (bf16)f2bf(hr); u2[row * KS2 + 1024 + d * 128 + 64 + p] = (bf16)f2bf(hi);
        const float fr = *(const GAS float*)(Fb + row * 256 + d * 128 + p), fi = *(const GAS float*)(Fb + row * 256 + d * 128 + 64 + p);
        const float nr = lt.x * hr - lt.y * hi + fr; hi = lt.x * hi + lt.y * hr + fi; hr = nr; }
}
template <int NJ>
__device__ __forceinline__ void topk_wave(Frame& F, const float* aff, int k, int srcrow0, int yrow0, int e, LAS int* idx_lds, LAS unsigned* av) {
#pragma unroll 1
    for (int j = 0; j < NJ; ++j) av[j * 64 + F.lane] = __builtin_bit_cast(unsigned, *(const GAS float*)(aff + j * 64 + F.lane));
    LDS_WAIT();
    unsigned T = 0u;
#pragma unroll 1
    for (int bit = 30; bit >= 0; --bit) { const unsigned cand = T | (1u << bit); int cnt = 0;
#pragma unroll 2
        for (int j = 0; j < NJ; ++j) cnt += (av[j * 64 + F.lane] >= cand) ? 1 : 0;
#pragma unroll
        for (int o = 1; o < 64; o <<= 1) cnt += __shfl_xor(cnt, o);
        if (cnt >= k) T = cand; }
    int ngt = 0, neq = 0;
#pragma unroll 2
    for (int j = 0; j < NJ; ++j) { const unsigned a = av[j * 64 + F.lane]; ngt += (a > T) ? 1 : 0; neq += (a == T) ? 1 : 0; }
    const int packed = (ngt << 16) | neq; int incl = packed;
#pragma unroll
    for (int o = 1; o < 64; o <<= 1) { const int t = __shfl_up(incl, o); incl += (F.lane >= o) ? t : 0; }
    const int excl = incl - packed, pgt = excl >> 16, peq = excl & 0xffff;
    const int need = k - (__builtin_amdgcn_readlane(incl, 63) >> 16);
    int slot = pgt + (peq < need ? peq : need), eqr = peq;
    int* IDX = WSP(int, WS_IDX); float* VALS = WSP(float, WS_VALS); int* SEL = WSP(int, WS_SEL);
#pragma unroll 1
    for (int j = 0; j < NJ; ++j) { const unsigned a = av[j * 64 + F.lane]; const bool gt = a > T, eq = a == T; const bool sl = gt || (eq && eqr < need); eqr += eq ? 1 : 0;
        const int src = srcrow0 + j * 64 + F.lane;
        if (sl) { IDX[yrow0 + slot] = src; VALS[yrow0 + slot] = __builtin_bit_cast(float, a); idx_lds[slot] = src; }
        SEL[(size_t)src * NE + e] = sl ? yrow0 + slot : -1;
        slot += sl ? 1 : 0; }
}
__device__ __forceinline__ void phase_topk(Frame& F, int l) {
    LAS int* idx_lds = (LAS int*)F.lds;
    const int ntask = l == 0 ? 256 : 128;
    for (int task = F.vcu; task < ntask; task += F.G) {
        const bool isctx = task >= 128; const int q = task & 127, b = q >> 4, e = q & 15;
        const int k = isctx ? CAPC : CAPL, yrow0 = isctx ? NE * NB * CAPL + e * (NB * CAPC) + b * CAPC : (e * NB + b) * CAPL;
        if (F.wave == 0) { if (isctx) topk_wave<4>(F, WSP(float, WS_AFFC) + (size_t)(b * NE + e) * CTXL, CAPC, ML + b * CTXL, yrow0, e, idx_lds, (LAS unsigned*)(F.lds + 4096));
                           else topk_wave<32>(F, WSP(float, WS_AFF) + (size_t)(b * NE + e) * SEQL, CAPL, b * SEQL, yrow0, e, idx_lds, (LAS unsigned*)(F.lds + 4096)); }
        LDS_WAIT(); __syncthreads();
        const unsigned char* H = WSP(unsigned char, WS_H); unsigned char* XS = WSP(unsigned char, WS_R1);
        for (int rr = F.wave; rr < k; rr += NWAVES) { const int src = idx_lds[rr]; const unsigned char* s = H + (size_t)src * DM + 16 * F.lane; unsigned char* dst = XS + (size_t)(yrow0 + rr) * DM + 16 * F.lane;
#pragma unroll
            for (int j = 0; j < 2; ++j) *(GAS v4u*)(dst + j * 1024) = *(const GAS v4u*)(s + j * 1024); }
        __syncthreads();
    }
}

template <class T> __device__ __forceinline__ T* opaque_ptr(T* p) { unsigned long long v = (unsigned long long)p; unsigned lo = (unsigned)v, hi = (unsigned)(v >> 32); asm volatile("" : "+v"(lo), "+v"(hi));
    lo = __builtin_amdgcn_readfirstlane(lo); hi = __builtin_amdgcn_readfirstlane(hi); return (T*)(((unsigned long long)hi << 32) | lo); }
__device__ __forceinline__ void launder(Frame& F) { F.ws = opaque_ptr(F.ws); F.out = opaque_ptr(F.out);
    int t = F.tid; asm volatile("" : "+v"(t)); F.tid = t; F.lane = t & 63; F.wave = __builtin_amdgcn_readfirstlane(t >> 6);
    int g = gridDim.x, bx = blockIdx.x; asm volatile("" : "+v"(g), "+v"(bx)); g = __builtin_amdgcn_readfirstlane(g); bx = __builtin_amdgcn_readfirstlane(bx);
    F.G = g; F.vcu = (g % 8 == 0) ? (bx % 8) * (g / 8) + bx / 8 : bx; }
__device__ __forceinline__ void grid_seam(Frame& F) {
    XcdBarrier b; b.bar = (unsigned*)(F.ws + WS_CTL) + CW_BAR; b.x = xb_xcc_id(); b.st = (volatile LAS unsigned*)(F.lds + MISC_OFF) + 8;
    xcd_barrier(b);
}
constexpr int NPHASE = 24;
struct Args { const float* in[27]; float* out; unsigned char* ws; };
#define IN(k) (LO <= (k) && (k) < HI)
#ifndef PROBE_SUB
#define PROBE_SUB 0
#endif
#ifndef PROBE_MASK
#define PROBE_MASK 0u
#endif
#define PHASE(k) if constexpr (IN(k)) for (int rep_ = 0; rep_ < (((PROBE_MASK >> (k)) & 1u) ? 2 : 1); ++rep_)
#define SEAM(k) do { if constexpr (IN(k) && IN((k) + 1)) grid_seam(F); } while (0)
template <int LO, int HI, int l>
__device__ __forceinline__ void layer_phases(Frame& F) {
    constexpr int pb = 1 + 11 * l;
    PHASE(pb + 0) { launder(F); phase_norm1(F, l); }
    SEAM(pb + 0);
    PHASE(pb + 1) {
        launder(F);
        SchedProj S{(const char*)WSP(bf16, WS_H), (const char*)(WSP(bf16, WS_WIN) + (size_t)l * DINP * DM), F.G, F.vcu, l};
        EpiProj E{WSP(bf16, WS_R1), WSP(bf16, WS_U2)};
        pg8::gemm_phase<EpiProj, SchedProj, true>(F.lds, F.tid, pg8::Dims{DM * 2, DM * 2, DM * 2}, S, E);
    }
    SEAM(pb + 1);
    PHASE(pb + 2) {
        launder(F);
        if (F.vcu < F.G - 64) phase_conv(F, l, F.G - 64);
        else { SchedF S{(const char*)WSP(bf16, WS_U2), (const char*)(WSP(bf16, WS_WF) + (size_t)l * NG * 256 * 1024), F.G, F.vcu};
            EpiF32 E{WSP(float, WS_F), 256, (size_t)NINST * 256};
            pg8::gemm_phase<EpiF32, SchedF, false>(F.lds, F.tid, pg8::Dims{KS2 * 2, 1024 * 2, 1024 * 2}, S, E); }
    }
    SEAM(pb + 2);
    PHASE(pb + 3) { launder(F); phase_carry(F, l); }
    SEAM(pb + 3);
    PHASE(pb + 4) {
        launder(F);
        SchedS2 S{(const char*)WSP(bf16, WS_U2), (const char*)(WSP(bf16, WS_W2) + (size_t)l * NG * 1024 * KS2), F.G, F.vcu, l};
        EpiS2 E{WSP(bf16, WS_U2), F.in[I_SSMD] + (size_t)l * DSSM, WSP(bf16, WS_Z)};
        pg8::gemm_phase<EpiS2, SchedS2, true>(F.lds, F.tid, pg8::Dims{KS2 * 2, KS2 * 2, KS2 * 2}, S, E);
    }
    SEAM(pb + 4);
    PHASE(pb + 5) {
        launder(F);
        SchedGlu S{(const char*)WSP(bf16, WS_Z), (const char*)(WSP(bf16, WS_WGLU) + (size_t)l * DSSM * DSSM), F.G, F.vcu, l == 0 ? 72 : 64};
        EpiGlu E{WSP(bf16, WS_Z), F.in[I_ONSG] + (size_t)l * DSSM, WSP(bf16, WS_R2)};
        if (F.G >= 144) pg8::gemm_phase<EpiGlu, SchedGlu, false>(F.lds, F.tid, pg8::Dims{DSSM * 2, DSSM * 2, DSSM * 2}, S, E);
    }
    SEAM(pb + 5);
    PHASE(pb + 6) {
        launder(F);
        SchedOut S{(const char*)WSP(bf16, WS_R2), (const char*)(WSP(bf16, WS_WOUT) + (size_t)l * DM * DM), F.G, F.vcu, l == 0 ? 72 : 64};
        EpiOut E{l == 0 ? F.in[I_X] : WSP(float, WS_XL), l == 0 ? F.in[I_CTX] : WSP(float, WS_XL) + (size_t)ML * DM, WSP(float, WS_MOD) + (size_t)l * 9 * 6 * DM, WSP(float, WS_XM)};
        pg8::gemm_phase<EpiOut, SchedOut, true>(F.lds, F.tid, pg8::Dims{DM * 2, DM * 2, DM * 2}, S, E);
    }
    SEAM(pb + 6);
    PHASE(pb + 7) { launder(F); phase_norm2(F, l); }
    SEAM(pb + 7);
    PHASE(pb + 8) { launder(F); phase_topk(F, l); }
    SEAM(pb + 8);
    PHASE(pb + 9) {
        launder(F);
        SchedMoe S{(const char*)WSP(unsigned char, WS_R1), (const char*)(WSP(unsigned char, WS_WGU) + (size_t)l * NE * 4096 * DM), F.G, F.vcu, 16, l};
        EpiMoe1 E{WSP(unsigned char, WS_R2)};
        pg8::gemm_phase<EpiMoe1, SchedMoe, true, true>(F.lds, F.tid, pg8::Dims{DM, DM, DM}, S, E);
    }
    SEAM(pb + 9);
    PHASE(pb + 10) {
        launder(F);
        SchedMoe S{(const char*)WSP(unsigned char, WS_R2), (const char*)(WSP(unsigned char, WS_WDN) + (size_t)l * NE * DM * DF), F.G, F.vcu, 8, l};
        EpiBf16 E{WSP(bf16, WS_R1), DM, 1.0f / (FP8_SW * FP8_SA)};
        pg8::gemm_phase<EpiBf16, SchedMoe, true, true>(F.lds, F.tid, pg8::Dims{DF, DF, DF}, S, E);
    }
    SEAM(pb + 10);
}
template <int LO, int HI>
__global__ void __launch_bounds__(NWAVES * 64, 2) trunk_fwd(Args args) {
    extern __shared__ __attribute__((aligned(16))) unsigned char lds[];
    Frame F;
    F.lds = (LAS unsigned char*)lds;
    F.tid = threadIdx.x; F.lane = F.tid & 63; F.wave = __builtin_amdgcn_readfirstlane(F.tid >> 6);
    F.G = gridDim.x; { const int bx = blockIdx.x; F.vcu = (F.G % 8 == 0) ? (bx % 8) * (F.G / 8) + bx / 8 : bx; }
    F.ws = args.ws; F.out = args.out; F.in = args.in;
    for (int u = F.tid; u < (LDS_BYTES - LDSCTL_OFF) / 4; u += NWAVES * 64) ((LAS unsigned*)(F.lds + LDSCTL_OFF))[u] = 0u;
    __syncthreads();
    if constexpr (HI - LO > 1) (void)xcd_barrier_post((unsigned*)(F.ws + WS_CTL) + CW_BAR, (volatile LAS unsigned*)(F.lds + MISC_OFF) + 8);

    PHASE(0) {
        launder(F);
        for (int q_ = 0; q_ < ((PROBE_SUB & 1) ? 2 : 1); ++q_) if (F.vcu < 192) { for (int t = F.vcu; t < 192; t += 192) p0_mod_task(F, t); }
        for (int q_ = 0; q_ < ((PROBE_SUB & 2) ? 2 : 1); ++q_) if (F.vcu >= 192) { for (int t = F.vcu - 192; t < 64; t += F.G - 192) p0_s5_task(F, t); }
        p0_router_t(F);
        for (int q_ = 0; q_ < ((PROBE_SUB & 4) ? 2 : 1); ++q_) p0_convert_weights(F);
    }
    SEAM(0);
    layer_phases<LO, HI, 0>(F);
    layer_phases<LO, HI, 1>(F);
    PHASE(23) { launder(F); phase_final(F); }
}
#undef IN
#undef PHASE
#undef SEAM

template <int P> static void launch_phase(int grid, hipStream_t stream, const Args& a) {
    hipLaunchKernelGGL((trunk_fwd<P, P + 1>), dim3(grid), dim3(NWAVES * 64), LDS_BYTES, stream, a);
}
template <int P> static void set_attr_phase() { (void)hipFuncSetAttribute((const void*)trunk_fwd<P, P + 1>, hipFuncAttributeMaxDynamicSharedMemorySize, LDS_BYTES); }
template <int... Ps> static void launch_all(std::integer_sequence<int, Ps...>, int grid, hipStream_t stream, const Args& a) { (launch_phase<Ps>(grid, stream, a), ...); }
template <int... Ps> static void set_attr_all(std::integer_sequence<int, Ps...>) { (set_attr_phase<Ps>(), ...); }
extern "C" void kernel_launch(void* const* d_in, const int* in_sizes, int n_in, void* d_out, int out_size, void* d_ws, size_t ws_size, hipStream_t stream) {
    static int grid = 0;
    if (grid == 0) {
        if (n_in != 27 || out_size != ML * DM || ws_size < WS_END) { fprintf(stderr, "kernel_launch: expected 27 inputs, %d outputs, >= %zu workspace bytes; got %d, %d, %zu\n", ML * DM, (size_t)WS_END, n_in, out_size, ws_size); grid = -1; return; }
        int dev = 0, cus = 0, per_cu = 0;
        if (hipGetDevice(&dev) != hipSuccess || hipDeviceGetAttribute(&cus, hipDeviceAttributeMultiprocessorCount, dev) != hipSuccess) { grid = -1; return; }
#if MK_N_LAUNCHES == 1
        if (hipFuncSetAttribute((const void*)trunk_fwd<0, NPHASE>, hipFuncAttributeMaxDynamicSharedMemorySize, LDS_BYTES) != hipSuccess) { fprintf(stderr, "kernel_launch: hipFuncSetAttribute failed\n"); grid = -1; return; }
        if (hipOccupancyMaxActiveBlocksPerMultiprocessor(&per_cu, (const void*)trunk_fwd<0, NPHASE>, NWAVES * 64, LDS_BYTES) != hipSuccess || per_cu < 1) fprintf(stderr, "kernel_launch: occupancy query reports %d\n", per_cu);
#else
        set_attr_all(std::make_integer_sequence<int, NPHASE>{});
#endif
        (void)hipGetLastError();
        grid = cus;
        if (grid < 256 || grid % 8 != 0) { fprintf(stderr, "kernel_launch: unexpected CU count %d\n", cus); }
    }
    if (grid < 0) return;
    (void)hipMemsetAsync((char*)d_ws + WS_CTL, 0, CTL_ZERO_BYTES, stream);
    Args a{};
    for (int i = 0; i < 27; ++i) a.in[i] = (const float*)d_in[i];
    a.out = (float*)d_out; a.ws = (unsigned char*)d_ws;
#if MK_N_LAUNCHES == 1
    hipLaunchKernelGGL((trunk_fwd<0, NPHASE>), dim3(grid), dim3(NWAVES * 64), LDS_BYTES, stream, a);
#else
    launch_all(std::make_integer_sequence<int, NPHASE>{}, grid, stream, a);
#endif
    const hipError_t le = hipPeekAtLastError();
    if (le != hipSuccess) fprintf(stderr, "kernel_launch: launch failed: %s\n", hipGetErrorName(le));
}
```

```cpp
#include <hip/hip_runtime.h>
#include <cstdio>
#include <cstdint>
#include <utility>

#define GAS __attribute__((address_space(1)))
#define LAS __attribute__((address_space(3)))
typedef unsigned short bf16;
typedef unsigned v4u __attribute__((ext_vector_type(4)));
typedef unsigned v2u __attribute__((ext_vector_type(2)));
typedef float f32x4 __attribute__((ext_vector_type(4)));
typedef float f32x2 __attribute__((ext_vector_type(2)));
typedef short bf16x8 __attribute__((ext_vector_type(8)));
typedef GAS unsigned gu32;

#ifndef MK_N_LAUNCHES
#define MK_N_LAUNCHES 1
#endif

constexpr int NB = 8, SEQL = 2048, CTXL = 256, DM = 2048;
constexpr int ML = NB * SEQL, MC = NB * CTXL, MT = ML + MC;
constexpr int DCONV = 1536, DSSM = 512, DINP = 3 * DCONV + DSSM;
constexpr int NG = 32, SG = 16, SP = 64, TCH = 64;
constexpr int NE = 16, DF = 2048, CAPL = 256, CAPC = 32;
constexpr int NINST = 512, KS2 = 1280;
constexpr int YROWS = NE * NB * CAPL + NE * NB * CAPC;
constexpr float EPS = 1e-6f;

constexpr size_t MiB = 1u << 20;
constexpr size_t WS_CTL = 0, CTL_ZERO_BYTES = 1 * MiB;
constexpr size_t WS_MOD = 1 * MiB;
constexpr size_t WS_RWT = 2 * MiB;
constexpr size_t WS_LT = 2 * MiB + 512 * 1024;
constexpr size_t WS_AFF = 3 * MiB;
constexpr size_t WS_AFFC = 4 * MiB;
constexpr size_t WS_IDX = 5 * MiB;
constexpr size_t WS_VALS = 5 * MiB + 256 * 1024;
constexpr size_t WS_SEL = 6 * MiB;
constexpr size_t WS_WGLU = 8 * MiB;
constexpr size_t WS_WOUT = 9 * MiB;
constexpr size_t WS_WIN = 25 * MiB;
constexpr size_t WS_WF = 65 * MiB;
constexpr size_t WS_W2 = 97 * MiB;
constexpr size_t WS_WGU = 257 * MiB;
constexpr size_t WS_WDN = 769 * MiB;
constexpr size_t WS_XL = 1025 * MiB;
constexpr size_t WS_XM = 1169 * MiB;
constexpr size_t WS_H = 1313 * MiB;
constexpr size_t WS_F = 1385 * MiB;
constexpr size_t WS_R1 = 1401 * MiB;
constexpr size_t WS_R2 = 1563 * MiB;
constexpr size_t WS_U2 = WS_R2 + 72 * MiB;
constexpr size_t WS_Z = WS_R2 + 112 * MiB;
constexpr size_t WS_END = 1707 * MiB;
constexpr int CW_BAR = 4096;

constexpr int RING_BYTES = 131072;
constexpr int LDSCTL_OFF = RING_BYTES, MISC_OFF = LDSCTL_OFF + 320;
constexpr int LDS_BYTES = 147456;
constexpr int NWAVES = 8;

#define LDS_WAIT() asm volatile("s_waitcnt lgkmcnt(0)" ::: "memory")
#define VM_WAIT() asm volatile("s_waitcnt vmcnt(0)" ::: "memory")
__device__ __forceinline__ unsigned f2bf(float f) { unsigned u = __builtin_bit_cast(unsigned, f); return (u + 0x7fffu + ((u >> 16) & 1u)) >> 16; }
__device__ __forceinline__ unsigned pk2(float lo, float hi) { return f2bf(lo) | (f2bf(hi) << 16); }
__device__ __forceinline__ float bflo(unsigned w) { return __builtin_bit_cast(float, w << 16); }
__device__ __forceinline__ float bfhi(unsigned w) { return __builtin_bit_cast(float, w & 0xffff0000u); }
__device__ __forceinline__ float wave_sum(float v) {
#pragma unroll
    for (int o = 1; o < 64; o <<= 1) v += __shfl_xor(v, o);
    return v;
}
__device__ __forceinline__ float sigmoidf_(float x) { return 1.0f / (1.0f + __expf(-x)); }
__device__ __forceinline__ float gelu_tanh(float y) { const float a = 1.5957691216f * (y + 0.044715f * y * y * y); return y * sigmoidf_(a); }

#ifndef FP8_SCALE1
#define FP8_SCALE1 0x7f7f7f7f
#endif
namespace pg8 {
constexpr int BM = 256, BK = 64, HALF = 128, HTB = HALF * BK * 2, STAGE_BYTES = 8 * HTB;
__host__ __device__ __forceinline__ int lds_byte(int r, int c) { const int st = (r >> 4) * 2 + (c >> 5), rr = r & 15, cc = c & 31, ob = rr * 64 + cc * 2; return st * 1024 + (ob ^ (((ob >> 9) & 1) << 5)); }
__host__ __device__ __forceinline__ void stage_rc(int b, int& R, int& C) { const int st = b / 1024, sb = b % 1024, swz = sb ^ (((sb >> 9) & 1) << 5); R = (st >> 1) * 16 + swz / 64; C = (st & 1) * 32 + (swz % 64) / 2; }
__host__ __device__ __forceinline__ int perm32(int rho) { const int n = rho >> 4, i = rho & 15; return 8 * (i >> 2) + 4 * n + (i & 3); }
__device__ __forceinline__ unsigned cvt_pk_bf16(float lo, float hi) { unsigned r; asm volatile("v_cvt_pk_bf16_f32 %0, %1, %2" : "=v"(r) : "v"(lo), "v"(hi)); return r; }

struct Unit { const char* a; const char* b; int pm, pn, aux; };
struct Dims { int lda, ldb, K; };
typedef int v4i_t __attribute__((ext_vector_type(4)));
typedef int v8i_t __attribute__((ext_vector_type(8)));
template <bool FP8> struct Frag { bf16x8 k[2]; };
template <> struct Frag<true> { v8i_t v; };

template <class Epi, class Sched, bool ALIGN_EPI, bool FP8 = false>
__device__ __forceinline__ void gemm_phase(LAS unsigned char* lds, const int tid, const Dims g, const Sched& S, const Epi& E) {
    const int wid = __builtin_amdgcn_readfirstlane(tid >> 6), lane = tid & 63, wr = wid >> 2, wc = wid & 3, fr = lane & 15, fq = lane >> 4;
    const int nt = g.K / (BK * 2);
    unsigned voffA[2], voffB[2];
#pragma unroll
    for (int i = 0; i < 2; ++i) { int R, C; stage_rc(tid * 16 + i * 8192, R, C); const int Rb = Epi::PERM ? ((R & ~31) + perm32(R & 31)) : R;
        voffA[i] = (unsigned)(R * g.lda + C * 2); voffB[i] = (unsigned)(Rb * g.ldb + C * 2); }
    const size_t kstep = (size_t)(BK * 2);
    const size_t hstepA = (size_t)HALF * g.lda, hstepB = (size_t)HALF * g.ldb;
    const unsigned ldsw = (unsigned)wid * 1024u;
    const int aoff = lds_byte(wr * 64 + fr, fq * 8), boff = lds_byte(wc * 32 + fr, fq * 8);
#define PG8_SA(b, h) (((b) * 2 + (h)) * HTB)
#define PG8_SB(b, h) ((4 + (b) * 2 + (h)) * HTB)
#define PG8_STAGE(bufoff, gbase, voff) do { _Pragma("unroll") for (int _i = 0; _i < 2; ++_i) \
        __builtin_amdgcn_global_load_lds((const unsigned*)((const char*)(gbase) + (voff)[_i]), (LAS unsigned*)(lds + (bufoff) + ldsw + _i * 8192), 16, 0, 0); } while (0)
#define PG8_LD1(dst, p) do { if constexpr (FP8) { const v4i_t lo_ = *(const LAS v4i_t*)(p), hi_ = *(const LAS v4i_t*)((p) + 1024); dst.v = __builtin_shufflevector(lo_, hi_, 0, 1, 2, 3, 4, 5, 6, 7); } \
        else { dst.k[0] = *(const LAS bf16x8*)(p); dst.k[1] = *(const LAS bf16x8*)((p) + 1024); } } while (0)
#define PG8_LDA(dst, b, h) do { _Pragma("unroll") for (int m = 0; m < 4; ++m) PG8_LD1(dst[m], lds + PG8_SA(b, h) + aoff + m * 2048); } while (0)
#define PG8_LDB(dst, b, h) do { _Pragma("unroll") for (int n = 0; n < 2; ++n) PG8_LD1(dst[n], lds + PG8_SB(b, h) + boff + n * 2048); } while (0)
#define PG8_MMA(ai, bj, At, Bt) do { __builtin_amdgcn_s_setprio(1); _Pragma("unroll") for (int m = 0; m < 4; ++m) _Pragma("unroll") for (int n = 0; n < 2; ++n) { \
        if constexpr (FP8) asm volatile("v_mfma_f32_16x16x128_f8f6f4 %0, %1, %2, %0" : "+v"(acc[ai][bj][m][n]) : "v"(Bt[n].v), "v"(At[m].v)); \
        else { _Pragma("unroll") for (int k = 0; k < 2; ++k) acc[ai][bj][m][n] = __builtin_amdgcn_mfma_f32_16x16x32_bf16(Bt[n].k[k], At[m].k[k], acc[ai][bj][m][n], 0, 0, 0); } } __builtin_amdgcn_s_setprio(0); } while (0)
#define PG8_WAIT_V(n) asm volatile("s_waitcnt vmcnt(" #n ")" ::: "memory")
#define PG8_WAIT_L(n) asm volatile("s_waitcnt lgkmcnt(" #n ")" ::: "memory")
#define PG8_BAR __builtin_amdgcn_s_barrier()
#define PG8_SCHED __builtin_amdgcn_sched_barrier(0)
    Unit cur, nxt; int ui = 0;
    if (!S.next(0, cur)) return;
    f32x4 acc[2][2][4][2];
#pragma unroll
    for (int a = 0; a < 2; ++a)
#pragma unroll
        for (int b = 0; b < 2; ++b)
#pragma unroll
            for (int m = 0; m < 4; ++m)
#pragma unroll
                for (int n = 0; n < 2; ++n) acc[a][b][m][n] = (f32x4){0.f, 0.f, 0.f, 0.f};
    Frag<FP8> At[4], B0[2], B1[2];
    const char* cA = cur.a; const char* cB = cur.b;
    PG8_STAGE(PG8_SB(0, 0), cB, voffB); PG8_STAGE(PG8_SB(0, 1), cB + hstepB, voffB); PG8_STAGE(PG8_SA(0, 0), cA, voffA); PG8_STAGE(PG8_SA(0, 1), cA + hstepA, voffA);
    if (wr == 1) PG8_BAR;
    PG8_WAIT_V(2); PG8_BAR;
    PG8_STAGE(PG8_SB(1, 0), cB + kstep, voffB); PG8_STAGE(PG8_SA(1, 0), cA + kstep, voffA); PG8_STAGE(PG8_SB(1, 1), cB + hstepB + kstep, voffB);
    PG8_WAIT_V(6); PG8_BAR;
    for (;;) {
        const bool has_next = S.next(ui + 1, nxt);
        const char* nA = has_next ? nxt.a : cA; const char* nB = has_next ? nxt.b : cB;
        for (int t = 0; t < nt; t += 2) {
            const bool last = (t == nt - 2);
            const char* a1 = cA + (size_t)(t + 1) * kstep;
            const char* a2 = last ? nA : cA + (size_t)(t + 2) * kstep; const char* b2 = last ? nB : cB + (size_t)(t + 2) * kstep;
            const char* a3 = a2 + kstep; const char* b3 = b2 + kstep;
            PG8_LDB(B0, 0, 0); PG8_LDB(B1, 0, 1); PG8_SCHED; PG8_LDA(At, 0, 0); PG8_STAGE(PG8_SA(1, 1), a1 + hstepA, voffA);
            PG8_WAIT_V(8); PG8_WAIT_L(0); PG8_BAR; PG8_MMA(0, 0, At, B0); PG8_MMA(0, 1, At, B1); PG8_BAR; PG8_SCHED;
            PG8_LDA(At, 0, 1); PG8_STAGE(PG8_SB(0, 0), b2, voffB); PG8_STAGE(PG8_SB(0, 1), b2 + hstepB, voffB); PG8_STAGE(PG8_SA(0, 0), a2, voffA);
            PG8_WAIT_V(8); PG8_WAIT_L(0); PG8_BAR; PG8_MMA(1, 0, At, B0); PG8_MMA(1, 1, At, B1); PG8_BAR; PG8_SCHED;
            PG8_LDB(B0, 1, 0); PG8_LDB(B1, 1, 1); PG8_SCHED; PG8_LDA(At, 1, 0); PG8_STAGE(PG8_SA(0, 1), a2 + hstepA, voffA);
            PG8_WAIT_V(8); PG8_WAIT_L(0); PG8_BAR; PG8_MMA(0, 0, At, B0); PG8_MMA(0, 1, At, B1); PG8_BAR; PG8_SCHED;
            PG8_LDA(At, 1, 1); PG8_STAGE(PG8_SB(1, 0), b3, voffB); PG8_STAGE(PG8_SB(1, 1), b3 + hstepB, voffB); PG8_STAGE(PG8_SA(1, 0), a3, voffA);
            PG8_WAIT_V(8); PG8_WAIT_L(0); PG8_BAR; PG8_MMA(1, 0, At, B0); PG8_MMA(1, 1, At, B1); PG8_BAR; PG8_SCHED;
        }
        if constexpr (FP8) asm volatile("s_nop 15\n\ts_nop 7" ::: "memory");
        if constexpr (ALIGN_EPI) { if (wr == 0) PG8_BAR; }
        if constexpr (!Epi::AFTER_DRAIN) { E(acc, cur, wr, wc, fr, fq); }
        if (!has_next) break;
#pragma unroll
        for (int a = 0; a < 2; ++a)
#pragma unroll
            for (int b = 0; b < 2; ++b)
#pragma unroll
                for (int m = 0; m < 4; ++m)
#pragma unroll
                    for (int n = 0; n < 2; ++n) acc[a][b][m][n] = (f32x4){0.f, 0.f, 0.f, 0.f};
        cur = nxt; cA = nA; cB = nB; ++ui;
        if constexpr (ALIGN_EPI) { if (wr == 1) PG8_BAR; }
    }
    PG8_WAIT_V(0);
    if constexpr (!ALIGN_EPI) { if (wr == 0) PG8_BAR; }
    PG8_BAR;
    if constexpr (Epi::AFTER_DRAIN) { E.fused(acc, cur, wr, wc, fr, fq, lds, wid, lane); }
#undef PG8_SA
#undef PG8_SB
#undef PG8_STAGE
#undef PG8_LDA
#undef PG8_LDB
#undef PG8_MMA
#undef PG8_LD1
#undef PG8_WAIT_V
#undef PG8_WAIT_L
#undef PG8_BAR
#undef PG8_SCHED
}
}

#define XB_TMO      128
#define XB_XCNT(j)  (256  + 64 * (j))
#define XB_XSUB(j)  (1280 + 64 * (j))
#define XB_XGEN(j)  (2304 + 64 * (j))
#define XB_TOP      3328
#define XB_TOPGEN   3392
#define XCD_BAR_WORDS 3456
#define XB_SPIN_CAP (1u << 18)

__device__ __forceinline__ unsigned xb_ld(unsigned* p)              { return __hip_atomic_load(p, __ATOMIC_RELAXED, __HIP_MEMORY_SCOPE_AGENT); }
__device__ __forceinline__ unsigned xb_add(unsigned* p, unsigned v) { return __hip_atomic_fetch_add(p, v, __ATOMIC_RELAXED, __HIP_MEMORY_SCOPE_AGENT); }
__device__ __forceinline__ unsigned xb_xcc_id() { return (unsigned)__builtin_amdgcn_s_getreg((3 << 11) | 20) & 0xFu; }
#define XB_SPIN(cond, bar) do { unsigned _sp = 0; while (cond) { __builtin_amdgcn_s_sleep(1); \
    if ((++_sp & 255u) == 0u) { if (xb_ld(&(bar)[XB_TMO])) break; if (_sp > XB_SPIN_CAP) { atomicAdd(&(bar)[XB_TMO], 1u); break; } } } } while (0)

struct XcdBarrier {
    unsigned* bar; unsigned x;
    volatile LAS unsigned* st;
};
__device__ __forceinline__ XcdBarrier xcd_barrier_post(unsigned* bar, volatile LAS unsigned* st) {
    XcdBarrier b; b.bar = bar; b.x = xb_xcc_id(); b.st = st;
    if (threadIdx.x == 0) (void)xb_add(&bar[XB_XCNT(b.x)], 1u);
    return b;
}
__device__ __forceinline__ void xcd_barrier_complete(unsigned* bar, unsigned x, unsigned& nloc, unsigned& nx) {
    const unsigned G = gridDim.x * gridDim.y * gridDim.z;
    unsigned sum, cnt, mine, sp = 0u;
    for (;;) {
        sum = 0u; cnt = 0u; mine = 0u;
#pragma unroll
        for (unsigned j = 0; j < 16; ++j) { const unsigned c = xb_ld(&bar[XB_XCNT(j)]); sum += c; cnt += (c > 0u) ? 1u : 0u; mine = (j == x) ? c : mine; }
        if (sum == G) break;
        __builtin_amdgcn_s_sleep(1);
        if ((++sp & 255u) == 0u) { if (xb_ld(&bar[XB_TMO])) break; if (sp > XB_SPIN_CAP) { atomicAdd(&bar[XB_TMO], 1u); break; } }
    }
    nloc = mine > 0u ? mine : 1u; nx = cnt > 0u ? cnt : 1u;
}
__device__ __forceinline__ void xcd_barrier(const XcdBarrier& b) {
    asm volatile("s_waitcnt vmcnt(0)" ::: "memory");
    __syncthreads();
    if (threadIdx.x == 0) {
        unsigned* bar = b.bar;
        __builtin_amdgcn_s_waitcnt(0);
        unsigned nloc = b.st[0], nx = b.st[1];
        if (nloc == 0u) { xcd_barrier_complete(bar, b.x, nloc, nx); b.st[0] = nloc; b.st[1] = nx; }
        const unsigned old = xb_add(&bar[XB_XSUB(b.x)], 1u);
        const unsigned gen = old / nloc;
        if (old + 1u == (gen + 1u) * nloc) {
            __builtin_amdgcn_fence(__ATOMIC_RELEASE, "agent");
            asm volatile("s_waitcnt vmcnt(0)" ::: "memory");
            const unsigned og = xb_add(&bar[XB_TOP], 1u);
            const unsigned tg = og / nx;
            if (og + 1u == (tg + 1u) * nx) xb_add(&bar[XB_TOPGEN], 1u);
            else XB_SPIN(xb_ld(&bar[XB_TOPGEN]) == tg, bar);
            __builtin_amdgcn_fence(__ATOMIC_ACQUIRE, "agent");
            xb_add(&bar[XB_XGEN(b.x)], 1u);
            asm volatile("s_waitcnt vmcnt(0)" ::: "memory");
        } else {
            XB_SPIN(xb_ld(&bar[XB_XGEN(b.x)]) == gen, bar);
            __builtin_amdgcn_fence(__ATOMIC_ACQUIRE, "agent");
            asm volatile("s_waitcnt vmcnt(0)" ::: "memory");
        }
    }
    __syncthreads();
}

struct Frame {
    LAS unsigned char* lds;
    int tid, lane, wave, vcu, G;
    unsigned char* ws;
    const float* const* in;
    float* out;
};
#define WSP(T, off) ((T*)(F.ws + (off)))
enum InIdx { I_X = 0, I_C, I_CTX, I_CCTX, I_ADAW, I_ADAB, I_N1G, I_WIN, I_CONVW, I_LRE, I_LIM, I_LDT, I_BRE, I_BIM, I_CRE, I_CIM, I_SSMD, I_WGLU, I_ONCG, I_ONSG, I_WOUT, I_N2G, I_RW, I_WG, I_WU, I_WD, I_FNG };

using pg8::Unit;
struct EpiProj {
    static constexpr bool PERM = true, AFTER_DRAIN = false;
    bf16* proj; bf16* u2;
    __device__ __forceinline__ void operator()(const f32x4 (&acc)[2][2][4][2], const Unit& u, int wr, int wc, int fr, int fq) const {
        const int row0 = u.pm * 256 + wr * 64 + fr, col0 = u.pn * 256 + wc * 32 + 8 * fq;
#pragma unroll
        for (int ai = 0; ai < 2; ++ai)
#pragma unroll
            for (int m = 0; m < 4; ++m) { const int row = row0 + ai * 128 + m * 16;
#pragma unroll
                for (int bj = 0; bj < 2; ++bj) { const f32x4 v0 = acc[ai][bj][m][0], v1 = acc[ai][bj][m][1]; const int col = col0 + bj * 128;
                    v4u w; w.x = pg8::cvt_pk_bf16(v0[0], v0[1]); w.y = pg8::cvt_pk_bf16(v0[2], v0[3]); w.z = pg8::cvt_pk_bf16(v1[0], v1[1]); w.w = pg8::cvt_pk_bf16(v1[2], v1[3]);
                    bf16* dst;
                    if (u.pn < 18) dst = proj + (size_t)row * (3 * DCONV) + col;
                    else { const int cc = col - 3 * DCONV, g = cc >> 4, i0 = cc & 15; dst = u2 + ((size_t)(g * NINST + (row >> 6)) * KS2 + (row & 63) * 16 + i0); }
                    *(GAS v4u*)dst = w; } }
    }
};
struct EpiF32 {
    static constexpr bool PERM = false, AFTER_DRAIN = false;
    float* C; int ldc; size_t cstride;
    __device__ __forceinline__ void operator()(const f32x4 (&acc)[2][2][4][2], const Unit& u, int wr, int wc, int fr, int fq) const {
        float* base = C + (size_t)u.aux * cstride; const int row0 = u.pm * 256 + wr * 64 + fr, col0 = u.pn * 256 + wc * 32 + 4 * fq;
#pragma unroll
        for (int ai = 0; ai < 2; ++ai)
#pragma unroll
            for (int m = 0; m < 4; ++m) { float* rowp = base + (size_t)(row0 + ai * 128 + m * 16) * ldc + col0;
#pragma unroll
                for (int bj = 0; bj < 2; ++bj)
#pragma unroll
                    for (int n = 0; n < 2; ++n) *(GAS f32x4*)(rowp + bj * 128 + n * 16) = acc[ai][bj][m][n]; }
    }
};
struct EpiS2 {
    static constexpr bool PERM = true, AFTER_DRAIN = false;
    const bf16* u2; const float* dsk; bf16* z;
    __device__ __forceinline__ void operator()(const f32x4 (&acc)[2][2][4][2], const Unit& u, int wr, int wc, int fr, int fq) const {
        const int g = u.aux, inst0 = u.pm * 256 + wr * 64 + fr, c0 = u.pn * 256 + wc * 32 + 8 * fq;
#pragma unroll
        for (int bj = 0; bj < 2; ++bj) { const int cidx = c0 + bj * 128, t = cidx >> 4, o0 = cidx & 15;
            const f32x4 d0 = *(const GAS f32x4*)(dsk + g * 16 + o0), d1 = *(const GAS f32x4*)(dsk + g * 16 + o0 + 4);
#pragma unroll
            for (int ai = 0; ai < 2; ++ai)
#pragma unroll
                for (int m = 0; m < 4; ++m) { const int inst = inst0 + ai * 128 + m * 16;
                    if (inst < MT / 64) {
                        const v4u uu = *(const GAS v4u*)(u2 + ((size_t)(g * NINST + inst) * KS2 + cidx));
                        const f32x4 a0 = acc[ai][bj][m][0], a1 = acc[ai][bj][m][1];
                        const float y0 = a0[0] + d0[0] * bflo(uu.x), y1 = a0[1] + d0[1] * bfhi(uu.x), y2 = a0[2] + d0[2] * bflo(uu.y), y3 = a0[3] + d0[3] * bfhi(uu.y);
                        const float y4 = a1[0] + d1[0] * bflo(uu.z), y5 = a1[1] + d1[1] * bfhi(uu.z), y6 = a1[2] + d1[2] * bflo(uu.w), y7 = a1[3] + d1[3] * bfhi(uu.w);
                        v4u w; w.x = pg8::cvt_pk_bf16(gelu_tanh(y0), gelu_tanh(y1)); w.y = pg8::cvt_pk_bf16(gelu_tanh(y2), gelu_tanh(y3));
                        w.z = pg8::cvt_pk_bf16(gelu_tanh(y4), gelu_tanh(y5)); w.w = pg8::cvt_pk_bf16(gelu_tanh(y6), gelu_tanh(y7));
                        *(GAS v4u*)(z + ((size_t)(inst * 64 + t) * DSSM + g * 16 + o0)) = w; } } }
    }
};
struct EpiGlu {
    static constexpr bool PERM = true, AFTER_DRAIN = true;
    const bf16* z; const float* gain; bf16* concat;
    __device__ __forceinline__ void operator()(const f32x4 (&)[2][2][4][2], const Unit&, int, int, int, int) const {}
    __device__ __forceinline__ void fused(f32x4 (&acc)[2][2][4][2], const Unit& u, int wr, int wc, int fr, int fq, LAS unsigned char* lds, int wid, int lane) const {
        LAS float* P = (LAS float*)lds;
        const int row0 = u.pm * 256 + wr * 64 + fr, col0 = u.pn * 256 + wc * 32 + 8 * fq;
#pragma unroll
        for (int ai = 0; ai < 2; ++ai)
#pragma unroll
            for (int m = 0; m < 4; ++m) { const int row = row0 + ai * 128 + m * 16, rt = ai * 128 + wr * 64 + m * 16 + fr;
#pragma unroll
                for (int bj = 0; bj < 2; ++bj) { const v4u zz = *(const GAS v4u*)(z + (size_t)row * DSSM + col0 + bj * 128);
                    f32x4 a0 = acc[ai][bj][m][0], a1 = acc[ai][bj][m][1];
                    a0[0] = bflo(zz.x) * sigmoidf_(a0[0]); a0[1] = bfhi(zz.x) * sigmoidf_(a0[1]); a0[2] = bflo(zz.y) * sigmoidf_(a0[2]); a0[3] = bfhi(zz.y) * sigmoidf_(a0[3]);
                    a1[0] = bflo(zz.z) * sigmoidf_(a1[0]); a1[1] = bfhi(zz.z) * sigmoidf_(a1[1]); a1[2] = bflo(zz.w) * sigmoidf_(a1[2]); a1[3] = bfhi(zz.w) * sigmoidf_(a1[3]);
                    acc[ai][bj][m][0] = a0; acc[ai][bj][m][1] = a1;
                    float s = (a0[0] * a0[0] + a0[1] * a0[1]) + (a0[2] * a0[2] + a0[3] * a0[3]) + (a1[0] * a1[0] + a1[1] * a1[1]) + (a1[2] * a1[2] + a1[3] * a1[3]);
                    s += __shfl_xor(s, 16); s += __shfl_xor(s, 32);
                    if (fq == 0) P[(rt * 2 + bj) * 4 + wc] = s; } }
        LDS_WAIT(); __builtin_amdgcn_s_barrier(); asm volatile("" ::: "memory");
#pragma unroll
        for (int bj = 0; bj < 2; ++bj) { const int col = col0 + bj * 128;
            const f32x4 g0 = *(const GAS f32x4*)(gain + col), g1 = *(const GAS f32x4*)(gain + col + 4);
#pragma unroll
            for (int ai = 0; ai < 2; ++ai)
#pragma unroll
                for (int m = 0; m < 4; ++m) { const int row = row0 + ai * 128 + m * 16, rt = ai * 128 + wr * 64 + m * 16 + fr;
                    const f32x4 p = *(const LAS f32x4*)(P + (rt * 2 + bj) * 4);
                    const float rs = 1.0f / sqrtf(((p[0] + p[1]) + (p[2] + p[3])) * (1.0f / 128.0f) + EPS);
                    const f32x4 a0 = acc[ai][bj][m][0] * rs * g0, a1 = acc[ai][bj][m][1] * rs * g1;
                    v4u w; w.x = pg8::cvt_pk_bf16(a0[0], a0[1]); w.y = pg8::cvt_pk_bf16(a0[2], a0[3]); w.z = pg8::cvt_pk_bf16(a1[0], a1[1]); w.w = pg8::cvt_pk_bf16(a1[2], a1[3]);
                    *(GAS v4u*)(concat + (size_t)row * DM + DCONV + col) = w; } }
    }
};
struct EpiOut {
    static constexpr bool PERM = false, AFTER_DRAIN = false;
    const float* xlat; const float* xctx; const float* mod; float* xm;
    __device__ __forceinline__ void operator()(const f32x4 (&acc)[2][2][4][2], const Unit& u, int wr, int wc, int fr, int fq) const {
        const int rb = u.pm < 64 ? (u.pm >> 3) : 8; const float* g1 = mod + (size_t)(rb * 6 + 2) * DM;
        const float* xp = u.pm < 64 ? xlat + (size_t)u.pm * 256 * DM : xctx + (size_t)(u.pm - 64) * 256 * DM;
        float* xo = xm + (size_t)u.pm * 256 * DM;
        const int r0 = wr * 64 + fr, col0 = u.pn * 256 + wc * 32 + 4 * fq;
        f32x4 gv[2][2];
#pragma unroll
        for (int bj = 0; bj < 2; ++bj)
#pragma unroll
            for (int n = 0; n < 2; ++n) gv[bj][n] = *(const GAS f32x4*)(g1 + col0 + bj * 128 + n * 16);
#pragma unroll
        for (int ai = 0; ai < 2; ++ai) { f32x4 xv[4][2][2];
#pragma unroll
            for (int m = 0; m < 4; ++m) { const size_t off = (size_t)(r0 + ai * 128 + m * 16) * DM + col0;
#pragma unroll
                for (int bj = 0; bj < 2; ++bj)
#pragma unroll
                    for (int n = 0; n < 2; ++n) xv[m][bj][n] = *(const GAS f32x4*)(xp + off + bj * 128 + n * 16); }
#pragma unroll
            for (int m = 0; m < 4; ++m) { const size_t off = (size_t)(r0 + ai * 128 + m * 16) * DM + col0;
#pragma unroll
                for (int bj = 0; bj < 2; ++bj)
#pragma unroll
                    for (int n = 0; n < 2; ++n) *(GAS f32x4*)(xo + off + bj * 128 + n * 16) = xv[m][bj][n] + gv[bj][n] * acc[ai][bj][m][n]; }
            asm volatile("" ::: "memory"); }
    }
};
constexpr float FP8_SW = 64.f, FP8_SH = 16.f, FP8_SA = 8.f;
__device__ __forceinline__ unsigned pk4_fp8(float a, float b, float c, float d) {
    a = __builtin_amdgcn_fmed3f(a, -448.f, 448.f); b = __builtin_amdgcn_fmed3f(b, -448.f, 448.f); c = __builtin_amdgcn_fmed3f(c, -448.f, 448.f); d = __builtin_amdgcn_fmed3f(d, -448.f, 448.f);
    unsigned w = (unsigned)__builtin_amdgcn_cvt_pk_fp8_f32(a, b, 0, false); return (unsigned)__builtin_amdgcn_cvt_pk_fp8_f32(c, d, (int)w, true); }
struct EpiMoe1 {
    static constexpr bool PERM = true, AFTER_DRAIN = false;
    unsigned char* act;
    __device__ __forceinline__ void operator()(const f32x4 (&acc)[2][2][4][2], const Unit& u, int wr, int wc, int fr, int fq) const {
        const int row0 = u.pm * 256 + wr * 64 + fr, f0 = u.pn * 128 + wc * 32 + 8 * fq; constexpr float sg = 1.0f / (FP8_SW * FP8_SH);
#pragma unroll
        for (int ai = 0; ai < 2; ++ai)
#pragma unroll
            for (int m = 0; m < 4; ++m) { const f32x4 g0 = acc[ai][0][m][0] * sg, g1 = acc[ai][0][m][1] * sg, u0 = acc[ai][1][m][0] * (sg * FP8_SA), u1 = acc[ai][1][m][1] * (sg * FP8_SA);
                float r[8];
#pragma unroll
                for (int j = 0; j < 4; ++j) { r[j] = g0[j] * sigmoidf_(g0[j]) * u0[j]; r[4 + j] = g1[j] * sigmoidf_(g1[j]) * u1[j]; }
                v2u w; w.x = pk4_fp8(r[0], r[1], r[2], r[3]); w.y = pk4_fp8(r[4], r[5], r[6], r[7]);
                *(GAS v2u*)(act + (size_t)(row0 + ai * 128 + m * 16) * DF + f0) = w; }
    }
};
struct EpiBf16 {
    static constexpr bool PERM = true, AFTER_DRAIN = false;
    bf16* O; int ldc; float scale;
    __device__ __forceinline__ void operator()(const f32x4 (&acc)[2][2][4][2], const Unit& u, int wr, int wc, int fr, int fq) const {
        const int row0 = u.pm * 256 + wr * 64 + fr, col0 = u.pn * 256 + wc * 32 + 8 * fq;
#pragma unroll
        for (int ai = 0; ai < 2; ++ai)
#pragma unroll
            for (int m = 0; m < 4; ++m) { bf16* rowp = O + (size_t)(row0 + ai * 128 + m * 16) * ldc + col0;
#pragma unroll
                for (int bj = 0; bj < 2; ++bj) { const f32x4 v0 = acc[ai][bj][m][0] * scale, v1 = acc[ai][bj][m][1] * scale;
                    v4u w; w.x = pg8::cvt_pk_bf16(v0[0], v0[1]); w.y = pg8::cvt_pk_bf16(v0[2], v0[3]); w.z = pg8::cvt_pk_bf16(v1[0], v1[1]); w.w = pg8::cvt_pk_bf16(v1[2], v1[3]);
                    *(GAS v4u*)(rowp + bj * 128) = w; } }
    }
};

struct SchedProj {
    const char* A; const char* B; int G, c, layer;
    __device__ __forceinline__ bool next(int i, Unit& u) const {
        const int L = i * G + c; int rt, ct;
        if (layer == 0) { if (L >= 1440) return false; rt = (L / 160) * 8 + (L & 7); ct = (L % 160) >> 3; }
        else { if (L >= 1296) return false; if (L < 1280) { rt = (L / 160) * 8 + (L & 7); ct = (L % 160) >> 3; } else { const int j = L - 1280; rt = 64 + (j & 7); ct = 18 + (j >> 3); } }
        u.pm = rt; u.pn = ct; u.aux = 0; u.a = A + (size_t)rt * 256 * DM * 2; u.b = B + (size_t)ct * 256 * DM * 2; return true; }
};
struct SchedF {
    const char* A; const char* B; int G, c;
    __device__ __forceinline__ bool next(int i, Unit& u) const {
        const int j = c - (G - 64); if (i != 0 || j < 0) return false;
        const int g = j >> 1, rt = j & 1; u.pm = rt; u.pn = 0; u.aux = g; u.a = A + (size_t)(g * NINST + rt * 256) * KS2 * 2; u.b = B + (size_t)g * 256 * 1024 * 2; return true; }
};
struct SchedS2 {
    const char* A; const char* B; int G, c, layer;
    __device__ __forceinline__ bool next(int i, Unit& u) const {
        const int L = i * G + c; int g, rt, ct;
        if (layer == 0) { if (L >= 256) return false; g = L >> 3; rt = (L >> 2) & 1; ct = L & 3; } else { if (L >= 128) return false; g = L >> 2; rt = 0; ct = L & 3; }
        u.pm = rt; u.pn = ct; u.aux = g; u.a = A + (size_t)(g * NINST + rt * 256) * KS2 * 2; u.b = B + (size_t)(g * 1024 + ct * 256) * KS2 * 2; return true; }
};
struct SchedGlu {
    const char* A; const char* B; int G, c, nrt;
    __device__ __forceinline__ bool next(int i, Unit& u) const {
        const int L = i * G + c; if (L >= nrt * 2) return false;
        u.pm = L >> 1; u.pn = L & 1; u.aux = 0; u.a = A + (size_t)u.pm * 256 * DSSM * 2; u.b = B + (size_t)u.pn * 256 * DSSM * 2; return true; }
};
struct SchedOut {
    const char* A; const char* B; int G, c, nrt;
    __device__ __forceinline__ bool next(int i, Unit& u) const {
        const int L = i * G + c; if (L >= nrt * 8) return false;
        u.pm = (L >> 6) * 8 + (L & 7); u.pn = (L & 63) >> 3; u.aux = 0; u.a = A + (size_t)u.pm * 256 * DM * 2; u.b = B + (size_t)u.pn * 256 * DM * 2; return true; }
};
struct SchedMoe {
    const char* A; const char* B; int G, c, nct, layer;
    __device__ __forceinline__ bool next(int i, Unit& u) const {
        const int L = i * G + c, per = 8 * nct, nlat = NE * per; int e, rtile, ct;
        if (L < nlat) { e = L / per; const int w = L % per; ct = (w >> 5) * 4 + (w & 3); rtile = e * 8 + ((w & 31) >> 2); }
        else { const int j = L - nlat; if (layer != 0 || j >= NE * nct) return false; e = j / nct; ct = j % nct; rtile = NE * 8 + e; }
        u.pm = rtile; u.pn = ct; u.aux = e; u.a = A + (size_t)rtile * 256 * 2048; u.b = B + ((size_t)e * nct + ct) * 256 * 2048; return true; }
};

struct CvtItem { const float* src; unsigned char* dst; int N, ldwt, fp8; };
__device__ __forceinline__ void cvt_decode(Frame& F, long it, CvtItem& d) {
    constexpr long I_EXP = 32 * 64;
    constexpr long N_GATE = 2L * NE * I_EXP, N_WIN = 2L * 32 * 160, N_WOUT = 2L * I_EXP;
    long r = it;
    if (r < 2 * N_GATE) {
        const int kind = r >= N_GATE; if (kind) r -= N_GATE;
        const int le = (int)(r / I_EXP), q = (int)(r % I_EXP), kb = q >> 6, n0 = (q & 63) * 32;
        d.src = F.in[kind ? I_WU : I_WG] + (size_t)le * DM * DF + (size_t)(kb * 64) * DF + n0; d.N = DF; d.ldwt = DM; d.fp8 = 1;
        d.dst = WSP(unsigned char, WS_WGU) + ((size_t)le * 4096 + (n0 >> 7) * 256 + kind * 128 + (n0 & 127)) * DM + kb * 64; return; }
    r -= 2 * N_GATE;
    if (r < N_GATE) { const int le = (int)(r / I_EXP), q = (int)(r % I_EXP), kb = q >> 6, n0 = (q & 63) * 32;
        d.src = F.in[I_WD] + (size_t)le * DF * DM + (size_t)(kb * 64) * DM + n0; d.N = DM; d.ldwt = DF; d.fp8 = 1;
        d.dst = WSP(unsigned char, WS_WDN) + ((size_t)le * DM + n0) * DF + kb * 64; return; }
    r -= N_GATE; d.fp8 = 0;
    if (r < N_WIN) { const int l = (int)(r / (32 * 160)), q = (int)(r % (32 * 160)), kb = q / 160, n0 = (q % 160) * 32;
        d.src = F.in[I_WIN] + (size_t)l * DM * DINP + (size_t)(kb * 64) * DINP + n0; d.N = DINP; d.ldwt = DM * 2;
        d.dst = (unsigned char*)(WSP(bf16, WS_WIN) + ((size_t)l * DINP + n0) * DM + kb * 64); return; }
    r -= N_WIN;
    if (r < N_WOUT) { const int l = (int)(r / I_EXP), q = (int)(r % I_EXP), kb = q >> 6, n0 = (q & 63) * 32;
        d.src = F.in[I_WOUT] + (size_t)l * DM * DM + (size_t)(kb * 64) * DM + n0; d.N = DM; d.ldwt = DM * 2;
        d.dst = (unsigned char*)(WSP(bf16, WS_WOUT) + ((size_t)l * DM + n0) * DM + kb * 64); return; }
    r -= N_WOUT;
    { const int l = (int)(r / 128), q = (int)(r % 128), kb = q >> 4, n0 = (q & 15) * 32;
        d.src = F.in[I_WGLU] + (size_t)l * DSSM * DSSM + (size_t)(kb * 64) * DSSM + n0; d.N = DSSM; d.ldwt = DSSM * 2;
        d.dst = (unsigned char*)(WSP(bf16, WS_WGLU) + ((size_t)l * DSSM + n0) * DSSM + kb * 64); }
}
__device__ __forceinline__ void cvt_load(const CvtItem& d, int lane, float (&t)[32]) {
    const float* src = d.src + (size_t)(lane >> 5) * d.N + (lane & 31);
#pragma unroll
    for (int i = 0; i < 32; ++i) t[i] = *(const GAS float*)(src + (size_t)(2 * i) * d.N);
}
template <bool FP8>
__device__ __forceinline__ void cvt_store(const CvtItem& d, LAS float* scr, int lane, const float (&t)[32]) {
    constexpr float sc = FP8 ? FP8_SW : 1.0f;
#pragma unroll
    for (int i = 0; i < 32; ++i) scr[(2 * i + (lane >> 5)) * 33 + (lane & 31)] = t[i] * sc;
    LDS_WAIT(); asm volatile("" ::: "memory");
    const int c = lane & 7;
#pragma unroll
    for (int j = 0; j < 4; ++j) { const int n = (lane >> 3) + 8 * j; const LAS float* s = scr + (8 * c) * 33 + n;
        const float v0 = s[0 * 33], v1 = s[1 * 33], v2 = s[2 * 33], v3 = s[3 * 33], v4 = s[4 * 33], v5 = s[5 * 33], v6 = s[6 * 33], v7 = s[7 * 33];
        if constexpr (FP8) { v2u o; o.x = pk4_fp8(v0, v1, v2, v3); o.y = pk4_fp8(v4, v5, v6, v7); *(GAS v2u*)(d.dst + (size_t)n * d.ldwt + 8 * c) = o; }
        else { v4u o; o.x = pk2(v0, v1); o.y = pk2(v2, v3); o.z = pk2(v4, v5); o.w = pk2(v6, v7); *(GAS v4u*)(d.dst + (size_t)n * d.ldwt + 16 * c) = o; } }
    LDS_WAIT(); asm volatile("" ::: "memory");
}
constexpr long CVT_NFP8 = 3L * (2L * NE * 2048), CVT_NITEMS = CVT_NFP8 + 2L * 32 * 160 + 2L * 2048 + 2L * 128;
#ifndef CVT_TB
#define CVT_TB 24576
#endif
constexpr long CVT_TA = CVT_NFP8 - CVT_TB; constexpr int NB_MOD = 192;
__device__ __forceinline__ long cvt_fp8_item_of(Frame& F, int k) {
    const long gw = (long)F.vcu * NWAVES + F.wave, NGW = (long)F.G * NWAVES;
    const int nA = gw < CVT_TA ? (int)((CVT_TA - gw + NGW - 1) / NGW) : 0;
    if (k < nA) return gw + (long)k * NGW;
    if (F.vcu >= NB_MOD) return -1;
    const long it = CVT_TA + gw + (long)(k - nA) * (NB_MOD * NWAVES); return it < CVT_NFP8 ? it : -1;
}
__device__ __forceinline__ long cvt_bf16_item_of(Frame& F, int k) {
    const long it = CVT_NFP8 + (long)F.vcu * NWAVES + F.wave + (long)k * F.G * NWAVES; return it < CVT_NITEMS ? it : -1;
}
template <bool FP8>
__device__ __forceinline__ void cvt_run(Frame& F, LAS float* scr) {
    CvtItem A, B; float ta[32], tb[32]; int k = 0;
    long ia = FP8 ? cvt_fp8_item_of(F, k++) : cvt_bf16_item_of(F, k++);
    if (ia < 0) return;
    cvt_decode(F, ia, A); cvt_load(A, F.lane, ta);
    for (;;) {
        long ib = FP8 ? cvt_fp8_item_of(F, k++) : cvt_bf16_item_of(F, k++); const bool vb = ib >= 0; ib = vb ? ib : ia;
        cvt_decode(F, ib, B); cvt_load(B, F.lane, tb);
        cvt_store<FP8>(A, scr, F.lane, ta);
        if (!vb) break;
        ia = FP8 ? cvt_fp8_item_of(F, k++) : cvt_bf16_item_of(F, k++); const bool va = ia >= 0; ia = va ? ia : ib;
        cvt_decode(F, ia, A); cvt_load(A, F.lane, ta);
        cvt_store<FP8>(B, scr, F.lane, tb);
        if (!va) break;
    }
}
__device__ __forceinline__ void p0_convert_weights(Frame& F) {
    LAS float* scr = (LAS float*)(F.lds + F.wave * 16384);
    cvt_run<true>(F, scr);
    cvt_run<false>(F, scr);
    __syncthreads();
}
__device__ __forceinline__ void p0_mod_task(Frame& F, int task) {
    const int l = task / 96, n0 = (task % 96) * 128;
    LAS float* sc = (LAS float*)F.lds;
    LAS float* red = (LAS float*)(F.lds + 9 * 2048 * 4);
    for (int i = F.tid; i < 9 * DM; i += 512) { const int r = i >> 11, k = i & 2047; const float v = r < 8 ? F.in[I_C][r * DM + k] : F.in[I_CCTX][k]; sc[i] = v * sigmoidf_(v); }
    __syncthreads();
    const float* W = F.in[I_ADAW] + (size_t)l * DM * 6 * DM + n0 + 2 * F.lane;
    float acc[9][2];
#pragma unroll
    for (int r = 0; r < 9; ++r) { acc[r][0] = 0.f; acc[r][1] = 0.f; }
    const int kbase = F.wave * 256;
#pragma unroll 4
    for (int kk = 0; kk < 256; ++kk) { const int k = kbase + kk; const f32x2 w = *(const GAS f32x2*)(W + (size_t)k * (6 * DM));
#pragma unroll
        for (int r = 0; r < 9; ++r) { const float s = sc[r * DM + k]; acc[r][0] += s * w.x; acc[r][1] += s * w.y; } }
#pragma unroll
    for (int r = 0; r < 9; ++r) { red[(F.wave * 9 + r) * 128 + 2 * F.lane] = acc[r][0]; red[(F.wave * 9 + r) * 128 + 2 * F.lane + 1] = acc[r][1]; }
    __syncthreads();
    float* mod = WSP(float, WS_MOD) + (size_t)l * 9 * 6 * DM;
    for (int i = F.tid; i < 9 * 128; i += 512) { const int r = i >> 7, n = i & 127; float s = F.in[I_ADAB][(size_t)l * 6 * DM + n0 + n];
#pragma unroll
        for (int w = 0; w < 8; ++w) s += red[(w * 9 + r) * 128 + n];
        mod[(size_t)r * 6 * DM + n0 + n] = s; }
    __syncthreads();
}
__device__ __forceinline__ void p0_s5_task(Frame& F, int task) {
    const int l = task >> 5, g = task & 31;
    LAS f32x2* PW = (LAS f32x2*)F.lds;
    LAS f32x2* BB = (LAS f32x2*)(F.lds + 33280);
    LAS f32x2* CC = (LAS f32x2*)(F.lds + 41472);
    LAS float* KD = (LAS float*)(F.lds + 49664);
    LAS bf16* KT = (LAS bf16*)(F.lds + 50688);
    bf16* WF = WSP(bf16, WS_WF) + (size_t)(l * NG + g) * 256 * 1024;
    bf16* W2 = WSP(bf16, WS_W2) + (size_t)(l * NG + g) * 1024 * KS2;
    for (int d = 0; d < 2; ++d) {
        const int ldg = (l * 2 + d) * NG + g;
        if (F.tid < 64) { const int p = F.tid;
            const double lr = (double)F.in[I_LRE][ldg * SP + p], li = (double)F.in[I_LIM][ldg * SP + p], dt = exp((double)F.in[I_LDT][ldg]);
            const double mag = exp(lr * dt), ar = mag * cos(li * dt), ai = mag * sin(li * dt), den = lr * lr + li * li, nr = ar - 1.0;
            const double kr = (nr * lr + ai * li) / den, ki = (ai * lr - nr * li) / den;
            double pr = 1.0, pi = 0.0;
            for (int e = 0; e <= 64; ++e) { PW[e * 64 + p] = (f32x2){(float)pr, (float)pi}; const double t = pr * ar - pi * ai; pi = pr * ai + pi * ar; pr = t; }
            if (true) { const f32x2 lt = PW[64 * 64 + p]; WSP(f32x2, WS_LT)[((l * NG + g) * 2 + d) * 64 + p] = lt; }
            for (int i = 0; i < SG; ++i) { const double br = (double)F.in[I_BRE][((size_t)ldg * SP + p) * SG + i], bi = (double)F.in[I_BIM][((size_t)ldg * SP + p) * SG + i];
                BB[p * 16 + i] = (f32x2){(float)(kr * br - ki * bi), (float)(kr * bi + ki * br)}; } }
        for (int i = F.tid; i < 1024; i += 512) CC[i] = (f32x2){F.in[I_CRE][(size_t)ldg * 1024 + i], F.in[I_CIM][(size_t)ldg * 1024 + i]};
        __syncthreads();
        { const int ph = F.tid & 1, q = F.tid >> 1, o = q >> 4, i = q & 15;
            float cbr[32], cbi[32];
#pragma unroll
            for (int p = 0; p < 32; ++p) { const f32x2 c = CC[o * 64 + ph * 32 + p], b = BB[(ph * 32 + p) * 16 + i]; cbr[p] = c.x * b.x - c.y * b.y; cbi[p] = c.x * b.y + c.y * b.x; }
#pragma unroll 1
            for (int j = 0; j < 64; ++j) { float s = 0.f;
#pragma unroll
                for (int p = 0; p < 32; ++p) { const f32x2 P = PW[j * 64 + ph * 32 + p]; s += cbr[p] * P.x - cbi[p] * P.y; }
                s += __shfl_xor(s, 1);
                if (ph == 0) { if (j == 0) { if (d == 0) KD[q] = s; else { s += KD[q]; KT[q] = (bf16)f2bf(s); } }
                               else KT[(d * 64 + j) * 256 + q] = (bf16)f2bf(s); } } }
        for (int it = F.tid; it < 128 * 128; it += 512) { const int n = it >> 7, k8 = it & 127, ri = n >> 6, p = n & 63, s = k8 >> 1, i0 = (k8 & 1) * 8, e = d == 0 ? 63 - s : s;
            const f32x2 P = PW[e * 64 + p]; float v[8];
#pragma unroll
            for (int j = 0; j < 8; ++j) { const f32x2 b = BB[p * 16 + i0 + j]; v[j] = ri == 0 ? (P.x * b.x - P.y * b.y) : (P.x * b.y + P.y * b.x); }
            v4u o; o.x = pk2(v[0], v[1]); o.y = pk2(v[2], v[3]); o.z = pk2(v[4], v[5]); o.w = pk2(v[6], v[7]);
            *(GAS v4u*)(WF + (size_t)(d * 128 + n) * 1024 + k8 * 8) = o; }
        for (int it = F.tid; it < 1024 * 16; it += 512) { const int n = it >> 4, c8 = it & 15, ri = c8 >> 3, p0 = (c8 & 7) * 8, t = n >> 4, o = n & 15, e = d == 0 ? t + 1 : 64 - t; float v[8];
#pragma unroll
            for (int j = 0; j < 8; ++j) { const f32x2 c = CC[o * 64 + p0 + j], P = PW[e * 64 + p0 + j]; v[j] = ri == 0 ? (c.x * P.x - c.y * P.y) : -(c.x * P.y + c.y * P.x); }
            v4u ov; ov.x = pk2(v[0], v[1]); ov.y = pk2(v[2], v[3]); ov.z = pk2(v[4], v[5]); ov.w = pk2(v[6], v[7]);
            *(GAS v4u*)(W2 + (size_t)n * KS2 + 1024 + d * 128 + c8 * 8) = ov; }
        __syncthreads();
    }
    for (int it = F.tid; it < 1024 * 128; it += 512) { const int n = it >> 7, k8 = it & 127, t = n >> 4, o = n & 15, s = k8 >> 1, i0 = (k8 & 1) * 8;
        const int dsel = s <= t ? 0 : 1, j = s <= t ? t - s : s - t;
        const v4u kv = *(const LAS v4u*)(KT + (dsel * 64 + j) * 256 + o * 16 + i0);
        *(GAS v4u*)(W2 + (size_t)n * KS2 + k8 * 8) = kv; }
    __syncthreads();
}
__device__ __forceinline__ void p0_router_t(Frame& F) {
    for (int i = (F.vcu * 512 + F.tid); i < 2 * 16 * DM; i += F.G * 512) { const int l = i >> 15, e = (i >> 11) & 15, k = i & 2047; WSP(float, WS_RWT)[i] = F.in[I_RW][((size_t)l * DM + k) * NE + e]; }
}

__device__ __forceinline__ int mbcnt64(unsigned long long m) { return (int)__builtin_amdgcn_mbcnt_hi((unsigned)(m >> 32), __builtin_amdgcn_mbcnt_lo((unsigned)m, 0u)); }
__device__ __forceinline__ void combine_row(Frame& F, int r, const float* g2, f32x4 (&x)[8]) {
    const int* sel = WSP(int, WS_SEL) + (size_t)r * NE; const float* vals = WSP(float, WS_VALS); const bf16* Y = WSP(bf16, WS_R1);
    const int mysel = F.lane < NE ? *(const GAS int*)(sel + F.lane) : -1;
    unsigned long long m = __ballot(mysel >= 0);
    f32x4 macc[8];
#pragma unroll
    for (int j = 0; j < 8; ++j) macc[j] = (f32x4){0.f, 0.f, 0.f, 0.f};
    while (m) { const int e = __builtin_ctzll(m); m &= m - 1;
        const int y = __builtin_amdgcn_readlane(mysel, e); const float val = *(const GAS float*)(vals + y); const bf16* yr = Y + (size_t)y * DM + 4 * F.lane;
#pragma unroll
        for (int j = 0; j < 8; ++j) { const v2u w = *(const GAS v2u*)(yr + j * 256); macc[j] += val * (f32x4){bflo(w.x), bfhi(w.x), bflo(w.y), bfhi(w.y)}; } }
#pragma unroll
    for (int j = 0; j < 8; ++j) x[j] += *(const GAS f32x4*)(g2 + j * 256 + 4 * F.lane) * macc[j];
}
__device__ __forceinline__ float row_rs(const f32x4 (&x)[8]) {
    float s = 0.f;
#pragma unroll
    for (int j = 0; j < 8; ++j) s += (x[j][0] * x[j][0] + x[j][1] * x[j][1]) + (x[j][2] * x[j][2] + x[j][3] * x[j][3]);
    return 1.0f / sqrtf(wave_sum(s) * (1.0f / DM) + EPS);
}
__device__ __forceinline__ void phase_norm1(Frame& F, int l) {
    const float* modl = WSP(float, WS_MOD) + (size_t)l * 9 * 6 * DM; const float* gn = F.in[I_N1G] + (size_t)l * DM;
    for (int r = F.vcu * NWAVES + F.wave; r < MT; r += F.G * NWAVES) {
        const int rb = r < ML ? (r >> 11) : 8;
        const float* xr = l == 0 ? (r < ML ? F.in[I_X] + (size_t)r * DM : F.in[I_CTX] + (size_t)(r - ML) * DM) : WSP(float, WS_XM) + (size_t)r * DM;
        f32x4 x[8];
#pragma unroll
        for (int j = 0; j < 8; ++j) x[j] = *(const GAS f32x4*)(xr + j * 256 + 4 * F.lane);
        if (l == 1) { combine_row(F, r, WSP(float, WS_MOD) + (size_t)(rb * 6 + 5) * DM, x);
            float* xo = WSP(float, WS_XL) + (size_t)r * DM;
#pragma unroll
            for (int j = 0; j < 8; ++j) *(GAS f32x4*)(xo + j * 256 + 4 * F.lane) = x[j]; }
        const float rs = row_rs(x); const float* sh = modl + (size_t)(rb * 6 + 0) * DM; const float* sc = modl + (size_t)(rb * 6 + 1) * DM;
        bf16* ho = WSP(bf16, WS_H) + (size_t)r * DM;
#pragma unroll
        for (int j = 0; j < 8; ++j) { const int c = j * 256 + 4 * F.lane; const f32x4 g = *(const GAS f32x4*)(gn + c), s1 = *(const GAS f32x4*)(sc + c), s0 = *(const GAS f32x4*)(sh + c);
            const f32x4 h = x[j] * rs * g * (1.0f + s1) + s0; v2u w; w.x = pk2(h[0], h[1]); w.y = pk2(h[2], h[3]); *(GAS v2u*)(ho + c) = w; }
    }
}
__device__ __forceinline__ void phase_final(Frame& F) {
    const float* gn = F.in[I_FNG];
    for (int r = F.vcu * NWAVES + F.wave; r < ML; r += F.G * NWAVES) {
        const int rb = r >> 11; const float* xr = WSP(float, WS_XM) + (size_t)r * DM;
        f32x4 x[8];
#pragma unroll
        for (int j = 0; j < 8; ++j) x[j] = *(const GAS f32x4*)(xr + j * 256 + 4 * F.lane);
        combine_row(F, r, WSP(float, WS_MOD) + (size_t)((9 + rb) * 6 + 5) * DM, x);
        const float rs = row_rs(x); float* o = F.out + (size_t)r * DM;
#pragma unroll
        for (int j = 0; j < 8; ++j) { const int c = j * 256 + 4 * F.lane; *(GAS f32x4*)(o + c) = x[j] * rs * *(const GAS f32x4*)(gn + c); }
    }
}
__device__ __forceinline__ void phase_norm2(Frame& F, int l) {
    LAS float* rwt = (LAS float*)F.lds;
    { const float* src = WSP(float, WS_RWT) + (size_t)l * NE * DM;
        for (int i = F.tid; i < NE * DM / 4; i += 512) *(LAS f32x4*)(rwt + 4 * i) = *(const GAS f32x4*)(src + 4 * i); }
    __syncthreads();
    const float* modl = WSP(float, WS_MOD) + (size_t)l * 9 * 6 * DM; const float* gn = F.in[I_N2G] + (size_t)l * DM;
    const int nrows = l == 0 ? MT : ML;
    for (int r = F.vcu * NWAVES + F.wave; r < nrows; r += F.G * NWAVES) {
        const int rb = r < ML ? (r >> 11) : 8; const float* xr = WSP(float, WS_XM) + (size_t)r * DM;
        f32x4 x[8];
#pragma unroll
        for (int j = 0; j < 8; ++j) x[j] = *(const GAS f32x4*)(xr + j * 256 + 4 * F.lane);
        const float rs = row_rs(x); const float* sh = modl + (size_t)(rb * 6 + 3) * DM; const float* sc = modl + (size_t)(rb * 6 + 4) * DM;
        unsigned char* ho = WSP(unsigned char, WS_H) + (size_t)r * DM;
#pragma unroll
        for (int j = 0; j < 8; ++j) { const int c = j * 256 + 4 * F.lane; const f32x4 g = *(const GAS f32x4*)(gn + c), s1 = *(const GAS f32x4*)(sc + c), s0 = *(const GAS f32x4*)(sh + c);
            x[j] = x[j] * rs * g * (1.0f + s1) + s0; *(GAS unsigned*)(ho + c) = pk4_fp8(x[j][0] * FP8_SH, x[j][1] * FP8_SH, x[j][2] * FP8_SH, x[j][3] * FP8_SH); }
        float p[NE];
#pragma unroll
        for (int eg = 0; eg < NE; eg += 2) { float s0 = 0.f, s1 = 0.f;
#pragma unroll
            for (int j = 0; j < 8; ++j) { const f32x4 w0 = *(const LAS f32x4*)(rwt + eg * DM + j * 256 + 4 * F.lane), w1 = *(const LAS f32x4*)(rwt + (eg + 1) * DM + j * 256 + 4 * F.lane);
                s0 += (x[j][0] * w0[0] + x[j][1] * w0[1]) + (x[j][2] * w0[2] + x[j][3] * w0[3]); s1 += (x[j][0] * w1[0] + x[j][1] * w1[1]) + (x[j][2] * w1[2] + x[j][3] * w1[3]); }
            p[eg] = s0; p[eg + 1] = s1; __builtin_amdgcn_sched_barrier(0); }
        const bool b5 = (F.lane & 32) != 0, b4 = (F.lane & 16) != 0, b3 = (F.lane & 8) != 0, b2 = (F.lane & 4) != 0;
        float q8[8], q4[4], q2[2];
#pragma unroll
        for (int i = 0; i < 8; ++i) { const float keep = b5 ? p[i + 8] : p[i], give = b5 ? p[i] : p[i + 8]; q8[i] = keep + __shfl_xor(give, 32); }
#pragma unroll
        for (int i = 0; i < 4; ++i) { const float keep = b4 ? q8[i + 4] : q8[i], give = b4 ? q8[i] : q8[i + 4]; q4[i] = keep + __shfl_xor(give, 16); }
#pragma unroll
        for (int i = 0; i < 2; ++i) { const float keep = b3 ? q4[i + 2] : q4[i], give = b3 ? q4[i] : q4[i + 2]; q2[i] = keep + __shfl_xor(give, 8); }
        float lg; { const float keep = b2 ? q2[1] : q2[0], give = b2 ? q2[0] : q2[1]; lg = keep + __shfl_xor(give, 4); }
        lg += __shfl_xor(lg, 2); lg += __shfl_xor(lg, 1);
        float mx = lg;
        mx = fmaxf(mx, __shfl_xor(mx, 4)); mx = fmaxf(mx, __shfl_xor(mx, 8)); mx = fmaxf(mx, __shfl_xor(mx, 16)); mx = fmaxf(mx, __shfl_xor(mx, 32));
        const float ex = __expf(lg - mx); float den = ex;
        den += __shfl_xor(den, 4); den += __shfl_xor(den, 8); den += __shfl_xor(den, 16); den += __shfl_xor(den, 32);
        const float mine = ex / den; const int ex_id = (F.lane >> 2) & 15;
        if ((F.lane & 3) == 0) { if (r < ML) WSP(float, WS_AFF)[((size_t)(rb * NE + ex_id) << 11) + (r & 2047)] = mine;
                                 else { const int q = r - ML; WSP(float, WS_AFFC)[((size_t)((q >> 8) * NE + ex_id) << 8) + (q & 255)] = mine; } }
    }
    __syncthreads();
}
__device__ __forceinline__ void unpack8(const v4u w, f32x4& lo, f32x4& hi) { lo = (f32x4){bflo(w.x), bfhi(w.x), bflo(w.y), bfhi(w.y)}; hi = (f32x4){bflo(w.z), bfhi(w.z), bflo(w.w), bfhi(w.w)}; }
__device__ __forceinline__ void phase_conv(Frame& F, int l, int nblk) {
    const bf16* P = WSP(bf16, WS_R1); bf16* cc = WSP(bf16, WS_R2);
    const float* cw = F.in[I_CONVW] + (size_t)l * 3 * DCONV; const float* gn = F.in[I_ONCG] + (size_t)l * DCONV;
    f32x4 w[3][3][2], g[3][2];
#pragma unroll
    for (int ch = 0; ch < 3; ++ch) { const int c0 = ch * 512 + 8 * F.lane;
#pragma unroll
        for (int t = 0; t < 3; ++t) { w[ch][t][0] = *(const GAS f32x4*)(cw + t * DCONV + c0); w[ch][t][1] = *(const GAS f32x4*)(cw + t * DCONV + c0 + 4); }
        g[ch][0] = *(const GAS f32x4*)(gn + c0); g[ch][1] = *(const GAS f32x4*)(gn + c0 + 4); }
    const int nrows = l == 0 ? MT : ML;
    for (int r = F.vcu * NWAVES + F.wave; r < nrows; r += nblk * NWAVES) {
        bool hp, hn; if (r < ML) { const int x = r & 63; hp = x > 0; hn = x < 63; } else { const int t = (r - ML) & 255; hp = t > 0; hn = t < 255; }
        const float mp = hp ? 1.f : 0.f, mn = hn ? 1.f : 0.f;
        const bf16* p0 = P + (size_t)r * (3 * DCONV); const bf16* pp = hp ? p0 - 3 * DCONV : p0; const bf16* pn = hn ? p0 + 3 * DCONV : p0;
        v4u raw[3][7];
#pragma unroll
        for (int ch = 0; ch < 3; ++ch) { const int c0 = ch * 512 + 8 * F.lane;
            raw[ch][0] = *(const GAS v4u*)(p0 + c0); raw[ch][1] = *(const GAS v4u*)(p0 + DCONV + c0); raw[ch][2] = *(const GAS v4u*)(p0 + 2 * DCONV + c0);
            raw[ch][3] = *(const GAS v4u*)(pp + DCONV + c0); raw[ch][4] = *(const GAS v4u*)(pp + 2 * DCONV + c0);
            raw[ch][5] = *(const GAS v4u*)(pn + DCONV + c0); raw[ch][6] = *(const GAS v4u*)(pn + 2 * DCONV + c0); }
#pragma unroll
        for (int ch = 0; ch < 3; ++ch) { const int c0 = ch * 512 + 8 * F.lane;
            f32x4 b0, b1, c0v, c1v, v0, v1, cp0, cp1, vp0, vp1, cn0, cn1, vn0, vn1;
            unpack8(raw[ch][0], b0, b1); unpack8(raw[ch][1], c0v, c1v); unpack8(raw[ch][2], v0, v1); unpack8(raw[ch][3], cp0, cp1); unpack8(raw[ch][4], vp0, vp1); unpack8(raw[ch][5], cn0, cn1); unpack8(raw[ch][6], vn0, vn1);
            const f32x4 y0 = b0 * (w[ch][0][0] * (mp * (cp0 * vp0)) + w[ch][1][0] * (c0v * v0) + w[ch][2][0] * (mn * (cn0 * vn0)));
            const f32x4 y1 = b1 * (w[ch][0][1] * (mp * (cp1 * vp1)) + w[ch][1][1] * (c1v * v1) + w[ch][2][1] * (mn * (cn1 * vn1)));
            float ss = (y0[0] * y0[0] + y0[1] * y0[1]) + (y0[2] * y0[2] + y0[3] * y0[3]) + (y1[0] * y1[0] + y1[1] * y1[1]) + (y1[2] * y1[2] + y1[3] * y1[3]);
            ss += __shfl_xor(ss, 1); ss += __shfl_xor(ss, 2); ss += __shfl_xor(ss, 4); ss += __shfl_xor(ss, 8);
            const float rs = 1.0f / sqrtf(ss * (1.0f / 128.0f) + EPS);
            const f32x4 o0 = y0 * rs * g[ch][0], o1 = y1 * rs * g[ch][1];
            v4u o; o.x = pk2(o0[0], o0[1]); o.y = pk2(o0[2], o0[3]); o.z = pk2(o1[0], o1[1]); o.w = pk2(o1[2], o1[3]);
            *(GAS v4u*)(cc + (size_t)r * DM + c0) = o; }
    }
}
__device__ __forceinline__ void phase_carry(Frame& F, int l) {
    const int gt = F.vcu * 512 + F.tid; if (gt >= NB * NG * 2 * SP) return;
    const int p = gt & 63, d = (gt >> 6) & 1, g = (gt >> 7) & 31, b = gt >> 12;
    const f32x2 lt = WSP(f32x2, WS_LT)[((l * NG + g) * 2 + d) * 64 + p];
    const float* Fb = WSP(float, WS_F); bf16* u2 = WSP(bf16, WS_U2);
    float hr = 0.f, hi = 0.f;
    for (int step = 0; step < 36; ++step) {
        int inst; if (step < 4) inst = 256 + b * 4 + (d == 0 ? step : 3 - step); else inst = b * 32 + (d == 0 ? step - 4 : 35 - step);
        const size_t row = (size_t)g * NINST + inst;
        u2[row * KS2 + 1024 + d * 128 + p] = (bf16)f2bf(hr); u2[row * KS2 + 1024 + d * 128 + 64 + p] = (bf16)f2bf(hi);
        const float fr = *(const GAS float*)(Fb + row * 256 + d * 128 + p), fi = *(const GAS float*)(Fb + row * 256 + d * 128 + 64 + p);
        const float nr = lt.x * hr - lt.y * hi + fr; hi = lt.x * hi + lt.y * hr + fi; hr = nr; }
}
template <int NJ>
__device__ __forceinline__ void topk_wave(Frame& F, const float* aff, int k, int srcrow0, int yrow0, int e, LAS int* idx_lds, LAS unsigned* av) {
#pragma unroll 1
    for (int j = 0; j < NJ; ++j) av[j * 64 + F.lane] = __builtin_bit_cast(unsigned, *(const GAS float*)(aff + j * 64 + F.lane));
    LDS_WAIT();
    unsigned T = 0u;
#pragma unroll 1
    for (int bit = 30; bit >= 0; --bit) { const unsigned cand = T | (1u << bit); int cnt = 0;
#pragma unroll 2
        for (int j = 0; j < NJ; ++j) cnt += (av[j * 64 + F.lane] >= cand) ? 1 : 0;
#pragma unroll
        for (int o = 1; o < 64; o <<= 1) cnt += __shfl_xor(cnt, o);
        if (cnt >= k) T = cand; }
    int ngt = 0, neq = 0;
#pragma unroll 2
    for (int j = 0; j < NJ; ++j) { const unsigned a = av[j * 64 + F.lane]; ngt += (a > T) ? 1 : 0; neq += (a == T) ? 1 : 0; }
    const int packed = (ngt << 16) | neq; int incl = packed;
#pragma unroll
    for (int o = 1; o < 64; o <<= 1) { const int t = __shfl_up(incl, o); incl += (F.lane >= o) ? t : 0; }
    const int excl = incl - packed, pgt = excl >> 16, peq = excl & 0xffff;
    const int need = k - (__builtin_amdgcn_readlane(incl, 63) >> 16);
    int slot = pgt + (peq < need ? peq : need), eqr = peq;
    int* IDX = WSP(int, WS_IDX); float* VALS = WSP(float, WS_VALS); int* SEL = WSP(int, WS_SEL);
#pragma unroll 1
    for (int j = 0; j < NJ; ++j) { const unsigned a = av[j * 64 + F.lane]; const bool gt = a > T, eq = a == T; const bool sl = gt || (eq && eqr < need); eqr += eq ? 1 : 0;
        const int src = srcrow0 + j * 64 + F.lane;
        if (sl) { IDX[yrow0 + slot] = src; VALS[yrow0 + slot] = __builtin_bit_cast(float, a); idx_lds[slot] = src; }
        SEL[(size_t)src * NE + e] = sl ? yrow0 + slot : -1;
        slot += sl ? 1 : 0; }
}
__device__ __forceinline__ void phase_topk(Frame& F, int l) {
    LAS int* idx_lds = (LAS int*)F.lds;
    const int ntask = l == 0 ? 256 : 128;
    for (int task = F.vcu; task < ntask; task += F.G) {
        const bool isctx = task >= 128; const int q = task & 127, b = q >> 4, e = q & 15;
        const int k = isctx ? CAPC : CAPL, yrow0 = isctx ? NE * NB * CAPL + e * (NB * CAPC) + b * CAPC : (e * NB + b) * CAPL;
        if (F.wave == 0) { if (isctx) topk_wave<4>(F, WSP(float, WS_AFFC) + (size_t)(b * NE + e) * CTXL, CAPC, ML + b * CTXL, yrow0, e, idx_lds, (LAS unsigned*)(F.lds + 4096));
                           else topk_wave<32>(F, WSP(float, WS_AFF) + (size_t)(b * NE + e) * SEQL, CAPL, b * SEQL, yrow0, e, idx_lds, (LAS unsigned*)(F.lds + 4096)); }
        LDS_WAIT(); __syncthreads();
        const unsigned char* H = WSP(unsigned char, WS_H); unsigned char* XS = WSP(unsigned char, WS_R1);
        for (int rr = F.wave; rr < k; rr += NWAVES) { const int src = idx_lds[rr]; const unsigned char* s = H + (size_t)src * DM + 16 * F.lane; unsigned char* dst = XS + (size_t)(yrow0 + rr) * DM + 16 * F.lane;
#pragma unroll
            for (int j = 0; j < 2; ++j) *(GAS v4u*)(dst + j * 1024) = *(const GAS v4u*)(s + j * 1024); }
        __syncthreads();
    }
}

template <class T> __device__ __forceinline__ T* opaque_ptr(T* p) { unsigned long long v = (unsigned long long)p; unsigned lo = (unsigned)v, hi = (unsigned)(v >> 32); asm volatile("" : "+v"(lo), "+v"(hi));
    lo = __builtin_amdgcn_readfirstlane(lo); hi = __builtin_amdgcn_readfirstlane(hi); return (T*)(((unsigned long long)hi << 32) | lo); }
__device__ __forceinline__ void launder(Frame& F) { F.ws = opaque_ptr(F.ws); F.out = opaque_ptr(F.out);
    int t = F.tid; asm volatile("" : "+v"(t)); F.tid = t; F.lane = t & 63; F.wave = __builtin_amdgcn_readfirstlane(t >> 6);
    int g = gridDim.x, bx = blockIdx.x; asm volatile("" : "+v"(g), "+v"(bx)); g = __builtin_amdgcn_readfirstlane(g); bx = __builtin_amdgcn_readfirstlane(bx);
    F.G = g; F.vcu = (g % 8 == 0) ? (bx % 8) * (g / 8) + bx / 8 : bx; }
__device__ __forceinline__ void grid_seam(Frame& F) {
    XcdBarrier b; b.bar = (unsigned*)(F.ws + WS_CTL) + CW_BAR; b.x = xb_xcc_id(); b.st = (volatile LAS unsigned*)(F.lds + MISC_OFF) + 8;
    xcd_barrier(b);
}
constexpr int NPHASE = 24;
struct Args { const float* in[27]; float* out; unsigned char* ws; };
#define IN(k) (LO <= (k) && (k) < HI)
#ifndef PROBE_SUB
#define PROBE_SUB 0
#endif
#ifndef PROBE_MASK
#define PROBE_MASK 0u
#endif
#define PHASE(k) if constexpr (IN(k)) for (int rep_ = 0; rep_ < (((PROBE_MASK >> (k)) & 1u) ? 2 : 1); ++rep_)
#define SEAM(k) do { if constexpr (IN(k) && IN((k) + 1)) grid_seam(F); } while (0)
template <int LO, int HI, int l>
__device__ __forceinline__ void layer_phases(Frame& F) {
    constexpr int pb = 1 + 11 * l;
    PHASE(pb + 0) { launder(F); phase_norm1(F, l); }
    SEAM(pb + 0);
    PHASE(pb + 1) {
        launder(F);
        SchedProj S{(const char*)WSP(bf16, WS_H), (const char*)(WSP(bf16, WS_WIN) + (size_t)l * DINP * DM), F.G, F.vcu, l};
        EpiProj E{WSP(bf16, WS_R1), WSP(bf16, WS_U2)};
        pg8::gemm_phase<EpiProj, SchedProj, true>(F.lds, F.tid, pg8::Dims{DM * 2, DM * 2, DM * 2}, S, E);
    }
    SEAM(pb + 1);
    PHASE(pb + 2) {
        launder(F);
        if (F.vcu < F.G - 64) phase_conv(F, l, F.G - 64);
        else { SchedF S{(const char*)WSP(bf16, WS_U2), (const char*)(WSP(bf16, WS_WF) + (size_t)l * NG * 256 * 1024), F.G, F.vcu};
            EpiF32 E{WSP(float, WS_F), 256, (size_t)NINST * 256};
            pg8::gemm_phase<EpiF32, SchedF, false>(F.lds, F.tid, pg8::Dims{KS2 * 2, 1024 * 2, 1024 * 2}, S, E); }
    }
    SEAM(pb + 2);
    PHASE(pb + 3) { launder(F); phase_carry(F, l); }
    SEAM(pb + 3);
    PHASE(pb + 4) {
        launder(F);
        SchedS2 S{(const char*)WSP(bf16, WS_U2), (const char*)(WSP(bf16, WS_W2) + (size_t)l * NG * 1024 * KS2), F.G, F.vcu, l};
        EpiS2 E{WSP(bf16, WS_U2), F.in[I_SSMD] + (size_t)l * DSSM, WSP(bf16, WS_Z)};
        pg8::gemm_phase<EpiS2, SchedS2, true>(F.lds, F.tid, pg8::Dims{KS2 * 2, KS2 * 2, KS2 * 2}, S, E);
    }
    SEAM(pb + 4);
    PHASE(pb + 5) {
        launder(F);
        SchedGlu S{(const char*)WSP(bf16, WS_Z), (const char*)(WSP(bf16, WS_WGLU) + (size_t)l * DSSM * DSSM), F.G, F.vcu, l == 0 ? 72 : 64};
        EpiGlu E{WSP(bf16, WS_Z), F.in[I_ONSG] + (size_t)l * DSSM, WSP(bf16, WS_R2)};
        if (F.G >= 144) pg8::gemm_phase<EpiGlu, SchedGlu, false>(F.lds, F.tid, pg8::Dims{DSSM * 2, DSSM * 2, DSSM * 2}, S, E);
    }
    SEAM(pb + 5);
    PHASE(pb + 6) {
        launder(F);
        SchedOut S{(const char*)WSP(bf16, WS_R2), (const char*)(WSP(bf16, WS_WOUT) + (size_t)l * DM * DM), F.G, F.vcu, l == 0 ? 72 : 64};
        EpiOut E{l == 0 ? F.in[I_X] : WSP(float, WS_XL), l == 0 ? F.in[I_CTX] : WSP(float, WS_XL) + (size_t)ML * DM, WSP(float, WS_MOD) + (size_t)l * 9 * 6 * DM, WSP(float, WS_XM)};
        pg8::gemm_phase<EpiOut, SchedOut, true>(F.lds, F.tid, pg8::Dims{DM * 2, DM * 2, DM * 2}, S, E);
    }
    SEAM(pb + 6);
    PHASE(pb + 7) { launder(F); phase_norm2(F, l); }
    SEAM(pb + 7);
    PHASE(pb + 8) { launder(F); phase_topk(F, l); }
    SEAM(pb + 8);
    PHASE(pb + 9) {
        launder(F);
        SchedMoe S{(const char*)WSP(unsigned char, WS_R1), (const char*)(WSP(unsigned char, WS_WGU) + (size_t)l * NE * 4096 * DM), F.G, F.vcu, 16, l};
        EpiMoe1 E{WSP(unsigned char, WS_R2)};
        pg8::gemm_phase<EpiMoe1, SchedMoe, true, true>(F.lds, F.tid, pg8::Dims{DM, DM, DM}, S, E);
    }
    SEAM(pb + 9);
    PHASE(pb + 10) {
        launder(F);
        SchedMoe S{(const char*)WSP(unsigned char, WS_R2), (const char*)(WSP(unsigned char, WS_WDN) + (size_t)l * NE * DM * DF), F.G, F.vcu, 8, l};
        EpiBf16 E{WSP(bf16, WS_R1), DM, 1.0f / (FP8_SW * FP8_SA)};
        pg8::gemm_phase<EpiBf16, SchedMoe, true, true>(F.lds, F.tid, pg8::Dims{DF, DF, DF}, S, E);
    }
    SEAM(pb + 10);
}
template <int LO, int HI>
__global__ void __launch_bounds__(NWAVES * 64, 2) trunk_fwd(Args args) {
    extern __shared__ __attribute__((aligned(16))) unsigned char lds[];
    Frame F;
    F.lds = (LAS unsigned char*)lds;
    F.tid = threadIdx.x; F.lane = F.tid & 63; F.wave = __builtin_amdgcn_readfirstlane(F.tid >> 6);
    F.G = gridDim.x; { const int bx = blockIdx.x; F.vcu = (F.G % 8 == 0) ? (bx % 8) * (F.G / 8) + bx / 8 : bx; }
    F.ws = args.ws; F.out = args.out; F.in = args.in;
    for (int u = F.tid; u < (LDS_BYTES - LDSCTL_OFF) / 4; u += NWAVES * 64) ((LAS unsigned*)(F.lds + LDSCTL_OFF))[u] = 0u;
    __syncthreads();
    if constexpr (HI - LO > 1) (void)xcd_barrier_post((unsigned*)(F.ws + WS_CTL) + CW_BAR, (volatile LAS unsigned*)(F.lds + MISC_OFF) + 8);

    PHASE(0) {
        launder(F);
        for (int q_ = 0; q_ < ((PROBE_SUB & 1) ? 2 : 1); ++q_) if (F.vcu < 192) { for (int t = F.vcu; t < 192; t += 192) p0_mod_task(F, t); }
        for (int q_ = 0; q_ < ((PROBE_SUB & 2) ? 2 : 1); ++q_) if (F.vcu >= 192) { for (int t = F.vcu - 192; t < 64; t += F.G - 192) p0_s5_task(F, t); }
        p0_router_t(F);
        for (int q_ = 0; q_ < ((PROBE_SUB & 4) ? 2 : 1); ++q_) p0_convert_weights(F);
    }
    SEAM(0);
    layer_phases<LO, HI, 0>(F);
    layer_phases<LO, HI, 1>(F);
    PHASE(23) { launder(F); phase_final(F); }
}
#undef IN
#undef PHASE
#undef SEAM

template <int P> static void launch_phase(int grid, hipStream_t stream, const Args& a) {
    hipLaunchKernelGGL((trunk_fwd<P, P + 1>), dim3(grid), dim3(NWAVES * 64), LDS_BYTES, stream, a);
}
template <int P> static void set_attr_phase() { (void)hipFuncSetAttribute((const void*)trunk_fwd<P, P + 1>, hipFuncAttributeMaxDynamicSharedMemorySize, LDS_BYTES); }
template <int... Ps> static void launch_all(std::integer_sequence<int, Ps...>, int grid, hipStream_t stream, const Args& a) { (launch_phase<Ps>(grid, stream, a), ...); }
template <int... Ps> static void set_attr_all(std::integer_sequence<int, Ps...>) { (set_attr_phase<Ps>(), ...); }
extern "C" void kernel_launch(void* const* d_in, const int* in_sizes, int n_in, void* d_out, int out_size, void* d_ws, size_t ws_size, hipStream_t stream) {
    static int grid = 0;
    if (grid == 0) {
        if (n_in != 27 || out_size != ML * DM || ws_size < WS_END) { fprintf(stderr, "kernel_launch: expected 27 inputs, %d outputs, >= %zu workspace bytes; got %d, %d, %zu\n", ML * DM, (size_t)WS_END, n_in, out_size, ws_size); grid = -1; return; }
        int dev = 0, cus = 0, per_cu = 0;
        if (hipGetDevice(&dev) != hipSuccess || hipDeviceGetAttribute(&cus, hipDeviceAttributeMultiprocessorCount, dev) != hipSuccess) { grid = -1; return; }
#if MK_N_LAUNCHES == 1
        if (hipFuncSetAttribute((const void*)trunk_fwd<0, NPHASE>, hipFuncAttributeMaxDynamicSharedMemorySize, LDS_BYTES) != hipSuccess) { fprintf(stderr, "kernel_launch: hipFuncSetAttribute failed\n"); grid = -1; return; }
        if (hipOccupancyMaxActiveBlocksPerMultiprocessor(&per_cu, (const void*)trunk_fwd<0, NPHASE>, NWAVES * 64, LDS_BYTES) != hipSuccess || per_cu < 1) fprintf(stderr, "kernel_launch: occupancy query reports %d\n", per_cu);
#else
        set_attr_all(std::make_integer_sequence<int, NPHASE>{});
#endif
        (void)hipGetLastError();
        grid = cus;
        if (grid < 256 || grid % 8 != 0) { fprintf(stderr, "kernel_launch: unexpected CU count %d\n", cus); }
    }
    if (grid < 0) return;
    (void)hipMemsetAsync((char*)d_ws + WS_CTL, 0, CTL_ZERO_BYTES, stream);
    Args a{};
    for (int i = 0; i < 27; ++i) a.in[i] = (const float*)d_in[i];
    a.out = (float*)d_out; a.ws = (unsigned char*)d_ws;
#if MK_N_LAUNCHES == 1
    hipLaunchKernelGGL((trunk_fwd<0, NPHASE>), dim3(grid), dim3(NWAVES * 64), LDS_BYTES, stream, a);
#else
    launch_all(std::make_integer_sequence<int, NPHASE>{}, grid, stream, a);
#endif
    const hipError_t le = hipPeekAtLastError();
    if (le != hipSuccess) fprintf(stderr, "kernel_launch: launch failed: %s\n", hipGetErrorName(le));
}
```

```cpp
#include <hip/hip_runtime.h>
#include <cstdio>
#include <cstdint>
#include <utility>

#define GAS __attribute__((address_space(1)))
#define LAS __attribute__((address_space(3)))
typedef unsigned short bf16;
typedef unsigned v4u __attribute__((ext_vector_type(4)));
typedef unsigned v2u __attribute__((ext_vector_type(2)));
typedef float f32x4 __attribute__((ext_vector_type(4)));
typedef float f32x2 __attribute__((ext_vector_type(2)));
typedef short bf16x8 __attribute__((ext_vector_type(8)));
typedef GAS unsigned gu32;

#ifndef MK_N_LAUNCHES
#define MK_N_LAUNCHES 1
#endif

constexpr int NB = 8, SEQL = 2048, CTXL = 256, DM = 2048;
constexpr int ML = NB * SEQL, MC = NB * CTXL, MT = ML + MC;
constexpr int DCONV = 1536, DSSM = 512, DINP = 3 * DCONV + DSSM;
constexpr int NG = 32, SG = 16, SP = 64, TCH = 64;
constexpr int NE = 16, DF = 2048, CAPL = 256, CAPC = 32;
constexpr int NINST = 512, KS2 = 1280;
constexpr int YROWS = NE * NB * CAPL + NE * NB * CAPC;
constexpr float EPS = 1e-6f;

constexpr size_t MiB = 1u << 20;
constexpr size_t WS_CTL = 0, CTL_ZERO_BYTES = 1 * MiB;
constexpr size_t WS_MOD = 1 * MiB;
constexpr size_t WS_RWT = 2 * MiB;
constexpr size_t WS_LT = 2 * MiB + 512 * 1024;
constexpr size_t WS_AFF = 3 * MiB;
constexpr size_t WS_AFFC = 4 * MiB;
constexpr size_t WS_IDX = 5 * MiB;
constexpr size_t WS_VALS = 5 * MiB + 256 * 1024;
constexpr size_t WS_SEL = 6 * MiB;
constexpr size_t WS_WGLU = 8 * MiB;
constexpr size_t WS_WOUT = 9 * MiB;
constexpr size_t WS_WIN = 25 * MiB;
constexpr size_t WS_WF = 65 * MiB;
constexpr size_t WS_W2 = 97 * MiB;
constexpr size_t WS_WGU = 257 * MiB;
constexpr size_t WS_WDN = 769 * MiB;
constexpr size_t WS_XL = 1025 * MiB;
constexpr size_t WS_XM = 1169 * MiB;
constexpr size_t WS_H = 1313 * MiB;
constexpr size_t WS_F = 1385 * MiB;
constexpr size_t WS_R1 = 1401 * MiB;
constexpr size_t WS_R2 = 1563 * MiB;
constexpr size_t WS_U2 = WS_R2 + 72 * MiB;
constexpr size_t WS_Z = WS_R2 + 112 * MiB;
constexpr size_t WS_END = 1707 * MiB;
constexpr int CW_BAR = 4096;

constexpr int RING_BYTES = 131072;
constexpr int LDSCTL_OFF = RING_BYTES, MISC_OFF = LDSCTL_OFF + 320;
constexpr int LDS_BYTES = 147456;
constexpr int NWAVES = 8;

#define LDS_WAIT() asm volatile("s_waitcnt lgkmcnt(0)" ::: "memory")
#define VM_WAIT() asm volatile("s_waitcnt vmcnt(0)" ::: "memory")
__device__ __forceinline__ unsigned f2bf(float f) { unsigned u = __builtin_bit_cast(unsigned, f); return (u + 0x7fffu + ((u >> 16) & 1u)) >> 16; }
__device__ __forceinline__ unsigned pk2(float lo, float hi) { return f2bf(lo) | (f2bf(hi) << 16); }
__device__ __forceinline__ float bflo(unsigned w) { return __builtin_bit_cast(float, w << 16); }
__device__ __forceinline__ float bfhi(unsigned w) { return __builtin_bit_cast(float, w & 0xffff0000u); }
__device__ __forceinline__ float wave_sum(float v) {
#pragma unroll
    for (int o = 1; o < 64; o <<= 1) v += __shfl_xor(v, o);
    return v;
}
__device__ __forceinline__ float sigmoidf_(float x) { return 1.0f / (1.0f + __expf(-x)); }
__device__ __forceinline__ float gelu_tanh(float y) { const float a = 1.5957691216f * (y + 0.044715f * y * y * y); return y * sigmoidf_(a); }

#ifndef FP8_SCALE1
#define FP8_SCALE1 0x7f7f7f7f
#endif
namespace pg8 {
constexpr int BM = 256, BK = 64, HALF = 128, HTB = HALF * BK * 2, STAGE_BYTES = 8 * HTB;
__host__ __device__ __forceinline__ int lds_byte(int r, int c) { const int st = (r >> 4) * 2 + (c >> 5), rr = r & 15, cc = c & 31, ob = rr * 64 + cc * 2; return st * 1024 + (ob ^ (((ob >> 9) & 1) << 5)); }
__host__ __device__ __forceinline__ void stage_rc(int b, int& R, int& C) { const int st = b / 1024, sb = b % 1024, swz = sb ^ (((sb >> 9) & 1) << 5); R = (st >> 1) * 16 + swz / 64; C = (st & 1) * 32 + (swz % 64) / 2; }
__host__ __device__ __forceinline__ int perm32(int rho) { const int n = rho >> 4, i = rho & 15; return 8 * (i >> 2) + 4 * n + (i & 3); }
__device__ __forceinline__ unsigned cvt_pk_bf16(float lo, float hi) { unsigned r; asm volatile("v_cvt_pk_bf16_f32 %0, %1, %2" : "=v"(r) : "v"(lo), "v"(hi)); return r; }

struct Unit { const char* a; const char* b; int pm, pn, aux; };
struct Dims { int lda, ldb, K; const int* gidx; };
typedef int v4i_t __attribute__((ext_vector_type(4)));
typedef int v8i_t __attribute__((ext_vector_type(8)));
template <bool FP8> struct Frag { bf16x8 k[2]; };
template <> struct Frag<true> { v8i_t v; };

template <class Epi, class Sched, bool ALIGN_EPI, bool FP8 = false, bool GATHER = false>
__device__ __forceinline__ void gemm_phase(LAS unsigned char* lds, const int tid, const Dims g, const Sched& S, const Epi& E) {
    const int wid = __builtin_amdgcn_readfirstlane(tid >> 6), lane = tid & 63, wr = wid >> 2, wc = wid & 3, fr = lane & 15, fq = lane >> 4;
    const int nt = g.K / (BK * 2);
    unsigned voffA[2], voffB[2];
#pragma unroll
    for (int i = 0; i < 2; ++i) { int R, C; stage_rc(tid * 16 + i * 8192, R, C); const int Rb = Epi::PERM ? ((R & ~31) + perm32(R & 31)) : R;
        voffA[i] = (unsigned)(R * g.lda + C * 2); voffB[i] = (unsigned)(Rb * g.ldb + C * 2); }
    const size_t kstep = (size_t)(BK * 2);
    const size_t hstepA = (size_t)HALF * g.lda, hstepB = (size_t)HALF * g.ldb;
    const unsigned ldsw = (unsigned)wid * 1024u;
    const int aoff = lds_byte(wr * 64 + fr, fq * 8), boff = lds_byte(wc * 32 + fr, fq * 8);
#define PG8_SA(b, h) (((b) * 2 + (h)) * HTB)
#define PG8_SB(b, h) ((4 + (b) * 2 + (h)) * HTB)
#define PG8_STAGE(bufoff, gbase, voff) do { _Pragma("unroll") for (int _i = 0; _i < 2; ++_i) \
        __builtin_amdgcn_global_load_lds((const unsigned*)((const char*)(gbase) + (voff)[_i]), (LAS unsigned*)(lds + (bufoff) + ldsw + _i * 8192), 16, 0, 0); } while (0)
#define PG8_STAGE_A(bufoff, gbase, h, isnext) do { if constexpr (GATHER) { if (isnext) PG8_STAGE(bufoff, gbase, gAn[h]); else PG8_STAGE(bufoff, gbase, gA[h]); } \
        else PG8_STAGE(bufoff, (gbase) + ((h) ? hstepA : (size_t)0), voffA); } while (0)
#define PG8_GIDX(dst, u) do { _Pragma("unroll") for (int h_ = 0; h_ < 2; ++h_) _Pragma("unroll") for (int i_ = 0; i_ < 2; ++i_) { int R_, C_; stage_rc(tid * 16 + i_ * 8192, R_, C_); \
        dst[h_][i_] = (unsigned)(*(const GAS int*)(g.gidx + (u).pm * 256 + h_ * 128 + R_)) * (unsigned)g.lda + (unsigned)(C_ * 2); } } while (0)
#define PG8_LD1(dst, p) do { if constexpr (FP8) { const v4i_t lo_ = *(const LAS v4i_t*)(p), hi_ = *(const LAS v4i_t*)((p) + 1024); dst.v = __builtin_shufflevector(lo_, hi_, 0, 1, 2, 3, 4, 5, 6, 7); } \
        else { dst.k[0] = *(const LAS bf16x8*)(p); dst.k[1] = *(const LAS bf16x8*)((p) + 1024); } } while (0)
#define PG8_LDA(dst, b, h) do { _Pragma("unroll") for (int m = 0; m < 4; ++m) PG8_LD1(dst[m], lds + PG8_SA(b, h) + aoff + m * 2048); } while (0)
#define PG8_LDB(dst, b, h) do { _Pragma("unroll") for (int n = 0; n < 2; ++n) PG8_LD1(dst[n], lds + PG8_SB(b, h) + boff + n * 2048); } while (0)
#define PG8_MMA(ai, bj, At, Bt) do { __builtin_amdgcn_s_setprio(1); _Pragma("unroll") for (int m = 0; m < 4; ++m) _Pragma("unroll") for (int n = 0; n < 2; ++n) { \
        if constexpr (FP8) asm volatile("v_mfma_f32_16x16x128_f8f6f4 %0, %1, %2, %0" : "+v"(acc[ai][bj][m][n]) : "v"(Bt[n].v), "v"(At[m].v)); \
        else { _Pragma("unroll") for (int k = 0; k < 2; ++k) acc[ai][bj][m][n] = __builtin_amdgcn_mfma_f32_16x16x32_bf16(Bt[n].k[k], At[m].k[k], acc[ai][bj][m][n], 0, 0, 0); } } __builtin_amdgcn_s_setprio(0); } while (0)
#define PG8_WAIT_V(n) asm volatile("s_waitcnt vmcnt(" #n ")" ::: "memory")
#define PG8_WAIT_L(n) asm volatile("s_waitcnt lgkmcnt(" #n ")" ::: "memory")
#define PG8_BAR __builtin_amdgcn_s_barrier()
#define PG8_SCHED __builtin_amdgcn_sched_barrier(0)
    Unit cur, nxt; int ui = 0;
    if (!S.next(0, cur)) return;
    f32x4 acc[2][2][4][2];
#pragma unroll
    for (int a = 0; a < 2; ++a)
#pragma unroll
        for (int b = 0; b < 2; ++b)
#pragma unroll
            for (int m = 0; m < 4; ++m)
#pragma unroll
                for (int n = 0; n < 2; ++n) acc[a][b][m][n] = (f32x4){0.f, 0.f, 0.f, 0.f};
    Frag<FP8> At[4], B0[2], B1[2];
    const char* cA = cur.a; const char* cB = cur.b;
    unsigned gA[2][2], gAn[2][2];
    if constexpr (GATHER) { PG8_GIDX(gA, cur); _Pragma("unroll") for (int h_ = 0; h_ < 2; ++h_) _Pragma("unroll") for (int i_ = 0; i_ < 2; ++i_) gAn[h_][i_] = gA[h_][i_]; }
    PG8_STAGE(PG8_SB(0, 0), cB, voffB); PG8_STAGE(PG8_SB(0, 1), cB + hstepB, voffB); PG8_STAGE_A(PG8_SA(0, 0), cA, 0, false); PG8_STAGE_A(PG8_SA(0, 1), cA, 1, false);
    if (wr == 1) PG8_BAR;
    PG8_WAIT_V(2); PG8_BAR;
    PG8_STAGE(PG8_SB(1, 0), cB + kstep, voffB); PG8_STAGE_A(PG8_SA(1, 0), cA + kstep, 0, false); PG8_STAGE(PG8_SB(1, 1), cB + hstepB + kstep, voffB);
    PG8_WAIT_V(6); PG8_BAR;
    for (;;) {
        const bool has_next = S.next(ui + 1, nxt);
        const char* nA = has_next ? nxt.a : cA; const char* nB = has_next ? nxt.b : cB;
        for (int t = 0; t < nt; t += 2) {
            const bool last = (t == nt - 2);
            const char* a1 = cA + (size_t)(t + 1) * kstep;
            if constexpr (GATHER) { if (t == nt - 4 && has_next) PG8_GIDX(gAn, nxt); }
            const char* a2 = last ? nA : cA + (size_t)(t + 2) * kstep; const char* b2 = last ? nB : cB + (size_t)(t + 2) * kstep;
            const char* a3 = a2 + kstep; const char* b3 = b2 + kstep;
            PG8_LDB(B0, 0, 0); PG8_LDB(B1, 0, 1); PG8_SCHED; PG8_LDA(At, 0, 0); PG8_STAGE_A(PG8_SA(1, 1), a1, 1, false);
            PG8_WAIT_V(8); PG8_WAIT_L(0); PG8_BAR; PG8_MMA(0, 0, At, B0); PG8_MMA(0, 1, At, B1); PG8_BAR; PG8_SCHED;
            PG8_LDA(At, 0, 1); PG8_STAGE(PG8_SB(0, 0), b2, voffB); PG8_STAGE(PG8_SB(0, 1), b2 + hstepB, voffB); PG8_STAGE_A(PG8_SA(0, 0), a2, 0, last);
            PG8_WAIT_V(8); PG8_WAIT_L(0); PG8_BAR; PG8_MMA(1, 0, At, B0); PG8_MMA(1, 1, At, B1); PG8_BAR; PG8_SCHED;
            PG8_LDB(B0, 1, 0); PG8_LDB(B1, 1, 1); PG8_SCHED; PG8_LDA(At, 1, 0); PG8_STAGE_A(PG8_SA(0, 1), a2, 1, last);
            PG8_WAIT_V(8); PG8_WAIT_L(0); PG8_BAR; PG8_MMA(0, 0, At, B0); PG8_MMA(0, 1, At, B1); PG8_BAR; PG8_SCHED;
            PG8_LDA(At, 1, 1); PG8_STAGE(PG8_SB(1, 0), b3, voffB); PG8_STAGE(PG8_SB(1, 1), b3 + hstepB, voffB); PG8_STAGE_A(PG8_SA(1, 0), a3, 0, last);
            PG8_WAIT_V(8); PG8_WAIT_L(0); PG8_BAR; PG8_MMA(1, 0, At, B0); PG8_MMA(1, 1, At, B1); PG8_BAR; PG8_SCHED;
        }
        if constexpr (FP8) asm volatile("s_nop 15\n\ts_nop 7" ::: "memory");
        if constexpr (ALIGN_EPI) { if (wr == 0) PG8_BAR; }
        if constexpr (!Epi::AFTER_DRAIN) { E(acc, cur, wr, wc, fr, fq); }
        if (!has_next) break;
#pragma unroll
        for (int a = 0; a < 2; ++a)
#pragma unroll
            for (int b = 0; b < 2; ++b)
#pragma unroll
                for (int m = 0; m < 4; ++m)
#pragma unroll
                    for (int n = 0; n < 2; ++n) acc[a][b][m][n] = (f32x4){0.f, 0.f, 0.f, 0.f};
        cur = nxt; cA = nA; cB = nB; ++ui;
        if constexpr (GATHER) { _Pragma("unroll") for (int h_ = 0; h_ < 2; ++h_) _Pragma("unroll") for (int i_ = 0; i_ < 2; ++i_) gA[h_][i_] = gAn[h_][i_]; }
        if constexpr (ALIGN_EPI) { if (wr == 1) PG8_BAR; }
    }
    PG8_WAIT_V(0);
    if constexpr (!ALIGN_EPI) { if (wr == 0) PG8_BAR; }
    PG8_BAR;
    if constexpr (Epi::AFTER_DRAIN) { E.fused(acc, cur, wr, wc, fr, fq, lds, wid, lane); }
#undef PG8_SA
#undef PG8_SB
#undef PG8_STAGE
#undef PG8_STAGE_A
#undef PG8_GIDX
#undef PG8_LDA
#undef PG8_LDB
#undef PG8_MMA
#undef PG8_LD1
#undef PG8_WAIT_V
#undef PG8_WAIT_L
#undef PG8_BAR
#undef PG8_SCHED
}
}

#define XB_TMO      128
#define XB_XCNT(j)  (256  + 64 * (j))
#define XB_XSUB(j)  (1280 + 64 * (j))
#define XB_XGEN(j)  (2304 + 64 * (j))
#define XB_TOP      3328
#define XB_TOPGEN   3392
#define XCD_BAR_WORDS 3456
#define XB_SPIN_CAP (1u << 18)

__device__ __forceinline__ unsigned xb_ld(unsigned* p)              { return __hip_atomic_load(p, __ATOMIC_RELAXED, __HIP_MEMORY_SCOPE_AGENT); }
__device__ __forceinline__ unsigned xb_add(unsigned* p, unsigned v) { return __hip_atomic_fetch_add(p, v, __ATOMIC_RELAXED, __HIP_MEMORY_SCOPE_AGENT); }
__device__ __forceinline__ unsigned xb_xcc_id() { return (unsigned)__builtin_amdgcn_s_getreg((3 << 11) | 20) & 0xFu; }
#define XB_SPIN(cond, bar) do { unsigned _sp = 0; while (cond) { __builtin_amdgcn_s_sleep(1); \
    if ((++_sp & 255u) == 0u) { if (xb_ld(&(bar)[XB_TMO])) break; if (_sp > XB_SPIN_CAP) { atomicAdd(&(bar)[XB_TMO], 1u); break; } } } } while (0)

struct XcdBarrier {
    unsigned* bar; unsigned x;
    volatile LAS unsigned* st;
};
__device__ __forceinline__ XcdBarrier xcd_barrier_post(unsigned* bar, volatile LAS unsigned* st) {
    XcdBarrier b; b.bar = bar; b.x = xb_xcc_id(); b.st = st;
    if (threadIdx.x == 0) (void)xb_add(&bar[XB_XCNT(b.x)], 1u);
    return b;
}
__device__ __forceinline__ void xcd_barrier_complete(unsigned* bar, unsigned x, unsigned& nloc, unsigned& nx) {
    const unsigned G = gridDim.x * gridDim.y * gridDim.z;
    unsigned sum, cnt, mine, sp = 0u;
    for (;;) {
        sum = 0u; cnt = 0u; mine = 0u;
#pragma unroll
        for (unsigned j = 0; j < 16; ++j) { const unsigned c = xb_ld(&bar[XB_XCNT(j)]); sum += c; cnt += (c > 0u) ? 1u : 0u; mine = (j == x) ? c : mine; }
        if (sum == G) break;
        __builtin_amdgcn_s_sleep(1);
        if ((++sp & 255u) == 0u) { if (xb_ld(&bar[XB_TMO])) break; if (sp > XB_SPIN_CAP) { atomicAdd(&bar[XB_TMO], 1u); break; } }
    }
    nloc = mine > 0u ? mine : 1u; nx = cnt > 0u ? cnt : 1u;
}
__device__ __forceinline__ void xcd_barrier(const XcdBarrier& b) {
    asm volatile("s_waitcnt vmcnt(0)" ::: "memory");
    __syncthreads();
    if (threadIdx.x == 0) {
        unsigned* bar = b.bar;
        __builtin_amdgcn_s_waitcnt(0);
        unsigned nloc = b.st[0], nx = b.st[1];
        if (nloc == 0u) { xcd_barrier_complete(bar, b.x, nloc, nx); b.st[0] = nloc; b.st[1] = nx; }
        const unsigned old = xb_add(&bar[XB_XSUB(b.x)], 1u);
        const unsigned gen = old / nloc;
        if (old + 1u == (gen + 1u) * nloc) {
            __builtin_amdgcn_fence(__ATOMIC_RELEASE, "agent");
            asm volatile("s_waitcnt vmcnt(0)" ::: "memory");
            const unsigned og = xb_add(&bar[XB_TOP], 1u);
            const unsigned tg = og / nx;
            if (og + 1u == (tg + 1u) * nx) xb_add(&bar[XB_TOPGEN], 1u);
            else XB_SPIN(xb_ld(&bar[XB_TOPGEN]) == tg, bar);
            __builtin_amdgcn_fence(__ATOMIC_ACQUIRE, "agent");
            xb_add(&bar[XB_XGEN(b.x)], 1u);
            asm volatile("s_waitcnt vmcnt(0)" ::: "memory");
        } else {
            XB_SPIN(xb_ld(&bar[XB_XGEN(b.x)]) == gen, bar);
            __builtin_amdgcn_fence(__ATOMIC_ACQUIRE, "agent");
            asm volatile("s_waitcnt vmcnt(0)" ::: "memory");
        }
    }
    __syncthreads();
}

struct Frame {
    LAS unsigned char* lds;
    int tid, lane, wave, vcu, G;
    unsigned char* ws;
    const float* const* in;
    float* out;
};
#define WSP(T, off) ((T*)(F.ws + (off)))
enum InIdx { I_X = 0, I_C, I_CTX, I_CCTX, I_ADAW, I_ADAB, I_N1G, I_WIN, I_CONVW, I_LRE, I_LIM, I_LDT, I_BRE, I_BIM, I_CRE, I_CIM, I_SSMD, I_WGLU, I_ONCG, I_ONSG, I_WOUT, I_N2G, I_RW, I_WG, I_WU, I_WD, I_FNG };

using pg8::Unit;
struct EpiProj {
    static constexpr bool PERM = true, AFTER_DRAIN = false;
    bf16* proj; bf16* u2;
    __device__ __forceinline__ void operator()(const f32x4 (&acc)[2][2][4][2], const Unit& u, int wr, int wc, int fr, int fq) const {
        const int row0 = u.pm * 256 + wr * 64 + fr, col0 = u.pn * 256 + wc * 32 + 8 * fq;
#pragma unroll
        for (int ai = 0; ai < 2; ++ai)
#pragma unroll
            for (int m = 0; m < 4; ++m) { const int row = row0 + ai * 128 + m * 16;
#pragma unroll
                for (int bj = 0; bj < 2; ++bj) { const f32x4 v0 = acc[ai][bj][m][0], v1 = acc[ai][bj][m][1]; const int col = col0 + bj * 128;
                    v4u w; w.x = pg8::cvt_pk_bf16(v0[0], v0[1]); w.y = pg8::cvt_pk_bf16(v0[2], v0[3]); w.z = pg8::cvt_pk_bf16(v1[0], v1[1]); w.w = pg8::cvt_pk_bf16(v1[2], v1[3]);
                    bf16* dst;
                    if (u.pn < 18) dst = proj + (size_t)row * (3 * DCONV) + col;
                    else { const int cc = col - 3 * DCONV, g = cc >> 4, i0 = cc & 15; dst = u2 + ((size_t)(g * NINST + (row >> 6)) * KS2 + (row & 63) * 16 + i0); }
                    *(GAS v4u*)dst = w; } }
    }
};
struct EpiF32 {
    static constexpr bool PERM = false, AFTER_DRAIN = false;
    float* C; int ldc; size_t cstride;
    __device__ __forceinline__ void operator()(const f32x4 (&acc)[2][2][4][2], const Unit& u, int wr, int wc, int fr, int fq) const {
        float* base = C + (size_t)u.aux * cstride; const int row0 = u.pm * 256 + wr * 64 + fr, col0 = u.pn * 256 + wc * 32 + 4 * fq;
#pragma unroll
        for (int ai = 0; ai < 2; ++ai)
#pragma unroll
            for (int m = 0; m < 4; ++m) { float* rowp = base + (size_t)(row0 + ai * 128 + m * 16) * ldc + col0;
#pragma unroll
                for (int bj = 0; bj < 2; ++bj)
#pragma unroll
                    for (int n = 0; n < 2; ++n) *(GAS f32x4*)(rowp + bj * 128 + n * 16) = acc[ai][bj][m][n]; }
    }
};
struct EpiS2 {
    static constexpr bool PERM = true, AFTER_DRAIN = false;
    const bf16* u2; const float* dsk; bf16* z;
    __device__ __forceinline__ void operator()(const f32x4 (&acc)[2][2][4][2], const Unit& u, int wr, int wc, int fr, int fq) const {
        const int g = u.aux, inst0 = u.pm * 256 + wr * 64 + fr, c0 = u.pn * 256 + wc * 32 + 8 * fq;
#pragma unroll
        for (int bj = 0; bj < 2; ++bj) { const int cidx = c0 + bj * 128, t = cidx >> 4, o0 = cidx & 15;
            const f32x4 d0 = *(const GAS f32x4*)(dsk + g * 16 + o0), d1 = *(const GAS f32x4*)(dsk + g * 16 + o0 + 4);
#pragma unroll
            for (int ai = 0; ai < 2; ++ai)
#pragma unroll
                for (int m = 0; m < 4; ++m) { const int inst = inst0 + ai * 128 + m * 16;
                    if (inst < MT / 64) {
                        const v4u uu = *(const GAS v4u*)(u2 + ((size_t)(g * NINST + inst) * KS2 + cidx));
                        const f32x4 a0 = acc[ai][bj][m][0], a1 = acc[ai][bj][m][1];
                        const float y0 = a0[0] + d0[0] * bflo(uu.x), y1 = a0[1] + d0[1] * bfhi(uu.x), y2 = a0[2] + d0[2] * bflo(uu.y), y3 = a0[3] + d0[3] * bfhi(uu.y);
                        const float y4 = a1[0] + d1[0] * bflo(uu.z), y5 = a1[1] + d1[1] * bfhi(uu.z), y6 = a1[2] + d1[2] * bflo(uu.w), y7 = a1[3] + d1[3] * bfhi(uu.w);
                        v4u w; w.x = pg8::cvt_pk_bf16(gelu_tanh(y0), gelu_tanh(y1)); w.y = pg8::cvt_pk_bf16(gelu_tanh(y2), gelu_tanh(y3));
                        w.z = pg8::cvt_pk_bf16(gelu_tanh(y4), gelu_tanh(y5)); w.w = pg8::cvt_pk_bf16(gelu_tanh(y6), gelu_tanh(y7));
                        *(GAS v4u*)(z + ((size_t)(inst * 64 + t) * DSSM + g * 16 + o0)) = w; } } }
    }
};
struct EpiGlu {
    static constexpr bool PERM = true, AFTER_DRAIN = true;
    const bf16* z; const float* gain; bf16* concat;
    __device__ __forceinline__ void operator()(const f32x4 (&)[2][2][4][2], const Unit&, int, int, int, int) const {}
    __device__ __forceinline__ void fused(f32x4 (&acc)[2][2][4][2], const Unit& u, int wr, int wc, int fr, int fq, LAS unsigned char* lds, int wid, int lane) const {
        LAS float* P = (LAS float*)lds;
        const int row0 = u.pm * 256 + wr * 64 + fr, col0 = u.pn * 256 + wc * 32 + 8 * fq;
#pragma unroll
        for (int ai = 0; ai < 2; ++ai)
#pragma unroll
            for (int m = 0; m < 4; ++m) { const int row = row0 + ai * 128 + m * 16, rt = ai * 128 + wr * 64 + m * 16 + fr;
#pragma unroll
                for (int bj = 0; bj < 2; ++bj) { const v4u zz = *(const GAS v4u*)(z + (size_t)row * DSSM + col0 + bj * 128);
                    f32x4 a0 = acc[ai][bj][m][0], a1 = acc[ai][bj][m][1];
                    a0[0] = bflo(zz.x) * sigmoidf_(a0[0]); a0[1] = bfhi(zz.x) * sigmoidf_(a0[1]); a0[2] = bflo(zz.y) * sigmoidf_(a0[2]); a0[3] = bfhi(zz.y) * sigmoidf_(a0[3]);
                    a1[0] = bflo(zz.z) * sigmoidf_(a1[0]); a1[1] = bfhi(zz.z) * sigmoidf_(a1[1]); a1[2] = bflo(zz.w) * sigmoidf_(a1[2]); a1[3] = bfhi(zz.w) * sigmoidf_(a1[3]);
                    acc[ai][bj][m][0] = a0; acc[ai][bj][m][1] = a1;
                    float s = (a0[0] * a0[0] + a0[1] * a0[1]) + (a0[2] * a0[2] + a0[3] * a0[3]) + (a1[0] * a1[0] + a1[1] * a1[1]) + (a1[2] * a1[2] + a1[3] * a1[3]);
                    s += __shfl_xor(s, 16); s += __shfl_xor(s, 32);
                    if (fq == 0) P[(rt * 2 + bj) * 4 + wc] = s; } }
        LDS_WAIT(); __builtin_amdgcn_s_barrier(); asm volatile("" ::: "memory");
#pragma unroll
        for (int bj = 0; bj < 2; ++bj) { const int col = col0 + bj * 128;
            const f32x4 g0 = *(const GAS f32x4*)(gain + col), g1 = *(const GAS f32x4*)(gain + col + 4);
#pragma unroll
            for (int ai = 0; ai < 2; ++ai)
#pragma unroll
                for (int m = 0; m < 4; ++m) { const int row = row0 + ai * 128 + m * 16, rt = ai * 128 + wr * 64 + m * 16 + fr;
                    const f32x4 p = *(const LAS f32x4*)(P + (rt * 2 + bj) * 4);
                    const float rs = 1.0f / sqrtf(((p[0] + p[1]) + (p[2] + p[3])) * (1.0f / 128.0f) + EPS);
                    const f32x4 a0 = acc[ai][bj][m][0] * rs * g0, a1 = acc[ai][bj][m][1] * rs * g1;
                    v4u w; w.x = pg8::cvt_pk_bf16(a0[0], a0[1]); w.y = pg8::cvt_pk_bf16(a0[2], a0[3]); w.z = pg8::cvt_pk_bf16(a1[0], a1[1]); w.w = pg8::cvt_pk_bf16(a1[2], a1[3]);
                    *(GAS v4u*)(concat + (size_t)row * DM + DCONV + col) = w; } }
    }
};
struct EpiOut {
    static constexpr bool PERM = false, AFTER_DRAIN = false;
    const float* xlat; const float* xctx; const float* mod; float* xm;
    __device__ __forceinline__ void operator()(const f32x4 (&acc)[2][2][4][2], const Unit& u, int wr, int wc, int fr, int fq) const {
        const int rb = u.pm < 64 ? (u.pm >> 3) : 8; const float* g1 = mod + (size_t)(rb * 6 + 2) * DM;
        const float* xp = u.pm < 64 ? xlat + (size_t)u.pm * 256 * DM : xctx + (size_t)(u.pm - 64) * 256 * DM;
        float* xo = xm + (size_t)u.pm * 256 * DM;
        const int r0 = wr * 64 + fr, col0 = u.pn * 256 + wc * 32 + 4 * fq;
        f32x4 gv[2][2];
#pragma unroll
        for (int bj = 0; bj < 2; ++bj)
#pragma unroll
            for (int n = 0; n < 2; ++n) gv[bj][n] = *(const GAS f32x4*)(g1 + col0 + bj * 128 + n * 16);
#pragma unroll
        for (int ai = 0; ai < 2; ++ai) { f32x4 xv[4][2][2];
#pragma unroll
            for (int m = 0; m < 4; ++m) { const size_t off = (size_t)(r0 + ai * 128 + m * 16) * DM + col0;
#pragma unroll
                for (int bj = 0; bj < 2; ++bj)
#pragma unroll
                    for (int n = 0; n < 2; ++n) xv[m][bj][n] = *(const GAS f32x4*)(xp + off + bj * 128 + n * 16); }
#pragma unroll
            for (int m = 0; m < 4; ++m) { const size_t off = (size_t)(r0 + ai * 128 + m * 16) * DM + col0;
#pragma unroll
                for (int bj = 0; bj < 2; ++bj)
#pragma unroll
                    for (int n = 0; n < 2; ++n) *(GAS f32x4*)(xo + off + bj * 128 + n * 16) = xv[m][bj][n] + gv[bj][n] * acc[ai][bj][m][n]; }
            asm volatile("" ::: "memory"); }
    }
};
constexpr float FP8_SW = 64.f, FP8_SH = 16.f, FP8_SA = 8.f;
__device__ __forceinline__ unsigned pk4_fp8(float a, float b, float c, float d) {
    a = __builtin_amdgcn_fmed3f(a, -448.f, 448.f); b = __builtin_amdgcn_fmed3f(b, -448.f, 448.f); c = __builtin_amdgcn_fmed3f(c, -448.f, 448.f); d = __builtin_amdgcn_fmed3f(d, -448.f, 448.f);
    unsigned w = (unsigned)__builtin_amdgcn_cvt_pk_fp8_f32(a, b, 0, false); return (unsigned)__builtin_amdgcn_cvt_pk_fp8_f32(c, d, (int)w, true); }
struct EpiMoe1 {
    static constexpr bool PERM = true, AFTER_DRAIN = false;
    unsigned char* act;
    __device__ __forceinline__ void operator()(const f32x4 (&acc)[2][2][4][2], const Unit& u, int wr, int wc, int fr, int fq) const {
        const int row0 = u.pm * 256 + wr * 64 + fr, f0 = u.pn * 128 + wc * 32 + 8 * fq; constexpr float sg = 1.0f / (FP8_SW * FP8_SH);
#pragma unroll
        for (int ai = 0; ai < 2; ++ai)
#pragma unroll
            for (int m = 0; m < 4; ++m) { const f32x4 g0 = acc[ai][0][m][0] * sg, g1 = acc[ai][0][m][1] * sg, u0 = acc[ai][1][m][0] * (sg * FP8_SA), u1 = acc[ai][1][m][1] * (sg * FP8_SA);
                float r[8];
#pragma unroll
                for (int j = 0; j < 4; ++j) { r[j] = g0[j] * sigmoidf_(g0[j]) * u0[j]; r[4 + j] = g1[j] * sigmoidf_(g1[j]) * u1[j]; }
                v2u w; w.x = pk4_fp8(r[0], r[1], r[2], r[3]); w.y = pk4_fp8(r[4], r[5], r[6], r[7]);
                *(GAS v2u*)(act + (size_t)(row0 + ai * 128 + m * 16) * DF + f0) = w; }
    }
};
struct EpiBf16 {
    static constexpr bool PERM = true, AFTER_DRAIN = false;
    bf16* O; int ldc; float scale;
    __device__ __forceinline__ void operator()(const f32x4 (&acc)[2][2][4][2], const Unit& u, int wr, int wc, int fr, int fq) const {
        const int row0 = u.pm * 256 + wr * 64 + fr, col0 = u.pn * 256 + wc * 32 + 8 * fq;
#pragma unroll
        for (int ai = 0; ai < 2; ++ai)
#pragma unroll
            for (int m = 0; m < 4; ++m) { bf16* rowp = O + (size_t)(row0 + ai * 128 + m * 16) * ldc + col0;
#pragma unroll
                for (int bj = 0; bj < 2; ++bj) { const f32x4 v0 = acc[ai][bj][m][0] * scale, v1 = acc[ai][bj][m][1] * scale;
                    v4u w; w.x = pg8::cvt_pk_bf16(v0[0], v0[1]); w.y = pg8::cvt_pk_bf16(v0[2], v0[3]); w.z = pg8::cvt_pk_bf16(v1[0], v1[1]); w.w = pg8::cvt_pk_bf16(v1[2], v1[3]);
                    *(GAS v4u*)(rowp + bj * 128) = w; } }
    }
};

struct SchedProj {
    const char* A; const char* B; int G, c, layer;
    __device__ __forceinline__ bool next(int i, Unit& u) const {
        const int L = i * G + c; int rt, ct;
        if (layer == 0) { if (L >= 1440) return false; rt = (L / 160) * 8 + (L & 7); ct = (L % 160) >> 3; }
        else { if (L >= 1296) return false; if (L < 1280) { rt = (L / 160) * 8 + (L & 7); ct = (L % 160) >> 3; } else { const int j = L - 1280; rt = 64 + (j & 7); ct = 18 + (j >> 3); } }
        u.pm = rt; u.pn = ct; u.aux = 0; u.a = A + (size_t)rt * 256 * DM * 2; u.b = B + (size_t)ct * 256 * DM * 2; return true; }
};
struct SchedF {
    const char* A; const char* B; int G, c;
    __device__ __forceinline__ bool next(int i, Unit& u) const {
        const int j = c - (G - 64); if (i != 0 || j < 0) return false;
        const int g = j >> 1, rt = j & 1; u.pm = rt; u.pn = 0; u.aux = g; u.a = A + (size_t)(g * NINST + rt * 256) * KS2 * 2; u.b = B + (size_t)g * 256 * 1024 * 2; return true; }
};
struct SchedS2 {
    const char* A; const char* B; int G, c, layer;
    __device__ __forceinline__ bool next(int i, Unit& u) const {
        const int L = i * G + c; int g, rt, ct;
        if (layer == 0) { if (L >= 256) return false; g = L >> 3; rt = (L >> 2) & 1; ct = L & 3; } else { if (L >= 128) return false; g = L >> 2; rt = 0; ct = L & 3; }
        u.pm = rt; u.pn = ct; u.aux = g; u.a = A + (size_t)(g * NINST + rt * 256) * KS2 * 2; u.b = B + (size_t)(g * 1024 + ct * 256) * KS2 * 2; return true; }
};
struct SchedGlu {
    const char* A; const char* B; int G, c, nrt;
    __device__ __forceinline__ bool next(int i, Unit& u) const {
        const int L = i * G + c; if (L >= nrt * 2) return false;
        u.pm = L >> 1; u.pn = L & 1; u.aux = 0; u.a = A + (size_t)u.pm * 256 * DSSM * 2; u.b = B + (size_t)u.pn * 256 * DSSM * 2; return true; }
};
struct SchedOut {
    const char* A; const char* B; int G, c, nrt;
    __device__ __forceinline__ bool next(int i, Unit& u) const {
        const int L = i * G + c; if (L >= nrt * 8) return false;
        u.pm = (L >> 6) * 8 + (L & 7); u.pn = (L & 63) >> 3; u.aux = 0; u.a = A + (size_t)u.pm * 256 * DM * 2; u.b = B + (size_t)u.pn * 256 * DM * 2; return true; }
};
struct SchedMoe {
    const char* A; const char* B; int G, c, nct, layer, gather;
    __device__ __forceinline__ bool next(int i, Unit& u) const {
        const int L = i * G + c, per = 8 * nct, nlat = NE * per; int e, rtile, ct;
        if (L < nlat) { e = L / per; const int w = L % per; ct = (w >> 5) * 4 + (w & 3); rtile = e * 8 + ((w & 31) >> 2); }
        else { const int j = L - nlat; if (layer != 0 || j >= NE * nct) return false; e = j / nct; ct = j % nct; rtile = NE * 8 + e; }
        u.pm = rtile; u.pn = ct; u.aux = e; u.a = gather ? A : A + (size_t)rtile * 256 * 2048; u.b = B + ((size_t)e * nct + ct) * 256 * 2048; return true; }
};

struct CvtItem { const float* src; unsigned char* dst; int N, ldwt, fp8; };
__device__ __forceinline__ void cvt_decode(Frame& F, long it, CvtItem& d) {
    constexpr long I_EXP = 32 * 64;
    constexpr long N_GATE = 2L * NE * I_EXP, N_WIN = 2L * 32 * 160, N_WOUT = 2L * I_EXP;
    long r = it;
    if (r < 2 * N_GATE) {
        const int kind = r >= N_GATE; if (kind) r -= N_GATE;
        const int le = (int)(r / I_EXP), q = (int)(r % I_EXP), kb = q >> 6, n0 = (q & 63) * 32;
        d.src = F.in[kind ? I_WU : I_WG] + (size_t)le * DM * DF + (size_t)(kb * 64) * DF + n0; d.N = DF; d.ldwt = DM; d.fp8 = 1;
        d.dst = WSP(unsigned char, WS_WGU) + ((size_t)le * 4096 + (n0 >> 7) * 256 + kind * 128 + (n0 & 127)) * DM + kb * 64; return; }
    r -= 2 * N_GATE;
    if (r < N_GATE) { const int le = (int)(r / I_EXP), q = (int)(r % I_EXP), kb = q >> 6, n0 = (q & 63) * 32;
        d.src = F.in[I_WD] + (size_t)le * DF * DM + (size_t)(kb * 64) * DM + n0; d.N = DM; d.ldwt = DF; d.fp8 = 1;
        d.dst = WSP(unsigned char, WS_WDN) + ((size_t)le * DM + n0) * DF + kb * 64; return; }
    r -= N_GATE; d.fp8 = 0;
    if (r < N_WIN) { const int l = (int)(r / (32 * 160)), q = (int)(r % (32 * 160)), kb = q / 160, n0 = (q % 160) * 32;
        d.src = F.in[I_WIN] + (size_t)l * DM * DINP + (size_t)(kb * 64) * DINP + n0; d.N = DINP; d.ldwt = DM * 2;
        d.dst = (unsigned char*)(WSP(bf16, WS_WIN) + ((size_t)l * DINP + n0) * DM + kb * 64); return; }
    r -= N_WIN;
    if (r < N_WOUT) { const int l = (int)(r / I_EXP), q = (int)(r % I_EXP), kb = q >> 6, n0 = (q & 63) * 32;
        d.src = F.in[I_WOUT] + (size_t)l * DM * DM + (size_t)(kb * 64) * DM + n0; d.N = DM; d.ldwt = DM * 2;
        d.dst = (unsigned char*)(WSP(bf16, WS_WOUT) + ((size_t)l * DM + n0) * DM + kb * 64); return; }
    r -= N_WOUT;
    { const int l = (int)(r / 128), q = (int)(r % 128), kb = q >> 4, n0 = (q & 15) * 32;
        d.src = F.in[I_WGLU] + (size_t)l * DSSM * DSSM + (size_t)(kb * 64) * DSSM + n0; d.N = DSSM; d.ldwt = DSSM * 2;
        d.dst = (unsigned char*)(WSP(bf16, WS_WGLU) + ((size_t)l * DSSM + n0) * DSSM + kb * 64); }
}
__device__ __forceinline__ void cvt_load(const CvtItem& d, int lane, float (&t)[32]) {
    const float* src = d.src + (size_t)(lane >> 5) * d.N + (lane & 31);
#pragma unroll
    for (int i = 0; i < 32; ++i) t[i] = *(const GAS float*)(src + (size_t)(2 * i) * d.N);
}
template <bool FP8>
__device__ __forceinline__ void cvt_store(const CvtItem& d, LAS float* scr, int lane, const float (&t)[32]) {
    constexpr float sc = FP8 ? FP8_SW : 1.0f;
#pragma unroll
    for (int i = 0; i < 32; ++i) scr[(2 * i + (lane >> 5)) * 33 + (lane & 31)] = t[i] * sc;
    LDS_WAIT(); asm volatile("" ::: "memory");
    const int c = lane & 7;
#pragma unroll
    for (int j = 0; j < 4; ++j) { const int n = (lane >> 3) + 8 * j; const LAS float* s = scr + (8 * c) * 33 + n;
        const float v0 = s[0 * 33], v1 = s[1 * 33], v2 = s[2 * 33], v3 = s[3 * 33], v4 = s[4 * 33], v5 = s[5 * 33], v6 = s[6 * 33], v7 = s[7 * 33];
        if constexpr (FP8) { v2u o; o.x = pk4_fp8(v0, v1, v2, v3); o.y = pk4_fp8(v4, v5, v6, v7); *(GAS v2u*)(d.dst + (size_t)n * d.ldwt + 8 * c) = o; }
        else { v4u o; o.x = pk2(v0, v1); o.y = pk2(v2, v3); o.z = pk2(v4, v5); o.w = pk2(v6, v7); *(GAS v4u*)(d.dst + (size_t)n * d.ldwt + 16 * c) = o; } }
    LDS_WAIT(); asm volatile("" ::: "memory");
}
constexpr long CVT_NFP8 = 3L * (2L * NE * 2048), CVT_NITEMS = CVT_NFP8 + 2L * 32 * 160 + 2L * 2048 + 2L * 128;
constexpr unsigned CVT_CHUNK = 8;
struct CvtQ { unsigned next, left; };
__device__ __forceinline__ long cvt_pull(Frame& F, CvtQ& q, unsigned* ctr, long lo, long hi) {
    if (q.left == 0u) { unsigned b = 0u; if (F.lane == 0) b = __hip_atomic_fetch_add(ctr, CVT_CHUNK, __ATOMIC_RELAXED, __HIP_MEMORY_SCOPE_AGENT);
        q.next = (unsigned)__builtin_amdgcn_readfirstlane((int)b); q.left = CVT_CHUNK; }
    const long it = lo + (long)q.next; ++q.next; --q.left; return it < hi ? it : -1;
}
template <bool FP8>
__device__ __forceinline__ void cvt_run(Frame& F, LAS float* scr) {
    unsigned* ctr = (unsigned*)(F.ws + WS_CTL) + (FP8 ? 64 : 128); const long lo = FP8 ? 0 : CVT_NFP8, hi = FP8 ? CVT_NFP8 : CVT_NITEMS;
    CvtItem A, B; float ta[32], tb[32]; CvtQ q{0u, 0u};
    long ia = cvt_pull(F, q, ctr, lo, hi);
    if (ia < 0) return;
    cvt_decode(F, ia, A); cvt_load(A, F.lane, ta);
    for (;;) {
        long ib = cvt_pull(F, q, ctr, lo, hi); const bool vb = ib >= 0; ib = vb ? ib : ia;
        cvt_decode(F, ib, B); cvt_load(B, F.lane, tb);
        cvt_store<FP8>(A, scr, F.lane, ta);
        if (!vb) break;
        ia = cvt_pull(F, q, ctr, lo, hi); const bool va = ia >= 0; ia = va ? ia : ib;
        cvt_decode(F, ia, A); cvt_load(A, F.lane, ta);
        cvt_store<FP8>(B, scr, F.lane, tb);
        if (!va) break;
    }
}
__device__ __forceinline__ void p0_convert_weights(Frame& F) {
    LAS float* scr = (LAS float*)(F.lds + F.wave * 16384);
    cvt_run<true>(F, scr);
    cvt_run<false>(F, scr);
    __syncthreads();
}
__device__ __forceinline__ void p0_mod_task(Frame& F, int task) {
    const int l = task / 96, n0 = (task % 96) * 128;
    LAS float* sc = (LAS float*)F.lds;
    LAS float* red = (LAS float*)(F.lds + 9 * 2048 * 4);
    for (int i = F.tid; i < 9 * DM; i += 512) { const int r = i >> 11, k = i & 2047; const float v = r < 8 ? F.in[I_C][r * DM + k] : F.in[I_CCTX][k]; sc[i] = v * sigmoidf_(v); }
    __syncthreads();
    const float* W = F.in[I_ADAW] + (size_t)l * DM * 6 * DM + n0 + 2 * F.lane;
    float acc[9][2];
#pragma unroll
    for (int r = 0; r < 9; ++r) { acc[r][0] = 0.f; acc[r][1] = 0.f; }
    const int kbase = F.wave * 256;
#pragma unroll 8
    for (int kk = 0; kk < 256; ++kk) { const int k = kbase + kk; const f32x2 w = *(const GAS f32x2*)(W + (size_t)k * (6 * DM));
#pragma unroll
        for (int r = 0; r < 9; ++r) { const float s = sc[r * DM + k]; acc[r][0] += s * w.x; acc[r][1] += s * w.y; } }
#pragma unroll
    for (int r = 0; r < 9; ++r) { red[(F.wave * 9 + r) * 128 + 2 * F.lane] = acc[r][0]; red[(F.wave * 9 + r) * 128 + 2 * F.lane + 1] = acc[r][1]; }
    __syncthreads();
    float* mod = WSP(float, WS_MOD) + (size_t)l * 9 * 6 * DM;
    for (int i = F.tid; i < 9 * 128; i += 512) { const int r = i >> 7, n = i & 127; float s = F.in[I_ADAB][(size_t)l * 6 * DM + n0 + n];
#pragma unroll
        for (int w = 0; w < 8; ++w) s += red[(w * 9 + r) * 128 + n];
        mod[(size_t)r * 6 * DM + n0 + n] = s; }
    __syncthreads();
}
__device__ __forceinline__ void p0_s5_task(Frame& F, int task) {
    const int l = task >> 5, g = task & 31;
    LAS f32x2* PW = (LAS f32x2*)F.lds;
    LAS f32x2* BB = (LAS f32x2*)(F.lds + 33280);
    LAS f32x2* CC = (LAS f32x2*)(F.lds + 41472);
    LAS float* KD = (LAS float*)(F.lds + 49664);
    LAS bf16* KT = (LAS bf16*)(F.lds + 50688);
    bf16* WF = WSP(bf16, WS_WF) + (size_t)(l * NG + g) * 256 * 1024;
    bf16* W2 = WSP(bf16, WS_W2) + (size_t)(l * NG + g) * 1024 * KS2;
    for (int d = 0; d < 2; ++d) {
        const int ldg = (l * 2 + d) * NG + g;
        if (F.tid < 64) { const int p = F.tid;
            const double lr = (double)F.in[I_LRE][ldg * SP + p], li = (double)F.in[I_LIM][ldg * SP + p], dt = exp((double)F.in[I_LDT][ldg]);
            const double mag = exp(lr * dt), ar = mag * cos(li * dt), ai = mag * sin(li * dt), den = lr * lr + li * li, nr = ar - 1.0;
            const double kr = (nr * lr + ai * li) / den, ki = (ai * lr - nr * li) / den;
            double pr = 1.0, pi = 0.0;
            for (int e = 0; e <= 64; ++e) { PW[e * 64 + p] = (f32x2){(float)pr, (float)pi}; const double t = pr * ar - pi * ai; pi = pr * ai + pi * ar; pr = t; }
            if (true) { const f32x2 lt = PW[64 * 64 + p]; WSP(f32x2, WS_LT)[((l * NG + g) * 2 + d) * 64 + p] = lt; }
            for (int i = 0; i < SG; ++i) { const double br = (double)F.in[I_BRE][((size_t)ldg * SP + p) * SG + i], bi = (double)F.in[I_BIM][((size_t)ldg * SP + p) * SG + i];
                BB[p * 16 + i] = (f32x2){(float)(kr * br - ki * bi), (float)(kr * bi + ki * br)}; } }
        for (int i = F.tid; i < 1024; i += 512) CC[i] = (f32x2){F.in[I_CRE][(size_t)ldg * 1024 + i], F.in[I_CIM][(size_t)ldg * 1024 + i]};
        __syncthreads();
        { const int ph = F.tid & 1, q = F.tid >> 1, o = q >> 4, i = q & 15;
            float cbr[32], cbi[32];
#pragma unroll
            for (int p = 0; p < 32; ++p) { const f32x2 c = CC[o * 64 + ph * 32 + p], b = BB[(ph * 32 + p) * 16 + i]; cbr[p] = c.x * b.x - c.y * b.y; cbi[p] = c.x * b.y + c.y * b.x; }
#pragma unroll 1
            for (int j = 0; j < 64; ++j) { float s = 0.f;
#pragma unroll
                for (int p = 0; p < 32; p += 2) { const f32x4 P = *(const LAS f32x4*)(PW + j * 64 + ph * 32 + p); s += (cbr[p] * P[0] - cbi[p] * P[1]) + (cbr[p + 1] * P[2] - cbi[p + 1] * P[3]); }
                s += __shfl_xor(s, 1);
                if (ph == 0) { if (j == 0) { if (d == 0) KD[q] = s; else { s += KD[q]; KT[q] = (bf16)f2bf(s); } }
                               else KT[(d * 64 + j) * 256 + q] = (bf16)f2bf(s); } } }
        for (int it = F.tid; it < 128 * 128; it += 512) { const int n = it >> 7, k8 = it & 127, ri = n >> 6, p = n & 63, s = k8 >> 1, i0 = (k8 & 1) * 8, e = d == 0 ? 63 - s : s;
            const f32x2 P = PW[e * 64 + p]; float v[8];
#pragma unroll
            for (int j = 0; j < 8; ++j) { const f32x2 b = BB[p * 16 + i0 + j]; v[j] = ri == 0 ? (P.x * b.x - P.y * b.y) : (P.x * b.y + P.y * b.x); }
            v4u o; o.x = pk2(v[0], v[1]); o.y = pk2(v[2], v[3]); o.z = pk2(v[4], v[5]); o.w = pk2(v[6], v[7]);
            *(GAS v4u*)(WF + (size_t)(d * 128 + n) * 1024 + k8 * 8) = o; }
        for (int it = F.tid; it < 1024 * 16; it += 512) { const int n = it >> 4, c8 = it & 15, ri = c8 >> 3, p0 = (c8 & 7) * 8, t = n >> 4, o = n & 15, e = d == 0 ? t + 1 : 64 - t; float v[8];
#pragma unroll
            for (int j = 0; j < 8; ++j) { const f32x2 c = CC[o * 64 + p0 + j], P = PW[e * 64 + p0 + j]; v[j] = ri == 0 ? (c.x * P.x - c.y * P.y) : -(c.x * P.y + c.y * P.x); }
            v4u ov; ov.x = pk2(v[0], v[1]); ov.y = pk2(v[2], v[3]); ov.z = pk2(v[4], v[5]); ov.w = pk2(v[6], v[7]);
            *(GAS v4u*)(W2 + (size_t)n * KS2 + 1024 + d * 128 + c8 * 8) = ov; }
        __syncthreads();
    }
    for (int it = F.tid; it < 1024 * 128; it += 512) { const int n = it >> 7, k8 = it & 127, t = n >> 4, o = n & 15, s = k8 >> 1, i0 = (k8 & 1) * 8;
        const int dsel = s <= t ? 0 : 1, j = s <= t ? t - s : s - t;
        const v4u kv = *(const LAS v4u*)(KT + (dsel * 64 + j) * 256 + o * 16 + i0);
        *(GAS v4u*)(W2 + (size_t)n * KS2 + k8 * 8) = kv; }
    __syncthreads();
}
__device__ __forceinline__ void p0_router_t(Frame& F) {
    for (int i = (F.vcu * 512 + F.tid); i < 2 * 16 * DM; i += F.G * 512) { const int l = i >> 15, e = (i >> 11) & 15, k = i & 2047; WSP(float, WS_RWT)[i] = F.in[I_RW][((size_t)l * DM + k) * NE + e]; }
}

__device__ __forceinline__ int mbcnt64(unsigned long long m) { return (int)__builtin_amdgcn_mbcnt_hi((unsigned)(m >> 32), __builtin_amdgcn_mbcnt_lo((unsigned)m, 0u)); }
__device__ __forceinline__ void combine_row(Frame& F, int r, const float* g2, f32x4 (&x)[8]) {
    const int* sel = WSP(int, WS_SEL) + (size_t)r * NE; const float* vals = WSP(float, WS_VALS); const bf16* Y = WSP(bf16, WS_R1);
    const int mysel = F.lane < NE ? *(const GAS int*)(sel + F.lane) : -1;
    unsigned long long m = __ballot(mysel >= 0);
    f32x4 macc[8];
#pragma unroll
    for (int j = 0; j < 8; ++j) macc[j] = (f32x4){0.f, 0.f, 0.f, 0.f};
    while (m) { const int e = __builtin_ctzll(m); m &= m - 1;
        const int y = __builtin_amdgcn_readlane(mysel, e); const float val = *(const GAS float*)(vals + y); const bf16* yr = Y + (size_t)y * DM + 4 * F.lane;
#pragma unroll
        for (int j = 0; j < 8; ++j) { const v2u w = *(const GAS v2u*)(yr + j * 256); macc[j] += val * (f32x4){bflo(w.x), bfhi(w.x), bflo(w.y), bfhi(w.y)}; } }
#pragma unroll
    for (int j = 0; j < 8; ++j) x[j] += *(const GAS f32x4*)(g2 + j * 256 + 4 * F.lane) * macc[j];
}
__device__ __forceinline__ float row_rs(const f32x4 (&x)[8]) {
    float s = 0.f;
#pragma unroll
    for (int j = 0; j < 8; ++j) s += (x[j][0] * x[j][0] + x[j][1] * x[j][1]) + (x[j][2] * x[j][2] + x[j][3] * x[j][3]);
    return 1.0f / sqrtf(wave_sum(s) * (1.0f / DM) + EPS);
}
__device__ __forceinline__ void phase_norm1(Frame& F, int l) {
    const float* modl = WSP(float, WS_MOD) + (size_t)l * 9 * 6 * DM; const float* gn = F.in[I_N1G] + (size_t)l * DM;
    for (int r = F.vcu * NWAVES + F.wave; r < MT; r += F.G * NWAVES) {
        const int rb = r < ML ? (r >> 11) : 8;
        const float* xr = l == 0 ? (r < ML ? F.in[I_X] + (size_t)r * DM : F.in[I_CTX] + (size_t)(r - ML) * DM) : WSP(float, WS_XM) + (size_t)r * DM;
        f32x4 x[8];
#pragma unroll
        for (int j = 0; j < 8; ++j) x[j] = *(const GAS f32x4*)(xr + j * 256 + 4 * F.lane);
        if (l == 1) { combine_row(F, r, WSP(float, WS_MOD) + (size_t)(rb * 6 + 5) * DM, x);
            float* xo = WSP(float, WS_XL) + (size_t)r * DM;
#pragma unroll
            for (int j = 0; j < 8; ++j) *(GAS f32x4*)(xo + j * 256 + 4 * F.lane) = x[j]; }
        const float rs = row_rs(x); const float* sh = modl + (size_t)(rb * 6 + 0) * DM; const float* sc = modl + (size_t)(rb * 6 + 1) * DM;
        bf16* ho = WSP(bf16, WS_H) + (size_t)r * DM;
#pragma unroll
        for (int j = 0; j < 8; ++j) { const int c = j * 256 + 4 * F.lane; const f32x4 g = *(const GAS f32x4*)(gn + c), s1 = *(const GAS f32x4*)(sc + c), s0 = *(const GAS f32x4*)(sh + c);
            const f32x4 h = x[j] * rs * g * (1.0f + s1) + s0; v2u w; w.x = pk2(h[0], h[1]); w.y = pk2(h[2], h[3]); *(GAS v2u*)(ho + c) = w; }
    }
}
__device__ __forceinline__ void phase_final(Frame& F) {
    const float* gn = F.in[I_FNG];
    for (int r = F.vcu * NWAVES + F.wave; r < ML; r += F.G * NWAVES) {
        const int rb = r >> 11; const float* xr = WSP(float, WS_XM) + (size_t)r * DM;
        f32x4 x[8];
#pragma unroll
        for (int j = 0; j < 8; ++j) x[j] = *(const GAS f32x4*)(xr + j * 256 + 4 * F.lane);
        combine_row(F, r, WSP(float, WS_MOD) + (size_t)((9 + rb) * 6 + 5) * DM, x);
        const float rs = row_rs(x); float* o = F.out + (size_t)r * DM;
#pragma unroll
        for (int j = 0; j < 8; ++j) { const int c = j * 256 + 4 * F.lane; *(GAS f32x4*)(o + c) = x[j] * rs * *(const GAS f32x4*)(gn + c); }
    }
}
__device__ __forceinline__ void phase_norm2(Frame& F, int l) {
    LAS float* rwt = (LAS float*)F.lds;
    { const float* src = WSP(float, WS_RWT) + (size_t)l * NE * DM;
        for (int i = F.tid; i < NE * DM / 4; i += 512) *(LAS f32x4*)(rwt + 4 * i) = *(const GAS f32x4*)(src + 4 * i); }
    __syncthreads();
    const float* modl = WSP(float, WS_MOD) + (size_t)l * 9 * 6 * DM; const float* gn = F.in[I_N2G] + (size_t)l * DM;
    const int nrows = l == 0 ? MT : ML;
    for (int r = F.vcu * NWAVES + F.wave; r < nrows; r += F.G * NWAVES) {
        const int rb = r < ML ? (r >> 11) : 8; const float* xr = WSP(float, WS_XM) + (size_t)r * DM;
        f32x4 x[8];
#pragma unroll
        for (int j = 0; j < 8; ++j) x[j] = *(const GAS f32x4*)(xr + j * 256 + 4 * F.lane);
        const float rs = row_rs(x); const float* sh = modl + (size_t)(rb * 6 + 3) * DM; const float* sc = modl + (size_t)(rb * 6 + 4) * DM;
        unsigned char* ho = WSP(unsigned char, WS_H) + (size_t)r * DM;
#pragma unroll
        for (int j = 0; j < 8; ++j) { const int c = j * 256 + 4 * F.lane; const f32x4 g = *(const GAS f32x4*)(gn + c), s1 = *(const GAS f32x4*)(sc + c), s0 = *(const GAS f32x4*)(sh + c);
            x[j] = x[j] * rs * g * (1.0f + s1) + s0; *(GAS unsigned*)(ho + c) = pk4_fp8(x[j][0] * FP8_SH, x[j][1] * FP8_SH, x[j][2] * FP8_SH, x[j][3] * FP8_SH); }
        float p[NE];
#pragma unroll
        for (int eg = 0; eg < NE; eg += 2) { float s0 = 0.f, s1 = 0.f;
#pragma unroll
            for (int j = 0; j < 8; ++j) { const f32x4 w0 = *(const LAS f32x4*)(rwt + eg * DM + j * 256 + 4 * F.lane), w1 = *(const LAS f32x4*)(rwt + (eg + 1) * DM + j * 256 + 4 * F.lane);
                s0 += (x[j][0] * w0[0] + x[j][1] * w0[1]) + (x[j][2] * w0[2] + x[j][3] * w0[3]); s1 += (x[j][0] * w1[0] + x[j][1] * w1[1]) + (x[j][2] * w1[2] + x[j][3] * w1[3]); }
            p[eg] = s0; p[eg + 1] = s1; __builtin_amdgcn_sched_barrier(0); }
        const bool b5 = (F.lane & 32) != 0, b4 = (F.lane & 16) != 0, b3 = (F.lane & 8) != 0, b2 = (F.lane & 4) != 0;
        float q8[8], q4[4], q2[2];
#pragma unroll
        for (int i = 0; i < 8; ++i) { const float keep = b5 ? p[i + 8] : p[i], give = b5 ? p[i] : p[i + 8]; q8[i] = keep + __shfl_xor(give, 32); }
#pragma unroll
        for (int i = 0; i < 4; ++i) { const float keep = b4 ? q8[i + 4] : q8[i], give = b4 ? q8[i] : q8[i + 4]; q4[i] = keep + __shfl_xor(give, 16); }
#pragma unroll
        for (int i = 0; i < 2; ++i) { const float keep = b3 ? q4[i + 2] : q4[i], give = b3 ? q4[i] : q4[i + 2]; q2[i] = keep + __shfl_xor(give, 8); }
        float lg; { const float keep = b2 ? q2[1] : q2[0], give = b2 ? q2[0] : q2[1]; lg = keep + __shfl_xor(give, 4); }
        lg += __shfl_xor(lg, 2); lg += __shfl_xor(lg, 1);
        float mx = lg;
        mx = fmaxf(mx, __shfl_xor(mx, 4)); mx = fmaxf(mx, __shfl_xor(mx, 8)); mx = fmaxf(mx, __shfl_xor(mx, 16)); mx = fmaxf(mx, __shfl_xor(mx, 32));
        const float ex = __expf(lg - mx); float den = ex;
        den += __shfl_xor(den, 4); den += __shfl_xor(den, 8); den += __shfl_xor(den, 16); den += __shfl_xor(den, 32);
        const float mine = ex / den; const int ex_id = (F.lane >> 2) & 15;
        if ((F.lane & 3) == 0) { if (r < ML) WSP(float, WS_AFF)[((size_t)(rb * NE + ex_id) << 11) + (r & 2047)] = mine;
                                 else { const int q = r - ML; WSP(float, WS_AFFC)[((size_t)((q >> 8) * NE + ex_id) << 8) + (q & 255)] = mine; } }
    }
    __syncthreads();
}
__device__ __forceinline__ void unpack8(const v4u w, f32x4& lo, f32x4& hi) { lo = (f32x4){bflo(w.x), bfhi(w.x), bflo(w.y), bfhi(w.y)}; hi = (f32x4){bflo(w.z), bfhi(w.z), bflo(w.w), bfhi(w.w)}; }
__device__ __forceinline__ void phase_conv(Frame& F, int l, int nblk) {
    const bf16* P = WSP(bf16, WS_R1); bf16* cc = WSP(bf16, WS_R2);
    const float* cw = F.in[I_CONVW] + (size_t)l * 3 * DCONV; const float* gn = F.in[I_ONCG] + (size_t)l * DCONV;
    f32x4 w[3][3][2], g[3][2];
#pragma unroll
    for (int ch = 0; ch < 3; ++ch) { const int c0 = ch * 512 + 8 * F.lane;
#pragma unroll
        for (int t = 0; t < 3; ++t) { w[ch][t][0] = *(const GAS f32x4*)(cw + t * DCONV + c0); w[ch][t][1] = *(const GAS f32x4*)(cw + t * DCONV + c0 + 4); }
        g[ch][0] = *(const GAS f32x4*)(gn + c0); g[ch][1] = *(const GAS f32x4*)(gn + c0 + 4); }
    const int nrows = l == 0 ? MT : ML;
    for (int r = F.vcu * NWAVES + F.wave; r < nrows; r += nblk * NWAVES) {
        bool hp, hn; if (r < ML) { const int x = r & 63; hp = x > 0; hn = x < 63; } else { const int t = (r - ML) & 255; hp = t > 0; hn = t < 255; }
        const float mp = hp ? 1.f : 0.f, mn = hn ? 1.f : 0.f;
        const bf16* p0 = P + (size_t)r * (3 * DCONV); const bf16* pp = hp ? p0 - 3 * DCONV : p0; const bf16* pn = hn ? p0 + 3 * DCONV : p0;
        v4u raw[3][7];
#pragma unroll
        for (int ch = 0; ch < 3; ++ch) { const int c0 = ch * 512 + 8 * F.lane;
            raw[ch][0] = *(const GAS v4u*)(p0 + c0); raw[ch][1] = *(const GAS v4u*)(p0 + DCONV + c0); raw[ch][2] = *(const GAS v4u*)(p0 + 2 * DCONV + c0);
            raw[ch][3] = *(const GAS v4u*)(pp + DCONV + c0); raw[ch][4] = *(const GAS v4u*)(pp + 2 * DCONV + c0);
            raw[ch][5] = *(const GAS v4u*)(pn + DCONV + c0); raw[ch][6] = *(const GAS v4u*)(pn + 2 * DCONV + c0); }
#pragma unroll
        for (int ch = 0; ch < 3; ++ch) { const int c0 = ch * 512 + 8 * F.lane;
            f32x4 b0, b1, c0v, c1v, v0, v1, cp0, cp1, vp0, vp1, cn0, cn1, vn0, vn1;
            unpack8(raw[ch][0], b0, b1); unpack8(raw[ch][1], c0v, c1v); unpack8(raw[ch][2], v0, v1); unpack8(raw[ch][3], cp0, cp1); unpack8(raw[ch][4], vp0, vp1); unpack8(raw[ch][5], cn0, cn1); unpack8(raw[ch][6], vn0, vn1);
            const f32x4 y0 = b0 * (w[ch][0][0] * (mp * (cp0 * vp0)) + w[ch][1][0] * (c0v * v0) + w[ch][2][0] * (mn * (cn0 * vn0)));
            const f32x4 y1 = b1 * (w[ch][0][1] * (mp * (cp1 * vp1)) + w[ch][1][1] * (c1v * v1) + w[ch][2][1] * (mn * (cn1 * vn1)));
            float ss = (y0[0] * y0[0] + y0[1] * y0[1]) + (y0[2] * y0[2] + y0[3] * y0[3]) + (y1[0] * y1[0] + y1[1] * y1[1]) + (y1[2] * y1[2] + y1[3] * y1[3]);
            ss += __shfl_xor(ss, 1); ss += __shfl_xor(ss, 2); ss += __shfl_xor(ss, 4); ss += __shfl_xor(ss, 8);
            const float rs = 1.0f / sqrtf(ss * (1.0f / 128.0f) + EPS);
            const f32x4 o0 = y0 * rs * g[ch][0], o1 = y1 * rs * g[ch][1];
            v4u o; o.x = pk2(o0[0], o0[1]); o.y = pk2(o0[2], o0[3]); o.z = pk2(o1[0], o1[1]); o.w = pk2(o1[2], o1[3]);
            *(GAS v4u*)(cc + (size_t)r * DM + c0) = o; }
    }
}
__device__ __forceinline__ void phase_carry(Frame& F, int l) {
    const int gt = F.vcu * 512 + F.tid; if (gt >= NB * NG * 2 * SP) return;
    const int p = gt & 63, d = (gt >> 6) & 1, g = (gt >> 7) & 31, b = gt >> 12;
    const f32x2 lt = WSP(f32x2, WS_LT)[((l * NG + g) * 2 + d) * 64 + p];
    const float* Fb = WSP(float, WS_F); bf16* u2 = WSP(bf16, WS_U2);
    float hr = 0.f, hi = 0.f;
    for (int step = 0; step < 36; ++step) {
        int inst; if (step < 4) inst = 256 + b * 4 + (d == 0 ? step : 3 - step); else inst = b * 32 + (d == 0 ? step - 4 : 35 - step);
        const size_t row = (size_t)g * NINST + inst;
        u2[row * KS2 + 1024 + d * 128 + p] = (bf16)f2bf(hr); u2[row * KS2 + 1024 + d * 128 + 64 + p] = (bf16)f2bf(hi);
        const float fr = *(const GAS float*)(Fb + row * 256 + d * 128 + p), fi = *(const GAS float*)(Fb + row * 256 + d * 128 + 64 + p);
        const float nr = lt.x * hr - lt.y * hi + fr; hi = lt.x * hi + lt.y * hr + fi; hr = nr; }
}
template <int NJ>
__device__ __forceinline__ void topk_wave(Frame& F, const float* aff, int k, int srcrow0, int yrow0, int e, LAS unsigned* av) {
#pragma unroll 1
    for (int j = 0; j < NJ; ++j) av[j * 64 + F.lane] = __builtin_bit_cast(unsigned, *(const GAS float*)(aff + j * 64 + F.lane));
    LDS_WAIT();
    unsigned T = 0u;
#pragma unroll 1
    for (int bit = 30; bit >= 0; --bit) { const unsigned cand = T | (1u << bit); int cnt = 0;
#pragma unroll 4
        for (int j = 0; j < NJ; ++j) cnt += __popcll(__ballot(av[j * 64 + F.lane] >= cand));
        if (cnt >= k) T = cand; }
    int ngt = 0, neq = 0;
#pragma unroll 2
    for (int j = 0; j < NJ; ++j) { const unsigned a = av[j * 64 + F.lane]; ngt += (a > T) ? 1 : 0; neq += (a == T) ? 1 : 0; }
    const int packed = (ngt << 16) | neq; int incl = packed;
#pragma unroll
    for (int o = 1; o < 64; o <<= 1) { const int t = __shfl_up(incl, o); incl += (F.lane >= o) ? t : 0; }
    const int excl = incl - packed, pgt = excl >> 16, peq = excl & 0xffff;
    const int need = k - (__builtin_amdgcn_readlane(incl, 63) >> 16);
    int slot = pgt + (peq < need ? peq : need), eqr = peq;
    int* IDX = WSP(int, WS_IDX); float* VALS = WSP(float, WS_VALS); int* SEL = WSP(int, WS_SEL);
#pragma unroll 1
    for (int j = 0; j < NJ; ++j) { const unsigned a = av[j * 64 + F.lane]; const bool gt = a > T, eq = a == T; const bool sl = gt || (eq && eqr < need); eqr += eq ? 1 : 0;
        const int src = srcrow0 + j * 64 + F.lane;
        if (sl) { IDX[yrow0 + slot] = src; VALS[yrow0 + slot] = __builtin_bit_cast(float, a); }
        SEL[(size_t)src * NE + e] = sl ? yrow0 + slot : -1;
        slot += sl ? 1 : 0; }
}
__device__ __forceinline__ void phase_topk(Frame& F, int l) {
    const int ntask = l == 0 ? 256 : 128;
    LAS unsigned* av = (LAS unsigned*)(F.lds + F.wave * 8192);
    for (int task = F.wave * F.G + F.vcu; task < ntask; task += F.G * NWAVES) {
        const bool isctx = task >= 128; const int q = task & 127, b = q >> 4, e = q & 15;
        const int yrow0 = isctx ? NE * NB * CAPL + e * (NB * CAPC) + b * CAPC : (e * NB + b) * CAPL;
        if (isctx) topk_wave<4>(F, WSP(float, WS_AFFC) + (size_t)(b * NE + e) * CTXL, CAPC, ML + b * CTXL, yrow0, e, av);
        else topk_wave<32>(F, WSP(float, WS_AFF) + (size_t)(b * NE + e) * SEQL, CAPL, b * SEQL, yrow0, e, av);
    }
}
template <class T> __device__ __forceinline__ T* opaque_ptr(T* p) { unsigned long long v = (unsigned long long)p; unsigned lo = (unsigned)v, hi = (unsigned)(v >> 32); asm volatile("" : "+v"(lo), "+v"(hi));
    lo = __builtin_amdgcn_readfirstlane(lo); hi = __builtin_amdgcn_readfirstlane(hi); return (T*)(((unsigned long long)hi << 32) | lo); }
__device__ __forceinline__ void launder(Frame& F) { F.ws = opaque_ptr(F.ws); F.out = opaque_ptr(F.out);
    int t = F.tid; asm volatile("" : "+v"(t)); F.tid = t; F.lane = t & 63; F.wave = __builtin_amdgcn_readfirstlane(t >> 6);
    int g = gridDim.x, bx = blockIdx.x; asm volatile("" : "+v"(g), "+v"(bx)); g = __builtin_amdgcn_readfirstlane(g); bx = __builtin_amdgcn_readfirstlane(bx);
    F.G = g; F.vcu = (g % 8 == 0) ? (bx % 8) * (g / 8) + bx / 8 : bx; }
__device__ __forceinline__ void grid_seam(Frame& F) {
    XcdBarrier b; b.bar = (unsigned*)(F.ws + WS_CTL) + CW_BAR; b.x = xb_xcc_id(); b.st = (volatile LAS unsigned*)(F.lds + MISC_OFF) + 8;
    xcd_barrier(b);
}
constexpr int NPHASE = 24;
struct Args { const float* in[27]; float* out; unsigned char* ws; };
#define IN(k) (LO <= (k) && (k) < HI)
#ifndef PROBE_SUB
#define PROBE_SUB 0
#endif
#ifndef PROBE_MASK
#define PROBE_MASK 0u
#endif
#define PHASE(k) if constexpr (IN(k)) for (int rep_ = 0; rep_ < (((PROBE_MASK >> (k)) & 1u) ? 2 : 1); ++rep_)
#define SEAM(k) do { if constexpr (IN(k) && IN((k) + 1)) grid_seam(F); } while (0)
template <int LO, int HI, int l>
__device__ __forceinline__ void layer_phases(Frame& F) {
    constexpr int pb = 1 + 11 * l;
    PHASE(pb + 0) { launder(F); phase_norm1(F, l); }
    SEAM(pb + 0);
    PHASE(pb + 1) {
        launder(F);
        SchedProj S{(const char*)WSP(bf16, WS_H), (const char*)(WSP(bf16, WS_WIN) + (size_t)l * DINP * DM), F.G, F.vcu, l};
        EpiProj E{WSP(bf16, WS_R1), WSP(bf16, WS_U2)};
        pg8::gemm_phase<EpiProj, SchedProj, true>(F.lds, F.tid, pg8::Dims{DM * 2, DM * 2, DM * 2, nullptr}, S, E);
    }
    SEAM(pb + 1);
    PHASE(pb + 2) {
        launder(F);
        if (F.vcu < F.G - 64) phase_conv(F, l, F.G - 64);
        else { SchedF S{(const char*)WSP(bf16, WS_U2), (const char*)(WSP(bf16, WS_WF) + (size_t)l * NG * 256 * 1024), F.G, F.vcu};
            EpiF32 E{WSP(float, WS_F), 256, (size_t)NINST * 256};
            pg8::gemm_phase<EpiF32, SchedF, false>(F.lds, F.tid, pg8::Dims{KS2 * 2, 1024 * 2, 1024 * 2, nullptr}, S, E); }
    }
    SEAM(pb + 2);
    PHASE(pb + 3) { launder(F); phase_carry(F, l); }
    SEAM(pb + 3);
    PHASE(pb + 4) {
        launder(F);
        SchedS2 S{(const char*)WSP(bf16, WS_U2), (const char*)(WSP(bf16, WS_W2) + (size_t)l * NG * 1024 * KS2), F.G, F.vcu, l};
        EpiS2 E{WSP(bf16, WS_U2), F.in[I_SSMD] + (size_t)l * DSSM, WSP(bf16, WS_Z)};
        pg8::gemm_phase<EpiS2, SchedS2, true>(F.lds, F.tid, pg8::Dims{KS2 * 2, KS2 * 2, KS2 * 2, nullptr}, S, E);
    }
    SEAM(pb + 4);
    PHASE(pb + 5) {
        launder(F);
        SchedGlu S{(const char*)WSP(bf16, WS_Z), (const char*)(WSP(bf16, WS_WGLU) + (size_t)l * DSSM * DSSM), F.G, F.vcu, l == 0 ? 72 : 64};
        EpiGlu E{WSP(bf16, WS_Z), F.in[I_ONSG] + (size_t)l * DSSM, WSP(bf16, WS_R2)};
        if (F.G >= 144) pg8::gemm_phase<EpiGlu, SchedGlu, false>(F.lds, F.tid, pg8::Dims{DSSM * 2, DSSM * 2, DSSM * 2, nullptr}, S, E);
    }
    SEAM(pb + 5);
    PHASE(pb + 6) {
        launder(F);
        SchedOut S{(const char*)WSP(bf16, WS_R2), (const char*)(WSP(bf16, WS_WOUT) + (size_t)l * DM * DM), F.G, F.vcu, l == 0 ? 72 : 64};
        EpiOut E{l == 0 ? F.in[I_X] : WSP(float, WS_XL), l == 0 ? F.in[I_CTX] : WSP(float, WS_XL) + (size_t)ML * DM, WSP(float, WS_MOD) + (size_t)l * 9 * 6 * DM, WSP(float, WS_XM)};
        pg8::gemm_phase<EpiOut, SchedOut, true>(F.lds, F.tid, pg8::Dims{DM * 2, DM * 2, DM * 2, nullptr}, S, E);
    }
    SEAM(pb + 6);
    PHASE(pb + 7) { launder(F); phase_norm2(F, l); }
    SEAM(pb + 7);
    PHASE(pb + 8) { launder(F); phase_topk(F, l); }
    SEAM(pb + 8);
    PHASE(pb + 9) {
        launder(F);
        SchedMoe S{(const char*)WSP(unsigned char, WS_H), (const char*)(WSP(unsigned char, WS_WGU) + (size_t)l * NE * 4096 * DM), F.G, F.vcu, 16, l, 1};
        EpiMoe1 E{WSP(unsigned char, WS_R2)};
        pg8::gemm_phase<EpiMoe1, SchedMoe, true, true, true>(F.lds, F.tid, pg8::Dims{DM, DM, DM, WSP(int, WS_IDX)}, S, E);
    }
    SEAM(pb + 9);
    PHASE(pb + 10) {
        launder(F);
        SchedMoe S{(const char*)WSP(unsigned char, WS_R2), (const char*)(WSP(unsigned char, WS_WDN) + (size_t)l * NE * DM * DF), F.G, F.vcu, 8, l, 0};
        EpiBf16 E{WSP(bf16, WS_R1), DM, 1.0f / (FP8_SW * FP8_SA)};
        pg8::gemm_phase<EpiBf16, SchedMoe, true, true>(F.lds, F.tid, pg8::Dims{DF, DF, DF, nullptr}, S, E);
    }
    SEAM(pb + 10);
}
template <int LO, int HI>
__global__ void __launch_bounds__(NWAVES * 64, 2) trunk_fwd(Args args) {
    extern __shared__ __attribute__((aligned(16))) unsigned char lds[];
    Frame F;
    F.lds = (LAS unsigned char*)lds;
    F.tid = threadIdx.x; F.lane = F.tid & 63; F.wave = __builtin_amdgcn_readfirstlane(F.tid >> 6);
    F.G = gridDim.x; { const int bx = blockIdx.x; F.vcu = (F.G % 8 == 0) ? (bx % 8) * (F.G / 8) + bx / 8 : bx; }
    F.ws = args.ws; F.out = args.out; F.in = args.in;
    for (int u = F.tid; u < (LDS_BYTES - LDSCTL_OFF) / 4; u += NWAVES * 64) ((LAS unsigned*)(F.lds + LDSCTL_OFF))[u] = 0u;
    __syncthreads();
    if constexpr (HI - LO > 1) (void)xcd_barrier_post((unsigned*)(F.ws + WS_CTL) + CW_BAR, (volatile LAS unsigned*)(F.lds + MISC_OFF) + 8);

    PHASE(0) {
        launder(F);
        for (int q_ = 0; q_ < ((PROBE_SUB & 1) ? 2 : 1); ++q_) if (F.vcu < 192) { for (int t = F.vcu; t < 192; t += 192) p0_mod_task(F, t); }
        for (int q_ = 0; q_ < ((PROBE_SUB & 2) ? 2 : 1); ++q_) if (F.vcu >= 192) { for (int t = F.vcu - 192; t < 64; t += F.G - 192) p0_s5_task(F, t); }
        p0_router_t(F);
        for (int q_ = 0; q_ < ((PROBE_SUB & 4) ? 2 : 1); ++q_) p0_convert_weights(F);
    }
    SEAM(0);
    layer_phases<LO, HI, 0>(F);
    layer_phases<LO, HI, 1>(F);
    PHASE(23) { launder(F); phase_final(F); }
}
#undef IN
#undef PHASE
#undef SEAM

template <int P> static void launch_phase(int grid, hipStream_t stream, const Args& a) {
    hipLaunchKernelGGL((trunk_fwd<P, P + 1>), dim3(grid), dim3(NWAVES * 64), LDS_BYTES, stream, a);
}
template <int P> static void set_attr_phase() { (void)hipFuncSetAttribute((const void*)trunk_fwd<P, P + 1>, hipFuncAttributeMaxDynamicSharedMemorySize, LDS_BYTES); }
template <int... Ps> static void launch_all(std::integer_sequence<int, Ps...>, int grid, hipStream_t stream, const Args& a) { (launch_phase<Ps>(grid, stream, a), ...); }
template <int... Ps> static void set_attr_all(std::integer_sequence<int, Ps...>) { (set_attr_phase<Ps>(), ...); }
extern "C" void kernel_launch(void* const* d_in, const int* in_sizes, int n_in, void* d_out, int out_size, void* d_ws, size_t ws_size, hipStream_t stream) {
    static int grid = 0;
    if (grid == 0) {
        if (n_in != 27 || out_size != ML * DM || ws_size < WS_END) { fprintf(stderr, "kernel_launch: expected 27 inputs, %d outputs, >= %zu workspace bytes; got %d, %d, %zu\n", ML * DM, (size_t)WS_END, n_in, out_size, ws_size); grid = -1; return; }
        int dev = 0, cus = 0, per_cu = 0;
        if (hipGetDevice(&dev) != hipSuccess || hipDeviceGetAttribute(&cus, hipDeviceAttributeMultiprocessorCount, dev) != hipSuccess) { grid = -1; return; }
#if MK_N_LAUNCHES == 1
        if (hipFuncSetAttribute((const void*)trunk_fwd<0, NPHASE>, hipFuncAttributeMaxDynamicSharedMemorySize, LDS_BYTES) != hipSuccess) { fprintf(stderr, "kernel_launch: hipFuncSetAttribute failed\n"); grid = -1; return; }
        if (hipOccupancyMaxActiveBlocksPerMultiprocessor(&per_cu, (const void*)trunk_fwd<0, NPHASE>, NWAVES * 64, LDS_BYTES) != hipSuccess || per_cu < 1) fprintf(stderr, "kernel_launch: occupancy query reports %d\n", per_cu);
#else
        set_attr_all(std::make_integer_sequence<int, NPHASE>{});
#endif
        (void)hipGetLastError();
        grid = cus;
        if (grid < 256 || grid % 8 != 0) { fprintf(stderr, "kernel_launch: unexpected CU count %d\n", cus); }
    }
    if (grid < 0) return;
    (void)hipMemsetAsync((char*)d_ws + WS_CTL, 0, CTL_ZERO_BYTES, stream);
    Args a{};
    for (int i = 0; i < 27; ++i) a.in[i] = (const float*)d_in[i];
    a.out = (float*)d_out; a.ws = (unsigned char*)d_ws;
#if MK_N_LAUNCHES == 1
    hipLaunchKernelGGL((trunk_fwd<0, NPHASE>), dim3(grid), dim3(NWAVES * 64), LDS_BYTES, stream, a);
#else
    launch_all(std::make_integer_sequence<int, NPHASE>{}, grid, stream, a);
#endif
    const hipError_t le = hipPeekAtLastError();
    if (le != hipSuccess) fprintf(stderr, "kernel_launch: launch failed: %s\n", hipGetErrorName(le));
}
```

```cpp
#include <hip/hip_runtime.h>
#include <cstdio>
#include <cstdint>
#include <utility>

#define GAS __attribute__((address_space(1)))
#define LAS __attribute__((address_space(3)))
typedef unsigned short bf16;
typedef unsigned v4u __attribute__((ext_vector_type(4)));
typedef unsigned v2u __attribute__((ext_vector_type(2)));
typedef float f32x4 __attribute__((ext_vector_type(4)));
typedef float f32x2 __attribute__((ext_vector_type(2)));
typedef short bf16x8 __attribute__((ext_vector_type(8)));
typedef GAS unsigned gu32;

#ifndef MK_N_LAUNCHES
#define MK_N_LAUNCHES 1
#endif

constexpr int NB = 8, SEQL = 2048, CTXL = 256, DM = 2048;
constexpr int ML = NB * SEQL, MC = NB * CTXL, MT = ML + MC;
constexpr int DCONV = 1536, DSSM = 512, DINP = 3 * DCONV + DSSM;
constexpr int NG = 32, SG = 16, SP = 64, TCH = 64;
constexpr int NE = 16, DF = 2048, CAPL = 256, CAPC = 32;
constexpr int NINST = 512, KS2 = 1280;
constexpr int YROWS = NE * NB * CAPL + NE * NB * CAPC;
constexpr float EPS = 1e-6f;

constexpr size_t MiB = 1u << 20;
constexpr size_t WS_CTL = 0, CTL_ZERO_BYTES = 1 * MiB;
constexpr size_t WS_MOD = 1 * MiB;
constexpr size_t WS_RWT = 2 * MiB;
constexpr size_t WS_LT = 2 * MiB + 512 * 1024;
constexpr size_t WS_AFF = 3 * MiB;
constexpr size_t WS_AFFC = 4 * MiB;
constexpr size_t WS_IDX = 5 * MiB;
constexpr size_t WS_VALS = 5 * MiB + 256 * 1024;
constexpr size_t WS_SEL = 6 * MiB;
constexpr size_t WS_WGLU = 8 * MiB;
constexpr size_t WS_WOUT = 9 * MiB;
constexpr size_t WS_WIN = 25 * MiB;
constexpr size_t WS_WF = 65 * MiB;
constexpr size_t WS_W2 = 97 * MiB;
constexpr size_t WS_WGU = 257 * MiB;
constexpr size_t WS_WDN = 769 * MiB;
constexpr size_t WS_XL = 1025 * MiB;
constexpr size_t WS_XM = 1169 * MiB;
constexpr size_t WS_H = 1313 * MiB;
constexpr size_t WS_F = 1385 * MiB;
constexpr size_t WS_R1 = 1401 * MiB;
constexpr size_t WS_R2 = 1563 * MiB;
constexpr size_t WS_U2 = WS_R2 + 72 * MiB;
constexpr size_t WS_Z = WS_R2 + 112 * MiB;
constexpr size_t WS_END = 1707 * MiB;
constexpr int CW_BAR = 4096;

constexpr int RING_BYTES = 131072;
constexpr int LDSCTL_OFF = RING_BYTES, MISC_OFF = LDSCTL_OFF + 320;
constexpr int LDS_BYTES = 147456;
constexpr int NWAVES = 8;

#define LDS_WAIT() asm volatile("s_waitcnt lgkmcnt(0)" ::: "memory")
#define VM_WAIT() asm volatile("s_waitcnt vmcnt(0)" ::: "memory")
__device__ __forceinline__ unsigned f2bf(float f) { unsigned u = __builtin_bit_cast(unsigned, f); return (u + 0x7fffu + ((u >> 16) & 1u)) >> 16; }
__device__ __forceinline__ unsigned pk2(float lo, float hi) { return f2bf(lo) | (f2bf(hi) << 16); }
__device__ __forceinline__ float bflo(unsigned w) { return __builtin_bit_cast(float, w << 16); }
__device__ __forceinline__ float bfhi(unsigned w) { return __builtin_bit_cast(float, w & 0xffff0000u); }
__device__ __forceinline__ float wave_sum(float v) {
#pragma unroll
    for (int o = 1; o < 64; o <<= 1) v += __shfl_xor(v, o);
    return v;
}
__device__ __forceinline__ float sigmoidf_(float x) { return 1.0f / (1.0f + __expf(-x)); }
__device__ __forceinline__ float gelu_tanh(float y) { const float a = 1.5957691216f * (y + 0.044715f * y * y * y); return y * sigmoidf_(a); }

#ifndef FP8_SCALE1
#define FP8_SCALE1 0x7f7f7f7f
#endif
namespace pg8 {
constexpr int BM = 256, BK = 64, HALF = 128, HTB = HALF * BK * 2, STAGE_BYTES = 8 * HTB;
__host__ __device__ __forceinline__ int lds_byte(int r, int c) { const int st = (r >> 4) * 2 + (c >> 5), rr = r & 15, cc = c & 31, ob = rr * 64 + cc * 2; return st * 1024 + (ob ^ (((ob >> 9) & 1) << 5)); }
__host__ __device__ __forceinline__ void stage_rc(int b, int& R, int& C) { const int st = b / 1024, sb = b % 1024, swz = sb ^ (((sb >> 9) & 1) << 5); R = (st >> 1) * 16 + swz / 64; C = (st & 1) * 32 + (swz % 64) / 2; }
__host__ __device__ __forceinline__ int perm32(int rho) { const int n = rho >> 4, i = rho & 15; return 8 * (i >> 2) + 4 * n + (i & 3); }
__device__ __forceinline__ unsigned cvt_pk_bf16(float lo, float hi) { unsigned r; asm volatile("v_cvt_pk_bf16_f32 %0, %1, %2" : "=v"(r) : "v"(lo), "v"(hi)); return r; }

struct Unit { const char* a; const char* b; int pm, pn, aux; };
struct Dims { int lda, ldb, K; const int* gidx; };
typedef int v4i_t __attribute__((ext_vector_type(4)));
typedef int v8i_t __attribute__((ext_vector_type(8)));
template <bool FP8> struct Frag { bf16x8 k[2]; };
template <> struct Frag<true> { v8i_t v; };

template <class Epi, class Sched, bool ALIGN_EPI, bool FP8 = false, bool GATHER = false>
__device__ __forceinline__ void gemm_phase(LAS unsigned char* lds, const int tid, const Dims g, const Sched& S, const Epi& E) {
    const int wid = __builtin_amdgcn_readfirstlane(tid >> 6), lane = tid & 63, wr = wid >> 2, wc = wid & 3, fr = lane & 15, fq = lane >> 4;
    const int nt = g.K / (BK * 2);
    unsigned voffA[2], voffB[2];
#pragma unroll
    for (int i = 0; i < 2; ++i) { int R, C; stage_rc(tid * 16 + i * 8192, R, C); const int Rb = Epi::PERM ? ((R & ~31) + perm32(R & 31)) : R;
        voffA[i] = (unsigned)(R * g.lda + C * 2); voffB[i] = (unsigned)(Rb * g.ldb + C * 2); }
    const size_t kstep = (size_t)(BK * 2);
    const size_t hstepA = (size_t)HALF * g.lda, hstepB = (size_t)HALF * g.ldb;
    const unsigned ldsw = (unsigned)wid * 1024u;
    const int aoff = lds_byte(wr * 64 + fr, fq * 8), boff = lds_byte(wc * 32 + fr, fq * 8);
#define PG8_SA(b, h) (((b) * 2 + (h)) * HTB)
#define PG8_SB(b, h) ((4 + (b) * 2 + (h)) * HTB)
#define PG8_STAGE(bufoff, gbase, voff) do { _Pragma("unroll") for (int _i = 0; _i < 2; ++_i) \
        __builtin_amdgcn_global_load_lds((const unsigned*)((const char*)(gbase) + (voff)[_i]), (LAS unsigned*)(lds + (bufoff) + ldsw + _i * 8192), 16, 0, 0); } while (0)
#define PG8_STAGE_A(bufoff, gbase, h, isnext) do { if constexpr (GATHER) { if (isnext) PG8_STAGE(bufoff, gbase, gAn[h]); else PG8_STAGE(bufoff, gbase, gA[h]); } \
        else PG8_STAGE(bufoff, (gbase) + ((h) ? hstepA : (size_t)0), voffA); } while (0)
#define PG8_GIDX(dst, u) do { _Pragma("unroll") for (int h_ = 0; h_ < 2; ++h_) _Pragma("unroll") for (int i_ = 0; i_ < 2; ++i_) { int R_, C_; stage_rc(tid * 16 + i_ * 8192, R_, C_); \
        dst[h_][i_] = (unsigned)(*(const GAS int*)(g.gidx + (u).pm * 256 + h_ * 128 + R_)) * (unsigned)g.lda + (unsigned)(C_ * 2); } } while (0)
#define PG8_LD1(dst, p) do { if constexpr (FP8) { const v4i_t lo_ = *(const LAS v4i_t*)(p), hi_ = *(const LAS v4i_t*)((p) + 1024); dst.v = __builtin_shufflevector(lo_, hi_, 0, 1, 2, 3, 4, 5, 6, 7); } \
        else { dst.k[0] = *(const LAS bf16x8*)(p); dst.k[1] = *(const LAS bf16x8*)((p) + 1024); } } while (0)
#define PG8_LDA(dst, b, h) do { _Pragma("unroll") for (int m = 0; m < 4; ++m) PG8_LD1(dst[m], lds + PG8_SA(b, h) + aoff + m * 2048); } while (0)
#define PG8_LDB(dst, b, h) do { _Pragma("unroll") for (int n = 0; n < 2; ++n) PG8_LD1(dst[n], lds + PG8_SB(b, h) + boff + n * 2048); } while (0)
#define PG8_MMA(ai, bj, At, Bt) do { __builtin_amdgcn_s_setprio(1); _Pragma("unroll") for (int m = 0; m < 4; ++m) _Pragma("unroll") for (int n = 0; n < 2; ++n) { \
        if constexpr (FP8) asm volatile("v_mfma_f32_16x16x128_f8f6f4 %0, %1, %2, %0" : "+v"(acc[ai][bj][m][n]) : "v"(Bt[n].v), "v"(At[m].v)); \
        else { _Pragma("unroll") for (int k = 0; k < 2; ++k) acc[ai][bj][m][n] = __builtin_amdgcn_mfma_f32_16x16x32_bf16(Bt[n].k[k], At[m].k[k], acc[ai][bj][m][n], 0, 0, 0); } } __builtin_amdgcn_s_setprio(0); } while (0)
#define PG8_WAIT_V(n) asm volatile("s_waitcnt vmcnt(" #n ")" ::: "memory")
#define PG8_WAIT_L(n) asm volatile("s_waitcnt lgkmcnt(" #n ")" ::: "memory")
#define PG8_BAR __builtin_amdgcn_s_barrier()
#define PG8_SCHED __builtin_amdgcn_sched_barrier(0)
    Unit cur, nxt; int ui = 0;
    if (!S.next(0, cur)) return;
    f32x4 acc[2][2][4][2];
#pragma unroll
    for (int a = 0; a < 2; ++a)
#pragma unroll
        for (int b = 0; b < 2; ++b)
#pragma unroll
            for (int m = 0; m < 4; ++m)
#pragma unroll
                for (int n = 0; n < 2; ++n) acc[a][b][m][n] = (f32x4){0.f, 0.f, 0.f, 0.f};
    Frag<FP8> At[4], B0[2], B1[2];
    const char* cA = cur.a; const char* cB = cur.b;
    unsigned gA[2][2], gAn[2][2];
    if constexpr (GATHER) { PG8_GIDX(gA, cur); _Pragma("unroll") for (int h_ = 0; h_ < 2; ++h_) _Pragma("unroll") for (int i_ = 0; i_ < 2; ++i_) gAn[h_][i_] = gA[h_][i_]; }
    PG8_STAGE(PG8_SB(0, 0), cB, voffB); PG8_STAGE(PG8_SB(0, 1), cB + hstepB, voffB); PG8_STAGE_A(PG8_SA(0, 0), cA, 0, false); PG8_STAGE_A(PG8_SA(0, 1), cA, 1, false);
    if (wr == 1) PG8_BAR;
    PG8_WAIT_V(2); PG8_BAR;
    PG8_STAGE(PG8_SB(1, 0), cB + kstep, voffB); PG8_STAGE_A(PG8_SA(1, 0), cA + kstep, 0, false); PG8_STAGE(PG8_SB(1, 1), cB + hstepB + kstep, voffB);
    PG8_WAIT_V(6); PG8_BAR;
    for (;;) {
        const bool has_next = S.next(ui + 1, nxt);
        const char* nA = has_next ? nxt.a : cA; const char* nB = has_next ? nxt.b : cB;
        for (int t = 0; t < nt; t += 2) {
            const bool last = (t == nt - 2);
            const char* a1 = cA + (size_t)(t + 1) * kstep;
            if constexpr (GATHER) { if (t == nt - 4 && has_next) PG8_GIDX(gAn, nxt); }
            const char* a2 = last ? nA : cA + (size_t)(t + 2) * kstep; const char* b2 = last ? nB : cB + (size_t)(t + 2) * kstep;
            const char* a3 = a2 + kstep; const char* b3 = b2 + kstep;
            PG8_LDB(B0, 0, 0); PG8_LDB(B1, 0, 1); PG8_SCHED; PG8_LDA(At, 0, 0); PG8_STAGE_A(PG8_SA(1, 1), a1, 1, false);
            PG8_WAIT_V(8); PG8_WAIT_L(0); PG8_BAR; PG8_MMA(0, 0, At, B0); PG8_MMA(0, 1, At, B1); PG8_BAR; PG8_SCHED;
            PG8_LDA(At, 0, 1); PG8_STAGE(PG8_SB(0, 0), b2, voffB); PG8_STAGE(PG8_SB(0, 1), b2 + hstepB, voffB); PG8_STAGE_A(PG8_SA(0, 0), a2, 0, last);
            PG8_WAIT_V(8); PG8_WAIT_L(0); PG8_BAR; PG8_MMA(1, 0, At, B0); PG8_MMA(1, 1, At, B1); PG8_BAR; PG8_SCHED;
            PG8_LDB(B0, 1, 0); PG8_LDB(B1, 1, 1); PG8_SCHED; PG8_LDA(At, 1, 0); PG8_STAGE_A(PG8_SA(0, 1), a2, 1, last);
            PG8_WAIT_V(8); PG8_WAIT_L(0); PG8_BAR; PG8_MMA(0, 0, At, B0); PG8_MMA(0, 1, At, B1); PG8_BAR; PG8_SCHED;
            PG8_LDA(At, 1, 1); PG8_STAGE(PG8_SB(1, 0), b3, voffB); PG8_STAGE(PG8_SB(1, 1), b3 + hstepB, voffB); PG8_STAGE_A(PG8_SA(1, 0), a3, 0, last);
            PG8_WAIT_V(8); PG8_WAIT_L(0); PG8_BAR; PG8_MMA(1, 0, At, B0); PG8_MMA(1, 1, At, B1); PG8_BAR; PG8_SCHED;
        }
        if constexpr (FP8) asm volatile("s_nop 15\n\ts_nop 7" ::: "memory");
        if constexpr (ALIGN_EPI) { if (wr == 0) PG8_BAR; }
        if constexpr (!Epi::AFTER_DRAIN) { E(acc, cur, wr, wc, fr, fq); }
        if (!has_next) break;
#pragma unroll
        for (int a = 0; a < 2; ++a)
#pragma unroll
            for (int b = 0; b < 2; ++b)
#pragma unroll
                for (int m = 0; m < 4; ++m)
#pragma unroll
                    for (int n = 0; n < 2; ++n) acc[a][b][m][n] = (f32x4){0.f, 0.f, 0.f, 0.f};
        cur = nxt; cA = nA; cB = nB; ++ui;
        if constexpr (GATHER) { _Pragma("unroll") for (int h_ = 0; h_ < 2; ++h_) _Pragma("unroll") for (int i_ = 0; i_ < 2; ++i_) gA[h_][i_] = gAn[h_][i_]; }
        if constexpr (ALIGN_EPI) { if (wr == 1) PG8_BAR; }
    }
    PG8_WAIT_V(0);
    if constexpr (!ALIGN_EPI) { if (wr == 0) PG8_BAR; }
    PG8_BAR;
    if constexpr (Epi::AFTER_DRAIN) { E.fused(acc, cur, wr, wc, fr, fq, lds, wid, lane); }
#undef PG8_SA
#undef PG8_SB
#undef PG8_STAGE
#undef PG8_STAGE_A
#undef PG8_GIDX
#undef PG8_LDA
#undef PG8_LDB
#undef PG8_MMA
#undef PG8_LD1
#undef PG8_WAIT_V
#undef PG8_WAIT_L
#undef PG8_BAR
#undef PG8_SCHED
}
}

#define XB_TMO      128
#define XB_XCNT(j)  (256  + 64 * (j))
#define XB_XSUB(j)  (1280 + 64 * (j))
#define XB_XGEN(j)  (2304 + 64 * (j))
#define XB_TOP      3328
#define XB_TOPGEN   3392
#define XCD_BAR_WORDS 3456
#define XB_SPIN_CAP (1u << 18)

__device__ __forceinline__ unsigned xb_ld(unsigned* p)              { return __hip_atomic_load(p, __ATOMIC_RELAXED, __HIP_MEMORY_SCOPE_AGENT); }
__device__ __forceinline__ unsigned xb_add(unsigned* p, unsigned v) { return __hip_atomic_fetch_add(p, v, __ATOMIC_RELAXED, __HIP_MEMORY_SCOPE_AGENT); }
__device__ __forceinline__ unsigned xb_xcc_id() { return (unsigned)__builtin_amdgcn_s_getreg((3 << 11) | 20) & 0xFu; }
#define XB_SPIN(cond, bar) do { unsigned _sp = 0; while (cond) { __builtin_amdgcn_s_sleep(1); \
    if ((++_sp & 255u) == 0u) { if (xb_ld(&(bar)[XB_TMO])) break; if (_sp > XB_SPIN_CAP) { atomicAdd(&(bar)[XB_TMO], 1u); break; } } } } while (0)

struct XcdBarrier {
    unsigned* bar; unsigned x;
    volatile LAS unsigned* st;
};
__device__ __forceinline__ XcdBarrier xcd_barrier_post(unsigned* bar, volatile LAS unsigned* st) {
    XcdBarrier b; b.bar = bar; b.x = xb_xcc_id(); b.st = st;
    if (threadIdx.x == 0) (void)xb_add(&bar[XB_XCNT(b.x)], 1u);
    return b;
}
__device__ __forceinline__ void xcd_barrier_complete(unsigned* bar, unsigned x, unsigned& nloc, unsigned& nx) {
    const unsigned G = gridDim.x * gridDim.y * gridDim.z;
    unsigned sum, cnt, mine, sp = 0u;
    for (;;) {
        sum = 0u; cnt = 0u; mine = 0u;
#pragma unroll
        for (unsigned j = 0; j < 16; ++j) { const unsigned c = xb_ld(&bar[XB_XCNT(j)]); sum += c; cnt += (c > 0u) ? 1u : 0u; mine = (j == x) ? c : mine; }
        if (sum == G) break;
        __builtin_amdgcn_s_sleep(1);
        if ((++sp & 255u) == 0u) { if (xb_ld(&bar[XB_TMO])) break; if (sp > XB_SPIN_CAP) { atomicAdd(&bar[XB_TMO], 1u); break; } }
    }
    nloc = mine > 0u ? mine : 1u; nx = cnt > 0u ? cnt : 1u;
}
__device__ __forceinline__ void xcd_barrier(const XcdBarrier& b) {
    asm volatile("s_waitcnt vmcnt(0)" ::: "memory");
    __syncthreads();
    if (threadIdx.x == 0) {
        unsigned* bar = b.bar;
        __builtin_amdgcn_s_waitcnt(0);
        unsigned nloc = b.st[0], nx = b.st[1];
        if (nloc == 0u) { xcd_barrier_complete(bar, b.x, nloc, nx); b.st[0] = nloc; b.st[1] = nx; }
        const unsigned old = xb_add(&bar[XB_XSUB(b.x)], 1u);
        const unsigned gen = old / nloc;
        if (old + 1u == (gen + 1u) * nloc) {
            __builtin_amdgcn_fence(__ATOMIC_RELEASE, "agent");
            asm volatile("s_waitcnt vmcnt(0)" ::: "memory");
            const unsigned og = xb_add(&bar[XB_TOP], 1u);
            const unsigned tg = og / nx;
            if (og + 1u == (tg + 1u) * nx) xb_add(&bar[XB_TOPGEN], 1u);
            else XB_SPIN(xb_ld(&bar[XB_TOPGEN]) == tg, bar);
            __builtin_amdgcn_fence(__ATOMIC_ACQUIRE, "agent");
            xb_add(&bar[XB_XGEN(b.x)], 1u);
            asm volatile("s_waitcnt vmcnt(0)" ::: "memory");
        } else {
            XB_SPIN(xb_ld(&bar[XB_XGEN(b.x)]) == gen, bar);
            __builtin_amdgcn_fence(__ATOMIC_ACQUIRE, "agent");
            asm volatile("s_waitcnt vmcnt(0)" ::: "memory");
        }
    }
    __syncthreads();
}

struct Frame {
    LAS unsigned char* lds;
    int tid, lane, wave, vcu, G;
    unsigned char* ws;
    const float* const* in;
    float* out;
};
#define WSP(T, off) ((T*)(F.ws + (off)))
enum InIdx { I_X = 0, I_C, I_CTX, I_CCTX, I_ADAW, I_ADAB, I_N1G, I_WIN, I_CONVW, I_LRE, I_LIM, I_LDT, I_BRE, I_BIM, I_CRE, I_CIM, I_SSMD, I_WGLU, I_ONCG, I_ONSG, I_WOUT, I_N2G, I_RW, I_WG, I_WU, I_WD, I_FNG };

using pg8::Unit;
struct EpiProj {
    static constexpr bool PERM = true, AFTER_DRAIN = false;
    bf16* proj; bf16* u2;
    __device__ __forceinline__ void operator()(const f32x4 (&acc)[2][2][4][2], const Unit& u, int wr, int wc, int fr, int fq) const {
        const int row0 = u.pm * 256 + wr * 64 + fr, col0 = u.pn * 256 + wc * 32 + 8 * fq;
#pragma unroll
        for (int ai = 0; ai < 2; ++ai)
#pragma unroll
            for (int m = 0; m < 4; ++m) { const int row = row0 + ai * 128 + m * 16;
#pragma unroll
                for (int bj = 0; bj < 2; ++bj) { const f32x4 v0 = acc[ai][bj][m][0], v1 = acc[ai][bj][m][1]; const int col = col0 + bj * 128;
                    v4u w; w.x = pg8::cvt_pk_bf16(v0[0], v0[1]); w.y = pg8::cvt_pk_bf16(v0[2], v0[3]); w.z = pg8::cvt_pk_bf16(v1[0], v1[1]); w.w = pg8::cvt_pk_bf16(v1[2], v1[3]);
                    bf16* dst;
                    if (u.pn < 18) dst = proj + (size_t)row * (3 * DCONV) + col;
                    else { const int cc = col - 3 * DCONV, g = cc >> 4, i0 = cc & 15; dst = u2 + ((size_t)(g * NINST + (row >> 6)) * KS2 + (row & 63) * 16 + i0); }
                    *(GAS v4u*)dst = w; } }
    }
};
struct EpiF32 {
    static constexpr bool PERM = false, AFTER_DRAIN = false;
    float* C; int ldc; size_t cstride;
    __device__ __forceinline__ void operator()(const f32x4 (&acc)[2][2][4][2], const Unit& u, int wr, int wc, int fr, int fq) const {
        float* base = C + (size_t)u.aux * cstride; const int row0 = u.pm * 256 + wr * 64 + fr, col0 = u.pn * 256 + wc * 32 + 4 * fq;
#pragma unroll
        for (int ai = 0; ai < 2; ++ai)
#pragma unroll
            for (int m = 0; m < 4; ++m) { float* rowp = base + (size_t)(row0 + ai * 128 + m * 16) * ldc + col0;
#pragma unroll
                for (int bj = 0; bj < 2; ++bj)
#pragma unroll
                    for (int n = 0; n < 2; ++n) *(GAS f32x4*)(rowp + bj * 128 + n * 16) = acc[ai][bj][m][n]; }
    }
};
struct EpiS2 {
    static constexpr bool PERM = true, AFTER_DRAIN = false;
    const bf16* u2; const float* dsk; bf16* z;
    __device__ __forceinline__ void operator()(const f32x4 (&acc)[2][2][4][2], const Unit& u, int wr, int wc, int fr, int fq) const {
        const int g = u.aux, inst0 = u.pm * 256 + wr * 64 + fr, c0 = u.pn * 256 + wc * 32 + 8 * fq;
#pragma unroll
        for (int bj = 0; bj < 2; ++bj) { const int cidx = c0 + bj * 128, t = cidx >> 4, o0 = cidx & 15;
            const f32x4 d0 = *(const GAS f32x4*)(dsk + g * 16 + o0), d1 = *(const GAS f32x4*)(dsk + g * 16 + o0 + 4);
#pragma unroll
            for (int ai = 0; ai < 2; ++ai)
#pragma unroll
                for (int m = 0; m < 4; ++m) { const int inst = inst0 + ai * 128 + m * 16;
                    if (inst < MT / 64) {
                        const v4u uu = *(const GAS v4u*)(u2 + ((size_t)(g * NINST + inst) * KS2 + cidx));
                        const f32x4 a0 = acc[ai][bj][m][0], a1 = acc[ai][bj][m][1];
                        const float y0 = a0[0] + d0[0] * bflo(uu.x), y1 = a0[1] + d0[1] * bfhi(uu.x), y2 = a0[2] + d0[2] * bflo(uu.y), y3 = a0[3] + d0[3] * bfhi(uu.y);
                        const float y4 = a1[0] + d1[0] * bflo(uu.z), y5 = a1[1] + d1[1] * bfhi(uu.z), y6 = a1[2] + d1[2] * bflo(uu.w), y7 = a1[3] + d1[3] * bfhi(uu.w);
                        v4u w; w.x = pg8::cvt_pk_bf16(gelu_tanh(y0), gelu_tanh(y1)); w.y = pg8::cvt_pk_bf16(gelu_tanh(y2), gelu_tanh(y3));
                        w.z = pg8::cvt_pk_bf16(gelu_tanh(y4), gelu_tanh(y5)); w.w = pg8::cvt_pk_bf16(gelu_tanh(y6), gelu_tanh(y7));
                        *(GAS v4u*)(z + ((size_t)(inst * 64 + t) * DSSM + g * 16 + o0)) = w; } } }
    }
};
struct EpiGlu {
    static constexpr bool PERM = true, AFTER_DRAIN = true;
    const bf16* z; const float* gain; bf16* concat;
    __device__ __forceinline__ void operator()(const f32x4 (&)[2][2][4][2], const Unit&, int, int, int, int) const {}
    __device__ __forceinline__ void fused(f32x4 (&acc)[2][2][4][2], const Unit& u, int wr, int wc, int fr, int fq, LAS unsigned char* lds, int wid, int lane) const {
        LAS float* P = (LAS float*)lds;
        const int row0 = u.pm * 256 + wr * 64 + fr, col0 = u.pn * 256 + wc * 32 + 8 * fq;
#pragma unroll
        for (int ai = 0; ai < 2; ++ai)
#pragma unroll
            for (int m = 0; m < 4; ++m) { const int row = row0 + ai * 128 + m * 16, rt = ai * 128 + wr * 64 + m * 16 + fr;
#pragma unroll
                for (int bj = 0; bj < 2; ++bj) { const v4u zz = *(const GAS v4u*)(z + (size_t)row * DSSM + col0 + bj * 128);
                    f32x4 a0 = acc[ai][bj][m][0], a1 = acc[ai][bj][m][1];
                    a0[0] = bflo(zz.x) * sigmoidf_(a0[0]); a0[1] = bfhi(zz.x) * sigmoidf_(a0[1]); a0[2] = bflo(zz.y) * sigmoidf_(a0[2]); a0[3] = bfhi(zz.y) * sigmoidf_(a0[3]);
                    a1[0] = bflo(zz.z) * sigmoidf_(a1[0]); a1[1] = bfhi(zz.z) * sigmoidf_(a1[1]); a1[2] = bflo(zz.w) * sigmoidf_(a1[2]); a1[3] = bfhi(zz.w) * sigmoidf_(a1[3]);
                    acc[ai][bj][m][0] = a0; acc[ai][bj][m][1] = a1;
                    float s = (a0[0] * a0[0] + a0[1] * a0[1]) + (a0[2] * a0[2] + a0[3] * a0[3]) + (a1[0] * a1[0] + a1[1] * a1[1]) + (a1[2] * a1[2] + a1[3] * a1[3]);
                    s += __shfl_xor(s, 16); s += __shfl_xor(s, 32);
                    if (fq == 0) P[(rt * 2 + bj) * 4 + wc] = s; } }
        LDS_WAIT(); __builtin_amdgcn_s_barrier(); asm volatile("" ::: "memory");
#pragma unroll
        for (int bj = 0; bj < 2; ++bj) { const int col = col0 + bj * 128;
            const f32x4 g0 = *(const GAS f32x4*)(gain + col), g1 = *(const GAS f32x4*)(gain + col + 4);
#pragma unroll
            for (int ai = 0; ai < 2; ++ai)
#pragma unroll
                for (int m = 0; m < 4; ++m) { const int row = row0 + ai * 128 + m * 16, rt = ai * 128 + wr * 64 + m * 16 + fr;
                    const f32x4 p = *(const LAS f32x4*)(P + (rt * 2 + bj) * 4);
                    const float rs = 1.0f / sqrtf(((p[0] + p[1]) + (p[2] + p[3])) * (1.0f / 128.0f) + EPS);
                    const f32x4 a0 = acc[ai][bj][m][0] * rs * g0, a1 = acc[ai][bj][m][1] * rs * g1;
                    v4u w; w.x = pg8::cvt_pk_bf16(a0[0], a0[1]); w.y = pg8::cvt_pk_bf16(a0[2], a0[3]); w.z = pg8::cvt_pk_bf16(a1[0], a1[1]); w.w = pg8::cvt_pk_bf16(a1[2], a1[3]);
                    *(GAS v4u*)(concat + (size_t)row * DM + DCONV + col) = w; } }
    }
};
template <bool XBF16> struct EpiOut {
    static constexpr bool PERM = true, AFTER_DRAIN = false;
    const void* xlat; const void* xctx; const float* mod; bf16* xm;
    __device__ __forceinline__ void operator()(const f32x4 (&acc)[2][2][4][2], const Unit& u, int wr, int wc, int fr, int fq) const {
        const int rb = u.pm < 64 ? (u.pm >> 3) : 8; const float* g1 = mod + (size_t)(rb * 6 + 2) * DM;
        const size_t rowoff = u.pm < 64 ? (size_t)u.pm * 256 * DM : (size_t)(u.pm - 64) * 256 * DM; const void* xbase = u.pm < 64 ? xlat : xctx;
        bf16* xo = xm + (size_t)u.pm * 256 * DM;
        const int r0 = wr * 64 + fr, col0 = u.pn * 256 + wc * 32 + 8 * fq;
        f32x4 gv[2][2];
#pragma unroll
        for (int bj = 0; bj < 2; ++bj)
#pragma unroll
            for (int n = 0; n < 2; ++n) gv[bj][n] = *(const GAS f32x4*)(g1 + col0 + bj * 128 + n * 4);
#pragma unroll
        for (int am = 0; am < 4; ++am) { const int ai = am >> 1, m0 = (am & 1) * 2; f32x4 xv[2][2][2];
#pragma unroll
            for (int mm = 0; mm < 2; ++mm) { const size_t off = rowoff + (size_t)(r0 + ai * 128 + (m0 + mm) * 16) * DM + col0;
#pragma unroll
                for (int bj = 0; bj < 2; ++bj) {
                    if constexpr (XBF16) { const v4u w = *(const GAS v4u*)((const bf16*)xbase + off + bj * 128); xv[mm][bj][0] = (f32x4){bflo(w.x), bfhi(w.x), bflo(w.y), bfhi(w.y)}; xv[mm][bj][1] = (f32x4){bflo(w.z), bfhi(w.z), bflo(w.w), bfhi(w.w)}; }
                    else { xv[mm][bj][0] = *(const GAS f32x4*)((const float*)xbase + off + bj * 128); xv[mm][bj][1] = *(const GAS f32x4*)((const float*)xbase + off + bj * 128 + 4); } } }
#pragma unroll
            for (int mm = 0; mm < 2; ++mm) { const int m = m0 + mm; const size_t off = (size_t)(r0 + ai * 128 + m * 16) * DM + col0;
#pragma unroll
                for (int bj = 0; bj < 2; ++bj) { const f32x4 o0 = xv[mm][bj][0] + gv[bj][0] * acc[ai][bj][m][0], o1 = xv[mm][bj][1] + gv[bj][1] * acc[ai][bj][m][1];
                    v4u w; w.x = pg8::cvt_pk_bf16(o0[0], o0[1]); w.y = pg8::cvt_pk_bf16(o0[2], o0[3]); w.z = pg8::cvt_pk_bf16(o1[0], o1[1]); w.w = pg8::cvt_pk_bf16(o1[2], o1[3]);
                    *(GAS v4u*)(xo + off + bj * 128) = w; } }
            asm volatile("" ::: "memory"); }
    }
};
constexpr float FP8_SW = 64.f, FP8_SH = 16.f, FP8_SA = 8.f;
__device__ __forceinline__ unsigned pk4_fp8(float a, float b, float c, float d) {
    a = __builtin_amdgcn_fmed3f(a, -448.f, 448.f); b = __builtin_amdgcn_fmed3f(b, -448.f, 448.f); c = __builtin_amdgcn_fmed3f(c, -448.f, 448.f); d = __builtin_amdgcn_fmed3f(d, -448.f, 448.f);
    unsigned w = (unsigned)__builtin_amdgcn_cvt_pk_fp8_f32(a, b, 0, false); return (unsigned)__builtin_amdgcn_cvt_pk_fp8_f32(c, d, (int)w, true); }
struct EpiMoe1 {
    static constexpr bool PERM = true, AFTER_DRAIN = false;
    unsigned char* act;
    __device__ __forceinline__ void operator()(const f32x4 (&acc)[2][2][4][2], const Unit& u, int wr, int wc, int fr, int fq) const {
        const int row0 = u.pm * 256 + wr * 64 + fr, f0 = u.pn * 128 + wc * 32 + 8 * fq; constexpr float sg = 1.0f / (FP8_SW * FP8_SH);
#pragma unroll
        for (int ai = 0; ai < 2; ++ai)
#pragma unroll
            for (int m = 0; m < 4; ++m) { const f32x4 g0 = acc[ai][0][m][0] * sg, g1 = acc[ai][0][m][1] * sg, u0 = acc[ai][1][m][0] * (sg * FP8_SA), u1 = acc[ai][1][m][1] * (sg * FP8_SA);
                float r[8];
#pragma unroll
                for (int j = 0; j < 4; ++j) { r[j] = g0[j] * sigmoidf_(g0[j]) * u0[j]; r[4 + j] = g1[j] * sigmoidf_(g1[j]) * u1[j]; }
                v2u w; w.x = pk4_fp8(r[0], r[1], r[2], r[3]); w.y = pk4_fp8(r[4], r[5], r[6], r[7]);
                *(GAS v2u*)(act + (size_t)(row0 + ai * 128 + m * 16) * DF + f0) = w; }
    }
};
struct EpiBf16 {
    static constexpr bool PERM = true, AFTER_DRAIN = false;
    bf16* O; int ldc; float scale;
    __device__ __forceinline__ void operator()(const f32x4 (&acc)[2][2][4][2], const Unit& u, int wr, int wc, int fr, int fq) const {
        const int row0 = u.pm * 256 + wr * 64 + fr, col0 = u.pn * 256 + wc * 32 + 8 * fq;
#pragma unroll
        for (int ai = 0; ai < 2; ++ai)
#pragma unroll
            for (int m = 0; m < 4; ++m) { bf16* rowp = O + (size_t)(row0 + ai * 128 + m * 16) * ldc + col0;
#pragma unroll
                for (int bj = 0; bj < 2; ++bj) { const f32x4 v0 = acc[ai][bj][m][0] * scale, v1 = acc[ai][bj][m][1] * scale;
                    v4u w; w.x = pg8::cvt_pk_bf16(v0[0], v0[1]); w.y = pg8::cvt_pk_bf16(v0[2], v0[3]); w.z = pg8::cvt_pk_bf16(v1[0], v1[1]); w.w = pg8::cvt_pk_bf16(v1[2], v1[3]);
                    *(GAS v4u*)(rowp + bj * 128) = w; } }
    }
};

struct SchedProj {
    const char* A; const char* B; int G, c, layer;
    __device__ __forceinline__ bool next(int i, Unit& u) const {
        const int L = i * G + c; int rt, ct;
        if (layer == 0) { if (L >= 1440) return false; rt = (L / 160) * 8 + (L & 7); ct = (L % 160) >> 3; }
        else { if (L >= 1296) return false; if (L < 1280) { rt = (L / 160) * 8 + (L & 7); ct = (L % 160) >> 3; } else { const int j = L - 1280; rt = 64 + (j & 7); ct = 18 + (j >> 3); } }
        u.pm = rt; u.pn = ct; u.aux = 0; u.a = A + (size_t)rt * 256 * DM * 2; u.b = B + (size_t)ct * 256 * DM * 2; return true; }
};
struct SchedF {
    const char* A; const char* B; int G, c;
    __device__ __forceinline__ bool next(int i, Unit& u) const {
        const int j = c - (G - 64); if (i != 0 || j < 0) return false;
        const int g = j >> 1, rt = j & 1; u.pm = rt; u.pn = 0; u.aux = g; u.a = A + (size_t)(g * NINST + rt * 256) * KS2 * 2; u.b = B + (size_t)g * 256 * 1024 * 2; return true; }
};
struct SchedS2 {
    const char* A; const char* B; int G, c, layer;
    __device__ __forceinline__ bool next(int i, Unit& u) const {
        const int L = i * G + c; int g, rt, ct;
        if (layer == 0) { if (L >= 256) return false; g = L >> 3; rt = (L >> 2) & 1; ct = L & 3; } else { if (L >= 128) return false; g = L >> 2; rt = 0; ct = L & 3; }
        u.pm = rt; u.pn = ct; u.aux = g; u.a = A + (size_t)(g * NINST + rt * 256) * KS2 * 2; u.b = B + (size_t)(g * 1024 + ct * 256) * KS2 * 2; return true; }
};
struct SchedGlu {
    const char* A; const char* B; int G, c, nrt;
    __device__ __forceinline__ bool next(int i, Unit& u) const {
        const int L = i * G + c; if (L >= nrt * 2) return false;
        u.pm = L >> 1; u.pn = L & 1; u.aux = 0; u.a = A + (size_t)u.pm * 256 * DSSM * 2; u.b = B + (size_t)u.pn * 256 * DSSM * 2; return true; }
};
struct SchedOut {
    const char* A; const char* B; int G, c, nrt;
    __device__ __forceinline__ bool next(int i, Unit& u) const {
        const int L = i * G + c; if (L >= nrt * 8) return false;
        u.pm = (L >> 6) * 8 + (L & 7); u.pn = (L & 63) >> 3; u.aux = 0; u.a = A + (size_t)u.pm * 256 * DM * 2; u.b = B + (size_t)u.pn * 256 * DM * 2; return true; }
};
struct SchedMoe {
    const char* A; const char* B; int G, c, nct, layer, gather;
    __device__ __forceinline__ bool next(int i, Unit& u) const {
        const int L = i * G + c, per = 8 * nct, nlat = NE * per; int e, rtile, ct;
        if (L < nlat) { e = L / per; const int w = L % per; ct = (w >> 5) * 4 + (w & 3); rtile = e * 8 + ((w & 31) >> 2); }
        else { const int j = L - nlat; if (layer != 0 || j >= NE * nct) return false; e = j / nct; ct = j % nct; rtile = NE * 8 + e; }
        u.pm = rtile; u.pn = ct; u.aux = e; u.a = gather ? A : A + (size_t)rtile * 256 * 2048; u.b = B + ((size_t)e * nct + ct) * 256 * 2048; return true; }
};

struct CvtItem { const float* src; unsigned char* dst; int N, ldwt, fp8; };
__device__ __forceinline__ void cvt_decode(Frame& F, long it, CvtItem& d) {
    constexpr long I_EXP = 32 * 64;
    constexpr long N_GATE = 2L * NE * I_EXP, N_WIN = 2L * 32 * 160, N_WOUT = 2L * I_EXP;
    long r = it;
    if (r < 2 * N_GATE) {
        const int kind = r >= N_GATE; if (kind) r -= N_GATE;
        const int le = (int)(r / I_EXP), q = (int)(r % I_EXP), kb = q >> 6, n0 = (q & 63) * 32;
        d.src = F.in[kind ? I_WU : I_WG] + (size_t)le * DM * DF + (size_t)(kb * 64) * DF + n0; d.N = DF; d.ldwt = DM; d.fp8 = 1;
        d.dst = WSP(unsigned char, WS_WGU) + ((size_t)le * 4096 + (n0 >> 7) * 256 + kind * 128 + (n0 & 127)) * DM + kb * 64; return; }
    r -= 2 * N_GATE;
    if (r < N_GATE) { const int le = (int)(r / I_EXP), q = (int)(r % I_EXP), kb = q >> 6, n0 = (q & 63) * 32;
        d.src = F.in[I_WD] + (size_t)le * DF * DM + (size_t)(kb * 64) * DM + n0; d.N = DM; d.ldwt = DF; d.fp8 = 1;
        d.dst = WSP(unsigned char, WS_WDN) + ((size_t)le * DM + n0) * DF + kb * 64; return; }
    r -= N_GATE; d.fp8 = 0;
    if (r < N_WIN) { const int l = (int)(r / (32 * 160)), q = (int)(r % (32 * 160)), kb = q / 160, n0 = (q % 160) * 32;
        d.src = F.in[I_WIN] + (size_t)l * DM * DINP + (size_t)(kb * 64) * DINP + n0; d.N = DINP; d.ldwt = DM * 2;
        d.dst = (unsigned char*)(WSP(bf16, WS_WIN) + ((size_t)l * DINP + n0) * DM + kb * 64); return; }
    r -= N_WIN;
    if (r < N_WOUT) { const int l = (int)(r / I_EXP), q = (int)(r % I_EXP), kb = q >> 6, n0 = (q & 63) * 32;
        d.src = F.in[I_WOUT] + (size_t)l * DM * DM + (size_t)(kb * 64) * DM + n0; d.N = DM; d.ldwt = DM * 2;
        d.dst = (unsigned char*)(WSP(bf16, WS_WOUT) + ((size_t)l * DM + n0) * DM + kb * 64); return; }
    r -= N_WOUT;
    { const int l = (int)(r / 128), q = (int)(r % 128), kb = q >> 4, n0 = (q & 15) * 32;
        d.src = F.in[I_WGLU] + (size_t)l * DSSM * DSSM + (size_t)(kb * 64) * DSSM + n0; d.N = DSSM; d.ldwt = DSSM * 2;
        d.dst = (unsigned char*)(WSP(bf16, WS_WGLU) + ((size_t)l * DSSM + n0) * DSSM + kb * 64); }
}
__device__ __forceinline__ void cvt_load(const CvtItem& d, int lane, float (&t)[32]) {
    const float* src = d.src + (size_t)(lane >> 5) * d.N + (lane & 31);
#pragma unroll
    for (int i = 0; i < 32; ++i) t[i] = *(const GAS float*)(src + (size_t)(2 * i) * d.N);
}
template <bool FP8>
__device__ __forceinline__ void cvt_store(const CvtItem& d, LAS float* scr, int lane, const float (&t)[32]) {
    constexpr float sc = FP8 ? FP8_SW : 1.0f;
#pragma unroll
    for (int i = 0; i < 32; ++i) scr[(2 * i + (lane >> 5)) * 33 + (lane & 31)] = t[i] * sc;
    LDS_WAIT(); asm volatile("" ::: "memory");
    const int c = lane & 7;
#pragma unroll
    for (int j = 0; j < 4; ++j) { const int n = (lane >> 3) + 8 * j; const LAS float* s = scr + (8 * c) * 33 + n;
        const float v0 = s[0 * 33], v1 = s[1 * 33], v2 = s[2 * 33], v3 = s[3 * 33], v4 = s[4 * 33], v5 = s[5 * 33], v6 = s[6 * 33], v7 = s[7 * 33];
        if constexpr (FP8) { v2u o; o.x = pk4_fp8(v0, v1, v2, v3); o.y = pk4_fp8(v4, v5, v6, v7); *(GAS v2u*)(d.dst + (size_t)n * d.ldwt + 8 * c) = o; }
        else { v4u o; o.x = pk2(v0, v1); o.y = pk2(v2, v3); o.z = pk2(v4, v5); o.w = pk2(v6, v7); *(GAS v4u*)(d.dst + (size_t)n * d.ldwt + 16 * c) = o; } }
    LDS_WAIT(); asm volatile("" ::: "memory");
}
constexpr long CVT_NFP8 = 3L * (2L * NE * 2048), CVT_NITEMS = CVT_NFP8 + 2L * 32 * 160 + 2L * 2048 + 2L * 128;
constexpr unsigned CVT_CHUNK = 8;
struct CvtQ { unsigned next, left; };
__device__ __forceinline__ long cvt_pull(Frame& F, CvtQ& q, unsigned* ctr, long lo, long hi) {
    if (q.left == 0u) { unsigned b = 0u; if (F.lane == 0) b = __hip_atomic_fetch_add(ctr, CVT_CHUNK, __ATOMIC_RELAXED, __HIP_MEMORY_SCOPE_AGENT);
        q.next = (unsigned)__builtin_amdgcn_readfirstlane((int)b); q.left = CVT_CHUNK; }
    const long it = lo + (long)q.next; ++q.next; --q.left; return it < hi ? it : -1;
}
template <bool FP8>
__device__ __forceinline__ void cvt_run(Frame& F, LAS float* scr) {
    unsigned* ctr = (unsigned*)(F.ws + WS_CTL) + (FP8 ? 64 : 128); const long lo = FP8 ? 0 : CVT_NFP8, hi = FP8 ? CVT_NFP8 : CVT_NITEMS;
    CvtItem A, B; float ta[32], tb[32]; CvtQ q{0u, 0u};
    long ia = cvt_pull(F, q, ctr, lo, hi);
    if (ia < 0) return;
    cvt_decode(F, ia, A); cvt_load(A, F.lane, ta);
    for (;;) {
        long ib = cvt_pull(F, q, ctr, lo, hi); const bool vb = ib >= 0; ib = vb ? ib : ia;
        cvt_decode(F, ib, B); cvt_load(B, F.lane, tb);
        cvt_store<FP8>(A, scr, F.lane, ta);
        if (!vb) break;
        ia = cvt_pull(F, q, ctr, lo, hi); const bool va = ia >= 0; ia = va ? ia : ib;
        cvt_decode(F, ia, A); cvt_load(A, F.lane, ta);
        cvt_store<FP8>(B, scr, F.lane, tb);
        if (!va) break;
    }
}
__device__ __forceinline__ void p0_convert_weights(Frame& F) {
    LAS float* scr = (LAS float*)(F.lds + F.wave * 16384);
    cvt_run<true>(F, scr);
    cvt_run<false>(F, scr);
    __syncthreads();
}
__device__ __forceinline__ void p0_mod_task(Frame& F, int task) {
    const int l = task / 96, n0 = (task % 96) * 128;
    LAS float* sc = (LAS float*)F.lds;
    LAS float* red = (LAS float*)(F.lds + 9 * 2048 * 4);
    for (int i = F.tid; i < 9 * DM; i += 512) { const int r = i >> 11, k = i & 2047; const float v = r < 8 ? F.in[I_C][r * DM + k] : F.in[I_CCTX][k]; sc[i] = v * sigmoidf_(v); }
    __syncthreads();
    const float* W = F.in[I_ADAW] + (size_t)l * DM * 6 * DM + n0 + 2 * F.lane;
    float acc[9][2];
#pragma unroll
    for (int r = 0; r < 9; ++r) { acc[r][0] = 0.f; acc[r][1] = 0.f; }
    const int kbase = F.wave * 256;
#pragma unroll 8
    for (int kk = 0; kk < 256; ++kk) { const int k = kbase + kk; const f32x2 w = *(const GAS f32x2*)(W + (size_t)k * (6 * DM));
#pragma unroll
        for (int r = 0; r < 9; ++r) { const float s = sc[r * DM + k]; acc[r][0] += s * w.x; acc[r][1] += s * w.y; } }
#pragma unroll
    for (int r = 0; r < 9; ++r) { red[(F.wave * 9 + r) * 128 + 2 * F.lane] = acc[r][0]; red[(F.wave * 9 + r) * 128 + 2 * F.lane + 1] = acc[r][1]; }
    __syncthreads();
    float* mod = WSP(float, WS_MOD) + (size_t)l * 9 * 6 * DM;
    for (int i = F.tid; i < 9 * 128; i += 512) { const int r = i >> 7, n = i & 127; float s = F.in[I_ADAB][(size_t)l * 6 * DM + n0 + n];
#pragma unroll
        for (int w = 0; w < 8; ++w) s += red[(w * 9 + r) * 128 + n];
        mod[(size_t)r * 6 * DM + n0 + n] = s; }
    __syncthreads();
}
__device__ __forceinline__ void p0_s5_task(Frame& F, int task) {
    const int l = task >> 5, g = task & 31;
    LAS f32x2* PW = (LAS f32x2*)F.lds;
    LAS f32x2* BB = (LAS f32x2*)(F.lds + 33280);
    LAS f32x2* CC = (LAS f32x2*)(F.lds + 41472);
    LAS float* KD = (LAS float*)(F.lds + 49664);
    LAS bf16* KT = (LAS bf16*)(F.lds + 50688);
    bf16* WF = WSP(bf16, WS_WF) + (size_t)(l * NG + g) * 256 * 1024;
    bf16* W2 = WSP(bf16, WS_W2) + (size_t)(l * NG + g) * 1024 * KS2;
    for (int d = 0; d < 2; ++d) {
        const int ldg = (l * 2 + d) * NG + g;
        if (F.tid < 64) { const int p = F.tid;
            const double lr = (double)F.in[I_LRE][ldg * SP + p], li = (double)F.in[I_LIM][ldg * SP + p], dt = exp((double)F.in[I_LDT][ldg]);
            const double mag = exp(lr * dt), ar = mag * cos(li * dt), ai = mag * sin(li * dt), den = lr * lr + li * li, nr = ar - 1.0;
            const double kr = (nr * lr + ai * li) / den, ki = (ai * lr - nr * li) / den;
            double pr = 1.0, pi = 0.0;
            for (int e = 0; e <= 64; ++e) { PW[e * 64 + p] = (f32x2){(float)pr, (float)pi}; const double t = pr * ar - pi * ai; pi = pr * ai + pi * ar; pr = t; }
            if (true) { const f32x2 lt = PW[64 * 64 + p]; WSP(f32x2, WS_LT)[((l * NG + g) * 2 + d) * 64 + p] = lt; }
            for (int i = 0; i < SG; ++i) { const double br = (double)F.in[I_BRE][((size_t)ldg * SP + p) * SG + i], bi = (double)F.in[I_BIM][((size_t)ldg * SP + p) * SG + i];
                BB[p * 16 + i] = (f32x2){(float)(kr * br - ki * bi), (float)(kr * bi + ki * br)}; } }
        for (int i = F.tid; i < 1024; i += 512) CC[i] = (f32x2){F.in[I_CRE][(size_t)ldg * 1024 + i], F.in[I_CIM][(size_t)ldg * 1024 + i]};
        __syncthreads();
        { const int ph = F.tid & 1, q = F.tid >> 1, o = q >> 4, i = q & 15;
            float cbr[32], cbi[32];
#pragma unroll
            for (int p = 0; p < 32; ++p) { const f32x2 c = CC[o * 64 + ph * 32 + p], b = BB[(ph * 32 + p) * 16 + i]; cbr[p] = c.x * b.x - c.y * b.y; cbi[p] = c.x * b.y + c.y * b.x; }
#pragma unroll 1
            for (int j = 0; j < 64; ++j) { float s = 0.f;
#pragma unroll
                for (int p = 0; p < 32; p += 2) { const f32x4 P = *(const LAS f32x4*)(PW + j * 64 + ph * 32 + p); s += (cbr[p] * P[0] - cbi[p] * P[1]) + (cbr[p + 1] * P[2] - cbi[p + 1] * P[3]); }
                s += __shfl_xor(s, 1);
                if (ph == 0) { if (j == 0) { if (d == 0) KD[q] = s; else { s += KD[q]; KT[q] = (bf16)f2bf(s); } }
                               else KT[(d * 64 + j) * 256 + q] = (bf16)f2bf(s); } } }
        for (int it = F.tid; it < 128 * 128; it += 512) { const int n = it >> 7, k8 = it & 127, ri = n >> 6, p = n & 63, s = k8 >> 1, i0 = (k8 & 1) * 8, e = d == 0 ? 63 - s : s;
            const f32x2 P = PW[e * 64 + p]; float v[8];
#pragma unroll
            for (int j = 0; j < 8; ++j) { const f32x2 b = BB[p * 16 + i0 + j]; v[j] = ri == 0 ? (P.x * b.x - P.y * b.y) : (P.x * b.y + P.y * b.x); }
            v4u o; o.x = pk2(v[0], v[1]); o.y = pk2(v[2], v[3]); o.z = pk2(v[4], v[5]); o.w = pk2(v[6], v[7]);
            *(GAS v4u*)(WF + (size_t)(d * 128 + n) * 1024 + k8 * 8) = o; }
        for (int it = F.tid; it < 1024 * 16; it += 512) { const int n = it >> 4, c8 = it & 15, ri = c8 >> 3, p0 = (c8 & 7) * 8, t = n >> 4, o = n & 15, e = d == 0 ? t + 1 : 64 - t; float v[8];
#pragma unroll
            for (int j = 0; j < 8; ++j) { const f32x2 c = CC[o * 64 + p0 + j], P = PW[e * 64 + p0 + j]; v[j] = ri == 0 ? (c.x * P.x - c.y * P.y) : -(c.x * P.y + c.y * P.x); }
            v4u ov; ov.x = pk2(v[0], v[1]); ov.y = pk2(v[2], v[3]); ov.z = pk2(v[4], v[5]); ov.w = pk2(v[6], v[7]);
            *(GAS v4u*)(W2 + (size_t)n * KS2 + 1024 + d * 128 + c8 * 8) = ov; }
        __syncthreads();
    }
    for (int it = F.tid; it < 1024 * 128; it += 512) { const int n = it >> 7, k8 = it & 127, t = n >> 4, o = n & 15, s = k8 >> 1, i0 = (k8 & 1) * 8;
        const int dsel = s <= t ? 0 : 1, j = s <= t ? t - s : s - t;
        const v4u kv = *(const LAS v4u*)(KT + (dsel * 64 + j) * 256 + o * 16 + i0);
        *(GAS v4u*)(W2 + (size_t)n * KS2 + k8 * 8) = kv; }
    __syncthreads();
}
__device__ __forceinline__ void p0_router_t(Frame& F) {
    for (int i = (F.vcu * 512 + F.tid); i < 2 * 16 * DM; i += F.G * 512) { const int l = i >> 15, e = (i >> 11) & 15, k = i & 2047; WSP(float, WS_RWT)[i] = F.in[I_RW][((size_t)l * DM + k) * NE + e]; }
}

__device__ __forceinline__ int mbcnt64(unsigned long long m) { return (int)__builtin_amdgcn_mbcnt_hi((unsigned)(m >> 32), __builtin_amdgcn_mbcnt_lo((unsigned)m, 0u)); }
__device__ __forceinline__ void combine_row(Frame& F, int r, const float* g2, f32x4 (&x)[8]) {
    const int* sel = WSP(int, WS_SEL) + (size_t)r * NE; const float* vals = WSP(float, WS_VALS); const bf16* Y = WSP(bf16, WS_R1);
    const int mysel = F.lane < NE ? *(const GAS int*)(sel + F.lane) : -1;
    unsigned long long m = __ballot(mysel >= 0);
    f32x4 macc[8];
#pragma unroll
    for (int j = 0; j < 8; ++j) macc[j] = (f32x4){0.f, 0.f, 0.f, 0.f};
    while (m) { const int e = __builtin_ctzll(m); m &= m - 1;
        const int y = __builtin_amdgcn_readlane(mysel, e); const float val = *(const GAS float*)(vals + y); const bf16* yr = Y + (size_t)y * DM + 4 * F.lane;
#pragma unroll
        for (int j = 0; j < 8; ++j) { const v2u w = *(const GAS v2u*)(yr + j * 256); macc[j] += val * (f32x4){bflo(w.x), bfhi(w.x), bflo(w.y), bfhi(w.y)}; } }
#pragma unroll
    for (int j = 0; j < 8; ++j) x[j] += *(const GAS f32x4*)(g2 + j * 256 + 4 * F.lane) * macc[j];
}
__device__ __forceinline__ f32x4 ld_bf4(const bf16* p) { const v2u w = *(const GAS v2u*)p; return (f32x4){bflo(w.x), bfhi(w.x), bflo(w.y), bfhi(w.y)}; }
__device__ __forceinline__ float row_rs(const f32x4 (&x)[8]) {
    float s = 0.f;
#pragma unroll
    for (int j = 0; j < 8; ++j) s += (x[j][0] * x[j][0] + x[j][1] * x[j][1]) + (x[j][2] * x[j][2] + x[j][3] * x[j][3]);
    return 1.0f / sqrtf(wave_sum(s) * (1.0f / DM) + EPS);
}
__device__ __forceinline__ void phase_norm1(Frame& F, int l) {
    const float* modl = WSP(float, WS_MOD) + (size_t)l * 9 * 6 * DM; const float* gn = F.in[I_N1G] + (size_t)l * DM;
    for (int r = F.vcu * NWAVES + F.wave; r < MT; r += F.G * NWAVES) {
        const int rb = r < ML ? (r >> 11) : 8;
        f32x4 x[8];
        if (l == 0) { const float* xr = r < ML ? F.in[I_X] + (size_t)r * DM : F.in[I_CTX] + (size_t)(r - ML) * DM;
#pragma unroll
            for (int j = 0; j < 8; ++j) x[j] = *(const GAS f32x4*)(xr + j * 256 + 4 * F.lane); }
        else { const bf16* xr = WSP(bf16, WS_XM) + (size_t)r * DM;
#pragma unroll
            for (int j = 0; j < 8; ++j) x[j] = ld_bf4(xr + j * 256 + 4 * F.lane); }
        if (l == 1) { combine_row(F, r, WSP(float, WS_MOD) + (size_t)(rb * 6 + 5) * DM, x);
            bf16* xo = WSP(bf16, WS_XL) + (size_t)r * DM;
#pragma unroll
            for (int j = 0; j < 8; ++j) { v2u w; w.x = pk2(x[j][0], x[j][1]); w.y = pk2(x[j][2], x[j][3]); *(GAS v2u*)(xo + j * 256 + 4 * F.lane) = w; } }
        const float rs = row_rs(x); const float* sh = modl + (size_t)(rb * 6 + 0) * DM; const float* sc = modl + (size_t)(rb * 6 + 1) * DM;
        bf16* ho = WSP(bf16, WS_H) + (size_t)r * DM;
#pragma unroll
        for (int j = 0; j < 8; ++j) { const int c = j * 256 + 4 * F.lane; const f32x4 g = *(const GAS f32x4*)(gn + c), s1 = *(const GAS f32x4*)(sc + c), s0 = *(const GAS f32x4*)(sh + c);
            const f32x4 h = x[j] * rs * g * (1.0f + s1) + s0; v2u w; w.x = pk2(h[0], h[1]); w.y = pk2(h[2], h[3]); *(GAS v2u*)(ho + c) = w; }
    }
}
__device__ __forceinline__ void phase_final(Frame& F) {
    const float* gn = F.in[I_FNG];
    for (int r = F.vcu * NWAVES + F.wave; r < ML; r += F.G * NWAVES) {
        const int rb = r >> 11; const bf16* xr = WSP(bf16, WS_XM) + (size_t)r * DM;
        f32x4 x[8];
#pragma unroll
        for (int j = 0; j < 8; ++j) x[j] = ld_bf4(xr + j * 256 + 4 * F.lane);
        combine_row(F, r, WSP(float, WS_MOD) + (size_t)((9 + rb) * 6 + 5) * DM, x);
        const float rs = row_rs(x); float* o = F.out + (size_t)r * DM;
#pragma unroll
        for (int j = 0; j < 8; ++j) { const int c = j * 256 + 4 * F.lane; *(GAS f32x4*)(o + c) = x[j] * rs * *(const GAS f32x4*)(gn + c); }
    }
}
__device__ __forceinline__ void phase_norm2(Frame& F, int l) {
    LAS float* rwt = (LAS float*)F.lds;
    { const float* src = WSP(float, WS_RWT) + (size_t)l * NE * DM;
        for (int i = F.tid; i < NE * DM / 4; i += 512) *(LAS f32x4*)(rwt + 4 * i) = *(const GAS f32x4*)(src + 4 * i); }
    __syncthreads();
    const float* modl = WSP(float, WS_MOD) + (size_t)l * 9 * 6 * DM; const float* gn = F.in[I_N2G] + (size_t)l * DM;
    const int nrows = l == 0 ? MT : ML;
    for (int r = F.vcu * NWAVES + F.wave; r < nrows; r += F.G * NWAVES) {
        const int rb = r < ML ? (r >> 11) : 8; const bf16* xr = WSP(bf16, WS_XM) + (size_t)r * DM;
        f32x4 x[8];
#pragma unroll
        for (int j = 0; j < 8; ++j) x[j] = ld_bf4(xr + j * 256 + 4 * F.lane);
        const float rs = row_rs(x); const float* sh = modl + (size_t)(rb * 6 + 3) * DM; const float* sc = modl + (size_t)(rb * 6 + 4) * DM;
        unsigned char* ho = WSP(unsigned char, WS_H) + (size_t)r * DM;
#pragma unroll
        for (int j = 0; j < 8; ++j) { const int c = j * 256 + 4 * F.lane; const f32x4 g = *(const GAS f32x4*)(gn + c), s1 = *(const GAS f32x4*)(sc + c), s0 = *(const GAS f32x4*)(sh + c);
            x[j] = x[j] * rs * g * (1.0f + s1) + s0; *(GAS unsigned*)(ho + c) = pk4_fp8(x[j][0] * FP8_SH, x[j][1] * FP8_SH, x[j][2] * FP8_SH, x[j][3] * FP8_SH); }
        float p[NE];
#pragma unroll
        for (int eg = 0; eg < NE; eg += 2) { float s0 = 0.f, s1 = 0.f;
#pragma unroll
            for (int j = 0; j < 8; ++j) { const f32x4 w0 = *(const LAS f32x4*)(rwt + eg * DM + j * 256 + 4 * F.lane), w1 = *(const LAS f32x4*)(rwt + (eg + 1) * DM + j * 256 + 4 * F.lane);
                s0 += (x[j][0] * w0[0] + x[j][1] * w0[1]) + (x[j][2] * w0[2] + x[j][3] * w0[3]); s1 += (x[j][0] * w1[0] + x[j][1] * w1[1]) + (x[j][2] * w1[2] + x[j][3] * w1[3]); }
            p[eg] = s0; p[eg + 1] = s1; __builtin_amdgcn_sched_barrier(0); }
        const bool b5 = (F.lane & 32) != 0, b4 = (F.lane & 16) != 0, b3 = (F.lane & 8) != 0, b2 = (F.lane & 4) != 0;
        float q8[8], q4[4], q2[2];
#pragma unroll
        for (int i = 0; i < 8; ++i) { const float keep = b5 ? p[i + 8] : p[i], give = b5 ? p[i] : p[i + 8]; q8[i] = keep + __shfl_xor(give, 32); }
#pragma unroll
        for (int i = 0; i < 4; ++i) { const float keep = b4 ? q8[i + 4] : q8[i], give = b4 ? q8[i] : q8[i + 4]; q4[i] = keep + __shfl_xor(give, 16); }
#pragma unroll
        for (int i = 0; i < 2; ++i) { const float keep = b3 ? q4[i + 2] : q4[i], give = b3 ? q4[i] : q4[i + 2]; q2[i] = keep + __shfl_xor(give, 8); }
        float lg; { const float keep = b2 ? q2[1] : q2[0], give = b2 ? q2[0] : q2[1]; lg = keep + __shfl_xor(give, 4); }
        lg += __shfl_xor(lg, 2); lg += __shfl_xor(lg, 1);
        float mx = lg;
        mx = fmaxf(mx, __shfl_xor(mx, 4)); mx = fmaxf(mx, __shfl_xor(mx, 8)); mx = fmaxf(mx, __shfl_xor(mx, 16)); mx = fmaxf(mx, __shfl_xor(mx, 32));
        const float ex = __expf(lg - mx); float den = ex;
        den += __shfl_xor(den, 4); den += __shfl_xor(den, 8); den += __shfl_xor(den, 16); den += __shfl_xor(den, 32);
        const float mine = ex / den; const int ex_id = (F.lane >> 2) & 15;
        if ((F.lane & 3) == 0) { if (r < ML) WSP(float, WS_AFF)[((size_t)(rb * NE + ex_id) << 11) + (r & 2047)] = mine;
                                 else { const int q = r - ML; WSP(float, WS_AFFC)[((size_t)((q >> 8) * NE + ex_id) << 8) + (q & 255)] = mine; } }
    }
    __syncthreads();
}
__device__ __forceinline__ void unpack8(const v4u w, f32x4& lo, f32x4& hi) { lo = (f32x4){bflo(w.x), bfhi(w.x), bflo(w.y), bfhi(w.y)}; hi = (f32x4){bflo(w.z), bfhi(w.z), bflo(w.w), bfhi(w.w)}; }
__device__ __forceinline__ void phase_conv(Frame& F, int l, int nblk) {
    const bf16* P = WSP(bf16, WS_R1); bf16* cc = WSP(bf16, WS_R2);
    const float* cw = F.in[I_CONVW] + (size_t)l * 3 * DCONV; const float* gn = F.in[I_ONCG] + (size_t)l * DCONV;
    f32x4 w[3][3][2], g[3][2];
#pragma unroll
    for (int ch = 0; ch < 3; ++ch) { const int c0 = ch * 512 + 8 * F.lane;
#pragma unroll
        for (int t = 0; t < 3; ++t) { w[ch][t][0] = *(const GAS f32x4*)(cw + t * DCONV + c0); w[ch][t][1] = *(const GAS f32x4*)(cw + t * DCONV + c0 + 4); }
        g[ch][0] = *(const GAS f32x4*)(gn + c0); g[ch][1] = *(const GAS f32x4*)(gn + c0 + 4); }
    const int nrows = l == 0 ? MT : ML;
    for (int r = F.vcu * NWAVES + F.wave; r < nrows; r += nblk * NWAVES) {
        bool hp, hn; if (r < ML) { const int x = r & 63; hp = x > 0; hn = x < 63; } else { const int t = (r - ML) & 255; hp = t > 0; hn = t < 255; }
        const float mp = hp ? 1.f : 0.f, mn = hn ? 1.f : 0.f;
        const bf16* p0 = P + (size_t)r * (3 * DCONV); const bf16* pp = hp ? p0 - 3 * DCONV : p0; const bf16* pn = hn ? p0 + 3 * DCONV : p0;
        v4u raw[3][7];
#pragma unroll
        for (int ch = 0; ch < 3; ++ch) { const int c0 = ch * 512 + 8 * F.lane;
            raw[ch][0] = *(const GAS v4u*)(p0 + c0); raw[ch][1] = *(const GAS v4u*)(p0 + DCONV + c0); raw[ch][2] = *(const GAS v4u*)(p0 + 2 * DCONV + c0);
            raw[ch][3] = *(const GAS v4u*)(pp + DCONV + c0); raw[ch][4] = *(const GAS v4u*)(pp + 2 * DCONV + c0);
            raw[ch][5] = *(const GAS v4u*)(pn + DCONV + c0); raw[ch][6] = *(const GAS v4u*)(pn + 2 * DCONV + c0); }
#pragma unroll
        for (int ch = 0; ch < 3; ++ch) { const int c0 = ch * 512 + 8 * F.lane;
            f32x4 b0, b1, c0v, c1v, v0, v1, cp0, cp1, vp0, vp1, cn0, cn1, vn0, vn1;
            unpack8(raw[ch][0], b0, b1); unpack8(raw[ch][1], c0v, c1v); unpack8(raw[ch][2], v0, v1); unpack8(raw[ch][3], cp0, cp1); unpack8(raw[ch][4], vp0, vp1); unpack8(raw[ch][5], cn0, cn1); unpack8(raw[ch][6], vn0, vn1);
            const f32x4 y0 = b0 * (w[ch][0][0] * (mp * (cp0 * vp0)) + w[ch][1][0] * (c0v * v0) + w[ch][2][0] * (mn * (cn0 * vn0)));
            const f32x4 y1 = b1 * (w[ch][0][1] * (mp * (cp1 * vp1)) + w[ch][1][1] * (c1v * v1) + w[ch][2][1] * (mn * (cn1 * vn1)));
            float ss = (y0[0] * y0[0] + y0[1] * y0[1]) + (y0[2] * y0[2] + y0[3] * y0[3]) + (y1[0] * y1[0] + y1[1] * y1[1]) + (y1[2] * y1[2] + y1[3] * y1[3]);
            ss += __shfl_xor(ss, 1); ss += __shfl_xor(ss, 2); ss += __shfl_xor(ss, 4); ss += __shfl_xor(ss, 8);
            const float rs = 1.0f / sqrtf(ss * (1.0f / 128.0f) + EPS);
            const f32x4 o0 = y0 * rs * g[ch][0], o1 = y1 * rs * g[ch][1];
            v4u o; o.x = pk2(o0[0], o0[1]); o.y = pk2(o0[2], o0[3]); o.z = pk2(o1[0], o1[1]); o.w = pk2(o1[2], o1[3]);
            *(GAS v4u*)(cc + (size_t)r * DM + c0) = o; }
    }
}
__device__ __forceinline__ void phase_carry(Frame& F, int l) {
    const int gt = F.vcu * 512 + F.tid; if (gt >= NB * NG * 2 * SP) return;
    const int p = gt & 63, d = (gt >> 6) & 1, g = (gt >> 7) & 31, b = gt >> 12;
    const f32x2 lt = WSP(f32x2, WS_LT)[((l * NG + g) * 2 + d) * 64 + p];
    const float* Fb = WSP(float, WS_F); bf16* u2 = WSP(bf16, WS_U2);
    float hr = 0.f, hi = 0.f;
    for (int step = 0; step < 36; ++step) {
        int inst; if (step < 4) inst = 256 + b * 4 + (d == 0 ? step : 3 - step); else inst = b * 32 + (d == 0 ? step - 4 : 35 - step);
        const size_t row = (size_t)g * NINST + inst;
        u2[row * KS2 + 1024 + d * 128 + p] = (bf16)f2bf(hr); u2[row * KS2 + 1024 + d * 128 + 64 + p] = (bf16)f2bf(hi);
        const float fr = *(const GAS float*)(Fb + row * 256 + d * 128 + p), fi = *(const GAS float*)(Fb + row * 256 + d * 128 + 64 + p);
        const float nr = lt.x * hr - lt.y * hi + fr; hi = lt.x * hi + lt.y * hr + fi; hr = nr; }
}
template <int NJ>
__device__ __forceinline__ void topk_wave(Frame& F, const float* aff, int k, int srcrow0, int yrow0, int e, LAS unsigned* av) {
#pragma unroll 1
    for (int j = 0; j < NJ; ++j) av[j * 64 + F.lane] = __builtin_bit_cast(unsigned, *(const GAS float*)(aff + j * 64 + F.lane));
    LDS_WAIT();
    unsigned T = 0u;
#pragma unroll 1
    for (int bit = 30; bit >= 0; --bit) { const unsigned cand = T | (1u << bit); int cnt = 0;
#pragma unroll 4
        for (int j = 0; j < NJ; ++j) cnt += __popcll(__ballot(av[j * 64 + F.lane] >= cand));
        if (cnt >= k) T = cand; }
    int ngt = 0, neq = 0;
#pragma unroll 2
    for (int j = 0; j < NJ; ++j) { const unsigned a = av[j * 64 + F.lane]; ngt += (a > T) ? 1 : 0; neq += (a == T) ? 1 : 0; }
    const int packed = (ngt << 16) | neq; int incl = packed;
#pragma unroll
    for (int o = 1; o < 64; o <<= 1) { const int t = __shfl_up(incl, o); incl += (F.lane >= o) ? t : 0; }
    const int excl = incl - packed, pgt = excl >> 16, peq = excl & 0xffff;
    const int need = k - (__builtin_amdgcn_readlane(incl, 63) >> 16);
    int slot = pgt + (peq < need ? peq : need), eqr = peq;
    int* IDX = WSP(int, WS_IDX); float* VALS = WSP(float, WS_VALS); int* SEL = WSP(int, WS_SEL);
#pragma unroll 1
    for (int j = 0; j < NJ; ++j) { const unsigned a = av[j * 64 + F.lane]; const bool gt = a > T, eq = a == T; const bool sl = gt || (eq && eqr < need); eqr += eq ? 1 : 0;
        const int src = srcrow0 + j * 64 + F.lane;
        if (sl) { IDX[yrow0 + slot] = src; VALS[yrow0 + slot] = __builtin_bit_cast(float, a); }
        SEL[(size_t)src * NE + e] = sl ? yrow0 + slot : -1;
        slot += sl ? 1 : 0; }
}
__device__ __forceinline__ void phase_topk(Frame& F, int l) {
    const int ntask = l == 0 ? 256 : 128;
    LAS unsigned* av = (LAS unsigned*)(F.lds + F.wave * 8192);
    for (int task = F.wave * F.G + F.vcu; task < ntask; task += F.G * NWAVES) {
        const bool isctx = task >= 128; const int q = task & 127, b = q >> 4, e = q & 15;
        const int yrow0 = isctx ? NE * NB * CAPL + e * (NB * CAPC) + b * CAPC : (e * NB + b) * CAPL;
        if (isctx) topk_wave<4>(F, WSP(float, WS_AFFC) + (size_t)(b * NE + e) * CTXL, CAPC, ML + b * CTXL, yrow0, e, av);
        else topk_wave<32>(F, WSP(float, WS_AFF) + (size_t)(b * NE + e) * SEQL, CAPL, b * SEQL, yrow0, e, av);
    }
}
template <class T> __device__ __forceinline__ T* opaque_ptr(T* p) { unsigned long long v = (unsigned long long)p; unsigned lo = (unsigned)v, hi = (unsigned)(v >> 32); asm volatile("" : "+v"(lo), "+v"(hi));
    lo = __builtin_amdgcn_readfirstlane(lo); hi = __builtin_amdgcn_readfirstlane(hi); return (T*)(((unsigned long long)hi << 32) | lo); }
__device__ __forceinline__ void launder(Frame& F) { F.ws = opaque_ptr(F.ws); F.out = opaque_ptr(F.out);
    int t = F.tid; asm volatile("" : "+v"(t)); F.tid = t; F.lane = t & 63; F.wave = __builtin_amdgcn_readfirstlane(t >> 6);
    int g = gridDim.x, bx = blockIdx.x; asm volatile("" : "+v"(g), "+v"(bx)); g = __builtin_amdgcn_readfirstlane(g); bx = __builtin_amdgcn_readfirstlane(bx);
    F.G = g; F.vcu = (g % 8 == 0) ? (bx % 8) * (g / 8) + bx / 8 : bx; }
__device__ __forceinline__ void grid_seam(Frame& F) {
    XcdBarrier b; b.bar = (unsigned*)(F.ws + WS_CTL) + CW_BAR; b.x = xb_xcc_id(); b.st = (volatile LAS unsigned*)(F.lds + MISC_OFF) + 8;
    xcd_barrier(b);
}
constexpr int NPHASE = 24;
struct Args { const float* in[27]; float* out; unsigned char* ws; };
#define IN(k) (LO <= (k) && (k) < HI)
#ifndef PROBE_SUB
#define PROBE_SUB 0
#endif
#ifndef PROBE_MASK
#define PROBE_MASK 0u
#endif
#define PHASE(k) if constexpr (IN(k)) for (int rep_ = 0; rep_ < (((PROBE_MASK >> (k)) & 1u) ? 2 : 1); ++rep_)
#define SEAM(k) do { if constexpr (IN(k) && IN((k) + 1)) grid_seam(F); } while (0)
template <int LO, int HI, int l>
__device__ __forceinline__ void layer_phases(Frame& F) {
    constexpr int pb = 1 + 11 * l;
    PHASE(pb + 0) { launder(F); phase_norm1(F, l); }
    SEAM(pb + 0);
    PHASE(pb + 1) {
        launder(F);
        SchedProj S{(const char*)WSP(bf16, WS_H), (const char*)(WSP(bf16, WS_WIN) + (size_t)l * DINP * DM), F.G, F.vcu, l};
        EpiProj E{WSP(bf16, WS_R1), WSP(bf16, WS_U2)};
        pg8::gemm_phase<EpiProj, SchedProj, true>(F.lds, F.tid, pg8::Dims{DM * 2, DM * 2, DM * 2, nullptr}, S, E);
    }
    SEAM(pb + 1);
    PHASE(pb + 2) {
        launder(F);
        if (F.vcu < F.G - 64) phase_conv(F, l, F.G - 64);
        else { SchedF S{(const char*)WSP(bf16, WS_U2), (const char*)(WSP(bf16, WS_WF) + (size_t)l * NG * 256 * 1024), F.G, F.vcu};
            EpiF32 E{WSP(float, WS_F), 256, (size_t)NINST * 256};
            pg8::gemm_phase<EpiF32, SchedF, false>(F.lds, F.tid, pg8::Dims{KS2 * 2, 1024 * 2, 1024 * 2, nullptr}, S, E); }
    }
    SEAM(pb + 2);
    PHASE(pb + 3) { launder(F); phase_carry(F, l); }
    SEAM(pb + 3);
    PHASE(pb + 4) {
        launder(F);
        SchedS2 S{(const char*)WSP(bf16, WS_U2), (const char*)(WSP(bf16, WS_W2) + (size_t)l * NG * 1024 * KS2), F.G, F.vcu, l};
        EpiS2 E{WSP(bf16, WS_U2), F.in[I_SSMD] + (size_t)l * DSSM, WSP(bf16, WS_Z)};
        pg8::gemm_phase<EpiS2, SchedS2, true>(F.lds, F.tid, pg8::Dims{KS2 * 2, KS2 * 2, KS2 * 2, nullptr}, S, E);
    }
    SEAM(pb + 4);
    PHASE(pb + 5) {
        launder(F);
        SchedGlu S{(const char*)WSP(bf16, WS_Z), (const char*)(WSP(bf16, WS_WGLU) + (size_t)l * DSSM * DSSM), F.G, F.vcu, l == 0 ? 72 : 64};
        EpiGlu E{WSP(bf16, WS_Z), F.in[I_ONSG] + (size_t)l * DSSM, WSP(bf16, WS_R2)};
        if (F.G >= 144) pg8::gemm_phase<EpiGlu, SchedGlu, false>(F.lds, F.tid, pg8::Dims{DSSM * 2, DSSM * 2, DSSM * 2, nullptr}, S, E);
    }
    SEAM(pb + 5);
    PHASE(pb + 6) {
        launder(F);
        SchedOut S{(const char*)WSP(bf16, WS_R2), (const char*)(WSP(bf16, WS_WOUT) + (size_t)l * DM * DM), F.G, F.vcu, l == 0 ? 72 : 64};
        EpiOut<l == 1> E{l == 0 ? (const void*)F.in[I_X] : (const void*)WSP(bf16, WS_XL), l == 0 ? (const void*)F.in[I_CTX] : (const void*)(WSP(bf16, WS_XL) + (size_t)ML * DM), WSP(float, WS_MOD) + (size_t)l * 9 * 6 * DM, WSP(bf16, WS_XM)};
        pg8::gemm_phase<EpiOut<l == 1>, SchedOut, true>(F.lds, F.tid, pg8::Dims{DM * 2, DM * 2, DM * 2, nullptr}, S, E);
    }
    SEAM(pb + 6);
    PHASE(pb + 7) { launder(F); phase_norm2(F, l); }
    SEAM(pb + 7);
    PHASE(pb + 8) { launder(F); phase_topk(F, l); }
    SEAM(pb + 8);
    PHASE(pb + 9) {
        launder(F);
        SchedMoe S{(const char*)WSP(unsigned char, WS_H), (const char*)(WSP(unsigned char, WS_WGU) + (size_t)l * NE * 4096 * DM), F.G, F.vcu, 16, l, 1};
        EpiMoe1 E{WSP(unsigned char, WS_R2)};
        pg8::gemm_phase<EpiMoe1, SchedMoe, true, true, true>(F.lds, F.tid, pg8::Dims{DM, DM, DM, WSP(int, WS_IDX)}, S, E);
    }
    SEAM(pb + 9);
    PHASE(pb + 10) {
        launder(F);
        SchedMoe S{(const char*)WSP(unsigned char, WS_R2), (const char*)(WSP(unsigned char, WS_WDN) + (size_t)l * NE * DM * DF), F.G, F.vcu, 8, l, 0};
        EpiBf16 E{WSP(bf16, WS_R1), DM, 1.0f / (FP8_SW * FP8_SA)};
        pg8::gemm_phase<EpiBf16, SchedMoe, true, true>(F.lds, F.tid, pg8::Dims{DF, DF, DF, nullptr}, S, E);
    }
    SEAM(pb + 10);
}
template <int LO, int HI>
__global__ void __launch_bounds__(NWAVES * 64, 2) trunk_fwd(Args args) {
    extern __shared__ __attribute__((aligned(16))) unsigned char lds[];
    Frame F;
    F.lds = (LAS unsigned char*)lds;
    F.tid = threadIdx.x; F.lane = F.tid & 63; F.wave = __builtin_amdgcn_readfirstlane(F.tid >> 6);
    F.G = gridDim.x; { const int bx = blockIdx.x; F.vcu = (F.G % 8 == 0) ? (bx % 8) * (F.G / 8) + bx / 8 : bx; }
    F.ws = args.ws; F.out = args.out; F.in = args.in;
    for (int u = F.tid; u < (LDS_BYTES - LDSCTL_OFF) / 4; u += NWAVES * 64) ((LAS unsigned*)(F.lds + LDSCTL_OFF))[u] = 0u;
    __syncthreads();
    if constexpr (HI - LO > 1) (void)xcd_barrier_post((unsigned*)(F.ws + WS_CTL) + CW_BAR, (volatile LAS unsigned*)(F.lds + MISC_OFF) + 8);

    PHASE(0) {
        launder(F);
        for (int q_ = 0; q_ < ((PROBE_SUB & 1) ? 2 : 1); ++q_) if (F.vcu < 192) { for (int t = F.vcu; t < 192; t += 192) p0_mod_task(F, t); }
        for (int q_ = 0; q_ < ((PROBE_SUB & 2) ? 2 : 1); ++q_) if (F.vcu >= 192) { for (int t = F.vcu - 192; t < 64; t += F.G - 192) p0_s5_task(F, t); }
        p0_router_t(F);
        for (int q_ = 0; q_ < ((PROBE_SUB & 4) ? 2 : 1); ++q_) p0_convert_weights(F);
    }
    SEAM(0);
    layer_phases<LO, HI, 0>(F);
    layer_phases<LO, HI, 1>(F);
    PHASE(23) { launder(F); phase_final(F); }
}
#undef IN
#undef PHASE
#undef SEAM

template <int P> static void launch_phase(int grid, hipStream_t stream, const Args& a) {
    hipLaunchKernelGGL((trunk_fwd<P, P + 1>), dim3(grid), dim3(NWAVES * 64), LDS_BYTES, stream, a);
}
template <int P> static void set_attr_phase() { (void)hipFuncSetAttribute((const void*)trunk_fwd<P, P + 1>, hipFuncAttributeMaxDynamicSharedMemorySize, LDS_BYTES); }
template <int... Ps> static void launch_all(std::integer_sequence<int, Ps...>, int grid, hipStream_t stream, const Args& a) { (launch_phase<Ps>(grid, stream, a), ...); }
template <int... Ps> static void set_attr_all(std::integer_sequence<int, Ps...>) { (set_attr_phase<Ps>(), ...); }
extern "C" void kernel_launch(void* const* d_in, const int* in_sizes, int n_in, void* d_out, int out_size, void* d_ws, size_t ws_size, hipStream_t stream) {
    static int grid = 0;
    if (grid == 0) {
        if (n_in != 27 || out_size != ML * DM || ws_size < WS_END) { fprintf(stderr, "kernel_launch: expected 27 inputs, %d outputs, >= %zu workspace bytes; got %d, %d, %zu\n", ML * DM, (size_t)WS_END, n_in, out_size, ws_size); grid = -1; return; }
        int dev = 0, cus = 0, per_cu = 0;
        if (hipGetDevice(&dev) != hipSuccess || hipDeviceGetAttribute(&cus, hipDeviceAttributeMultiprocessorCount, dev) != hipSuccess) { grid = -1; return; }
#if MK_N_LAUNCHES == 1
        if (hipFuncSetAttribute((const void*)trunk_fwd<0, NPHASE>, hipFuncAttributeMaxDynamicSharedMemorySize, LDS_BYTES) != hipSuccess) { fprintf(stderr, "kernel_launch: hipFuncSetAttribute failed\n"); grid = -1; return; }
        if (hipOccupancyMaxActiveBlocksPerMultiprocessor(&per_cu, (const void*)trunk_fwd<0, NPHASE>, NWAVES * 64, LDS_BYTES) != hipSuccess || per_cu < 1) fprintf(stderr, "kernel_launch: occupancy query reports %d\n", per_cu);
#else
        set_attr_all(std::make_integer_sequence<int, NPHASE>{});
#endif
        (void)hipGetLastError();
        grid = cus;
        if (grid < 256 || grid % 8 != 0) { fprintf(stderr, "kernel_launch: unexpected CU count %d\n", cus); }
    }
    if (grid < 0) return;
    (void)hipMemsetAsync((char*)d_ws + WS_CTL, 0, CTL_ZERO_BYTES, stream);
    Args a{};
    for (int i = 0; i < 27; ++i) a.in[i] = (const float*)d_in[i];
    a.out = (float*)d_out; a.ws = (unsigned char*)d_ws;
#if MK_N_LAUNCHES == 1
    hipLaunchKernelGGL((trunk_fwd<0, NPHASE>), dim3(grid), dim3(NWAVES * 64), LDS_BYTES, stream, a);
#else
    launch_all(std::make_integer_sequence<int, NPHASE>{}, grid, stream, a);
#endif
    const hipError_t le = hipPeekAtLastError();
    if (le != hipSuccess) fprintf(stderr, "kernel_launch: launch failed: %s\n", hipGetErrorName(le));
}
```

```cpp
#include <hip/hip_runtime.h>
#include <cstdio>
#include <cstdint>
#include <utility>

#define GAS __attribute__((address_space(1)))
#define LAS __attribute__((address_space(3)))
typedef unsigned short bf16;
typedef unsigned v4u __attribute__((ext_vector_type(4)));
typedef unsigned v2u __attribute__((ext_vector_type(2)));
typedef float f32x4 __attribute__((ext_vector_type(4)));
typedef float f32x2 __attribute__((ext_vector_type(2)));
typedef short bf16x8 __attribute__((ext_vector_type(8)));
typedef GAS unsigned gu32;

#ifndef MK_N_LAUNCHES
#define MK_N_LAUNCHES 1
#endif

constexpr int NB = 8, SEQL = 2048, CTXL = 256, DM = 2048;
constexpr int ML = NB * SEQL, MC = NB * CTXL, MT = ML + MC;
constexpr int DCONV = 1536, DSSM = 512, DINP = 3 * DCONV + DSSM;
constexpr int NG = 32, SG = 16, SP = 64, TCH = 64;
constexpr int NE = 16, DF = 2048, CAPL = 256, CAPC = 32;
constexpr int NINST = 512, KS2 = 1280;
constexpr int YROWS = NE * NB * CAPL + NE * NB * CAPC;
constexpr float EPS = 1e-6f;

constexpr size_t MiB = 1u << 20;
constexpr size_t WS_CTL = 0, CTL_ZERO_BYTES = 1 * MiB;
constexpr size_t WS_MOD = 1 * MiB;
constexpr size_t WS_RWT = 2 * MiB;
constexpr size_t WS_LT = 2 * MiB + 512 * 1024;
constexpr size_t WS_AFF = 3 * MiB;
constexpr size_t WS_AFFC = 4 * MiB;
constexpr size_t WS_IDX = 5 * MiB;
constexpr size_t WS_VALS = 5 * MiB + 256 * 1024;
constexpr size_t WS_SEL = 6 * MiB;
constexpr size_t WS_WGLU = 8 * MiB;
constexpr size_t WS_WOUT = 9 * MiB;
constexpr size_t WS_WIN = 25 * MiB;
constexpr size_t WS_WF = 65 * MiB;
constexpr size_t WS_W2 = 97 * MiB;
constexpr size_t WS_WGU = 257 * MiB;
constexpr size_t WS_WDN = 769 * MiB;
constexpr size_t WS_XL = 1025 * MiB;
constexpr size_t WS_XM = 1169 * MiB;
constexpr size_t WS_H = 1313 * MiB;
constexpr size_t WS_F = 1385 * MiB;
constexpr size_t WS_R1 = 1401 * MiB;
constexpr size_t WS_R2 = 1563 * MiB;
constexpr size_t WS_U2 = WS_R2 + 72 * MiB;
constexpr size_t WS_Z = WS_R2 + 112 * MiB;
constexpr size_t WS_END = 1707 * MiB;
constexpr int CW_BAR = 4096;

constexpr int RING_BYTES = 131072;
constexpr int LDSCTL_OFF = RING_BYTES, MISC_OFF = LDSCTL_OFF + 320;
constexpr int LDS_BYTES = 147456;
constexpr int NWAVES = 8;

#define LDS_WAIT() asm volatile("s_waitcnt lgkmcnt(0)" ::: "memory")
#define VM_WAIT() asm volatile("s_waitcnt vmcnt(0)" ::: "memory")
__device__ __forceinline__ unsigned f2bf(float f) { unsigned u = __builtin_bit_cast(unsigned, f); return (u + 0x7fffu + ((u >> 16) & 1u)) >> 16; }
__device__ __forceinline__ unsigned pk2(float lo, float hi) { return f2bf(lo) | (f2bf(hi) << 16); }
__device__ __forceinline__ float bflo(unsigned w) { return __builtin_bit_cast(float, w << 16); }
__device__ __forceinline__ float bfhi(unsigned w) { return __builtin_bit_cast(float, w & 0xffff0000u); }
__device__ __forceinline__ float wave_sum(float v) {
#pragma unroll
    for (int o = 1; o < 64; o <<= 1) v += __shfl_xor(v, o);
    return v;
}
__device__ __forceinline__ float sigmoidf_(float x) { return 1.0f / (1.0f + __expf(-x)); }
__device__ __forceinline__ float gelu_tanh(float y) { const float a = 1.5957691216f * (y + 0.044715f * y * y * y); return y * sigmoidf_(a); }

#ifndef FP8_SCALE1
#define FP8_SCALE1 0x7f7f7f7f
#endif
namespace pg8 {
constexpr int BM = 256, BK = 64, HALF = 128, HTB = HALF * BK * 2, STAGE_BYTES = 8 * HTB;
__host__ __device__ __forceinline__ int lds_byte(int r, int c) { const int st = (r >> 4) * 2 + (c >> 5), rr = r & 15, cc = c & 31, ob = rr * 64 + cc * 2; return st * 1024 + (ob ^ (((ob >> 9) & 1) << 5)); }
__host__ __device__ __forceinline__ void stage_rc(int b, int& R, int& C) { const int st = b / 1024, sb = b % 1024, swz = sb ^ (((sb >> 9) & 1) << 5); R = (st >> 1) * 16 + swz / 64; C = (st & 1) * 32 + (swz % 64) / 2; }
__host__ __device__ __forceinline__ int perm32(int rho) { const int n = rho >> 4, i = rho & 15; return 8 * (i >> 2) + 4 * n + (i & 3); }
__device__ __forceinline__ unsigned cvt_pk_bf16(float lo, float hi) { unsigned r; asm volatile("v_cvt_pk_bf16_f32 %0, %1, %2" : "=v"(r) : "v"(lo), "v"(hi)); return r; }

struct Unit { const char* a; const char* b; int pm, pn, aux; };
struct Dims { int lda, ldb, K; const int* gidx; };
typedef int v4i_t __attribute__((ext_vector_type(4)));
typedef int v8i_t __attribute__((ext_vector_type(8)));
template <bool FP8> struct Frag { bf16x8 k[2]; };
template <> struct Frag<true> { v8i_t v; };

template <class Epi, class Sched, bool ALIGN_EPI, bool FP8 = false, bool GATHER = false>
__device__ __forceinline__ void gemm_phase(LAS unsigned char* lds, const int tid, const Dims g, const Sched& S, const Epi& E) {
    const int wid = __builtin_amdgcn_readfirstlane(tid >> 6), lane = tid & 63, wr = wid >> 2, wc = wid & 3, fr = lane & 15, fq = lane >> 4;
    const int nt = g.K / (BK * 2);
    unsigned voffA[2], voffB[2];
#pragma unroll
    for (int i = 0; i < 2; ++i) { int R, C; stage_rc(tid * 16 + i * 8192, R, C); const int Rb = Epi::PERM ? ((R & ~31) + perm32(R & 31)) : R;
        voffA[i] = (unsigned)(R * g.lda + C * 2); voffB[i] = (unsigned)(Rb * g.ldb + C * 2); }
    const size_t kstep = (size_t)(BK * 2);
    const size_t hstepA = (size_t)HALF * g.lda, hstepB = (size_t)HALF * g.ldb;
    const unsigned ldsw = (unsigned)wid * 1024u;
    const int aoff = lds_byte(wr * 64 + fr, fq * 8), boff = lds_byte(wc * 32 + fr, fq * 8);
#define PG8_SA(b, h) (((b) * 2 + (h)) * HTB)
#define PG8_SB(b, h) ((4 + (b) * 2 + (h)) * HTB)
#define PG8_STAGE(bufoff, gbase, voff) do { _Pragma("unroll") for (int _i = 0; _i < 2; ++_i) \
        __builtin_amdgcn_global_load_lds((const unsigned*)((const char*)(gbase) + (voff)[_i]), (LAS unsigned*)(lds + (bufoff) + ldsw + _i * 8192), 16, 0, 0); } while (0)
#define PG8_STAGE_A(bufoff, gbase, h, isnext) do { if constexpr (GATHER) { if (isnext) PG8_STAGE(bufoff, gbase, gAn[h]); else PG8_STAGE(bufoff, gbase, gA[h]); } \
        else PG8_STAGE(bufoff, (gbase) + ((h) ? hstepA : (size_t)0), voffA); } while (0)
#define PG8_GIDX(dst, u) do { _Pragma("unroll") for (int h_ = 0; h_ < 2; ++h_) _Pragma("unroll") for (int i_ = 0; i_ < 2; ++i_) { int R_, C_; stage_rc(tid * 16 + i_ * 8192, R_, C_); \
        dst[h_][i_] = (unsigned)(*(const GAS int*)(g.gidx + (u).pm * 256 + h_ * 128 + R_)) * (unsigned)g.lda + (unsigned)(C_ * 2); } } while (0)
#define PG8_LD1(dst, p) do { if constexpr (FP8) { const v4i_t lo_ = *(const LAS v4i_t*)(p), hi_ = *(const LAS v4i_t*)((p) + 1024); dst.v = __builtin_shufflevector(lo_, hi_, 0, 1, 2, 3, 4, 5, 6, 7); } \
        else { dst.k[0] = *(const LAS bf16x8*)(p); dst.k[1] = *(const LAS bf16x8*)((p) + 1024); } } while (0)
#define PG8_LDA(dst, b, h) do { _Pragma("unroll") for (int m = 0; m < 4; ++m) PG8_LD1(dst[m], lds + PG8_SA(b, h) + aoff + m * 2048); } while (0)
#define PG8_LDB(dst, b, h) do { _Pragma("unroll") for (int n = 0; n < 2; ++n) PG8_LD1(dst[n], lds + PG8_SB(b, h) + boff + n * 2048); } while (0)
#define PG8_MMA(ai, bj, At, Bt) do { __builtin_amdgcn_s_setprio(1); _Pragma("unroll") for (int m = 0; m < 4; ++m) _Pragma("unroll") for (int n = 0; n < 2; ++n) { \
        if constexpr (FP8) asm volatile("v_mfma_f32_16x16x128_f8f6f4 %0, %1, %2, %0" : "+v"(acc[ai][bj][m][n]) : "v"(Bt[n].v), "v"(At[m].v)); \
        else { _Pragma("unroll") for (int k = 0; k < 2; ++k) acc[ai][bj][m][n] = __builtin_amdgcn_mfma_f32_16x16x32_bf16(Bt[n].k[k], At[m].k[k], acc[ai][bj][m][n], 0, 0, 0); } } __builtin_amdgcn_s_setprio(0); } while (0)
#define PG8_WAIT_V(n) asm volatile("s_waitcnt vmcnt(" #n ")" ::: "memory")
#define PG8_WAIT_L(n) asm volatile("s_waitcnt lgkmcnt(" #n ")" ::: "memory")
#define PG8_BAR __builtin_amdgcn_s_barrier()
#define PG8_SCHED __builtin_amdgcn_sched_barrier(0)
    Unit cur, nxt; int ui = 0;
    if (!S.next(0, cur)) return;
    f32x4 acc[2][2][4][2];
#pragma unroll
    for (int a = 0; a < 2; ++a)
#pragma unroll
        for (int b = 0; b < 2; ++b)
#pragma unroll
            for (int m = 0; m < 4; ++m)
#pragma unroll
                for (int n = 0; n < 2; ++n) acc[a][b][m][n] = (f32x4){0.f, 0.f, 0.f, 0.f};
    Frag<FP8> At[4], B0[2], B1[2];
    const char* cA = cur.a; const char* cB = cur.b;
    unsigned gA[2][2], gAn[2][2];
    if constexpr (GATHER) { PG8_GIDX(gA, cur); _Pragma("unroll") for (int h_ = 0; h_ < 2; ++h_) _Pragma("unroll") for (int i_ = 0; i_ < 2; ++i_) gAn[h_][i_] = gA[h_][i_]; }
    PG8_STAGE(PG8_SB(0, 0), cB, voffB); PG8_STAGE(PG8_SB(0, 1), cB + hstepB, voffB); PG8_STAGE_A(PG8_SA(0, 0), cA, 0, false); PG8_STAGE_A(PG8_SA(0, 1), cA, 1, false);
    if (wr == 1) PG8_BAR;
    PG8_WAIT_V(2); PG8_BAR;
    PG8_STAGE(PG8_SB(1, 0), cB + kstep, voffB); PG8_STAGE_A(PG8_SA(1, 0), cA + kstep, 0, false); PG8_STAGE(PG8_SB(1, 1), cB + hstepB + kstep, voffB);
    PG8_WAIT_V(6); PG8_BAR;
    for (;;) {
        const bool has_next = S.next(ui + 1, nxt);
        const char* nA = has_next ? nxt.a : cA; const char* nB = has_next ? nxt.b : cB;
        for (int t = 0; t < nt; t += 2) {
            const bool last = (t == nt - 2);
            const char* a1 = cA + (size_t)(t + 1) * kstep;
            if constexpr (GATHER) { if (t == nt - 4 && has_next) PG8_GIDX(gAn, nxt); }
            const char* a2 = last ? nA : cA + (size_t)(t + 2) * kstep; const char* b2 = last ? nB : cB + (size_t)(t + 2) * kstep;
            const char* a3 = a2 + kstep; const char* b3 = b2 + kstep;
            PG8_LDB(B0, 0, 0); PG8_LDB(B1, 0, 1); PG8_SCHED; PG8_LDA(At, 0, 0); PG8_STAGE_A(PG8_SA(1, 1), a1, 1, false);
            PG8_WAIT_V(8); PG8_WAIT_L(0); PG8_BAR; PG8_MMA(0, 0, At, B0); PG8_MMA(0, 1, At, B1); PG8_BAR; PG8_SCHED;
            PG8_LDA(At, 0, 1); PG8_STAGE(PG8_SB(0, 0), b2, voffB); PG8_STAGE(PG8_SB(0, 1), b2 + hstepB, voffB); PG8_STAGE_A(PG8_SA(0, 0), a2, 0, last);
            PG8_WAIT_V(8); PG8_WAIT_L(0); PG8_BAR; PG8_MMA(1, 0, At, B0); PG8_MMA(1, 1, At, B1); PG8_BAR; PG8_SCHED;
            PG8_LDB(B0, 1, 0); PG8_LDB(B1, 1, 1); PG8_SCHED; PG8_LDA(At, 1, 0); PG8_STAGE_A(PG8_SA(0, 1), a2, 1, last);
            PG8_WAIT_V(8); PG8_WAIT_L(0); PG8_BAR; PG8_MMA(0, 0, At, B0); PG8_MMA(0, 1, At, B1); PG8_BAR; PG8_SCHED;
            PG8_LDA(At, 1, 1); PG8_STAGE(PG8_SB(1, 0), b3, voffB); PG8_STAGE(PG8_SB(1, 1), b3 + hstepB, voffB); PG8_STAGE_A(PG8_SA(1, 0), a3, 0, last);
            PG8_WAIT_V(8); PG8_WAIT_L(0); PG8_BAR; PG8_MMA(1, 0, At, B0); PG8_MMA(1, 1, At, B1); PG8_BAR; PG8_SCHED;
        }
        if constexpr (FP8) asm volatile("s_nop 15\n\ts_nop 7" ::: "memory");
        if constexpr (ALIGN_EPI) { if (wr == 0) PG8_BAR; }
        if constexpr (!Epi::AFTER_DRAIN) { E(acc, cur, wr, wc, fr, fq); }
        if (!has_next) break;
#pragma unroll
        for (int a = 0; a < 2; ++a)
#pragma unroll
            for (int b = 0; b < 2; ++b)
#pragma unroll
                for (int m = 0; m < 4; ++m)
#pragma unroll
                    for (int n = 0; n < 2; ++n) acc[a][b][m][n] = (f32x4){0.f, 0.f, 0.f, 0.f};
        cur = nxt; cA = nA; cB = nB; ++ui;
        if constexpr (GATHER) { _Pragma("unroll") for (int h_ = 0; h_ < 2; ++h_) _Pragma("unroll") for (int i_ = 0; i_ < 2; ++i_) gA[h_][i_] = gAn[h_][i_]; }
        if constexpr (ALIGN_EPI) { if (wr == 1) PG8_BAR; }
    }
    PG8_WAIT_V(0);
    if constexpr (!ALIGN_EPI) { if (wr == 0) PG8_BAR; }
    PG8_BAR;
    if constexpr (Epi::AFTER_DRAIN) { E.fused(acc, cur, wr, wc, fr, fq, lds, wid, lane); }
#undef PG8_SA
#undef PG8_SB
#undef PG8_STAGE
#undef PG8_STAGE_A
#undef PG8_GIDX
#undef PG8_LDA
#undef PG8_LDB
#undef PG8_MMA
#undef PG8_LD1
#undef PG8_WAIT_V
#undef PG8_WAIT_L
#undef PG8_BAR
#undef PG8_SCHED
}
}

#define XB_TMO      128
#define XB_XCNT(j)  (256  + 64 * (j))
#define XB_XSUB(j)  (1280 + 64 * (j))
#define XB_XGEN(j)  (2304 + 64 * (j))
#define XB_TOP      3328
#define XB_TOPGEN   3392
#define XCD_BAR_WORDS 3456
#define XB_SPIN_CAP (1u << 18)

__device__ __forceinline__ unsigned xb_ld(unsigned* p)              { return __hip_atomic_load(p, __ATOMIC_RELAXED, __HIP_MEMORY_SCOPE_AGENT); }
__device__ __forceinline__ unsigned xb_add(unsigned* p, unsigned v) { return __hip_atomic_fetch_add(p, v, __ATOMIC_RELAXED, __HIP_MEMORY_SCOPE_AGENT); }
__device__ __forceinline__ unsigned xb_xcc_id() { return (unsigned)__builtin_amdgcn_s_getreg((3 << 11) | 20) & 0xFu; }
#define XB_SPIN(cond, bar) do { unsigned _sp = 0; while (cond) { __builtin_amdgcn_s_sleep(1); \
    if ((++_sp & 255u) == 0u) { if (xb_ld(&(bar)[XB_TMO])) break; if (_sp > XB_SPIN_CAP) { atomicAdd(&(bar)[XB_TMO], 1u); break; } } } } while (0)

struct XcdBarrier {
    unsigned* bar; unsigned x;
    volatile LAS unsigned* st;
};
__device__ __forceinline__ XcdBarrier xcd_barrier_post(unsigned* bar, volatile LAS unsigned* st) {
    XcdBarrier b; b.bar = bar; b.x = xb_xcc_id(); b.st = st;
    if (threadIdx.x == 0) (void)xb_add(&bar[XB_XCNT(b.x)], 1u);
    return b;
}
__device__ __forceinline__ void xcd_barrier_complete(unsigned* bar, unsigned x, unsigned& nloc, unsigned& nx) {
    const unsigned G = gridDim.x * gridDim.y * gridDim.z;
    unsigned sum, cnt, mine, sp = 0u;
    for (;;) {
        sum = 0u; cnt = 0u; mine = 0u;
#pragma unroll
        for (unsigned j = 0; j < 16; ++j) { const unsigned c = xb_ld(&bar[XB_XCNT(j)]); sum += c; cnt += (c > 0u) ? 1u : 0u; mine = (j == x) ? c : mine; }
        if (sum == G) break;
        __builtin_amdgcn_s_sleep(1);
        if ((++sp & 255u) == 0u) { if (xb_ld(&bar[XB_TMO])) break; if (sp > XB_SPIN_CAP) { atomicAdd(&bar[XB_TMO], 1u); break; } }
    }
    nloc = mine > 0u ? mine : 1u; nx = cnt > 0u ? cnt : 1u;
}
__device__ __forceinline__ void xcd_barrier(const XcdBarrier& b) {
    asm volatile("s_waitcnt vmcnt(0)" ::: "memory");
    __syncthreads();
    if (threadIdx.x == 0) {
        unsigned* bar = b.bar;
        __builtin_amdgcn_s_waitcnt(0);
        unsigned nloc = b.st[0], nx = b.st[1];
        if (nloc == 0u) { xcd_barrier_complete(bar, b.x, nloc, nx); b.st[0] = nloc; b.st[1] = nx; }
        const unsigned old = xb_add(&bar[XB_XSUB(b.x)], 1u);
        const unsigned gen = old / nloc;
        if (old + 1u == (gen + 1u) * nloc) {
            __builtin_amdgcn_fence(__ATOMIC_RELEASE, "agent");
            asm volatile("s_waitcnt vmcnt(0)" ::: "memory");
            const unsigned og = xb_add(&bar[XB_TOP], 1u);
            const unsigned tg = og / nx;
            if (og + 1u == (tg + 1u) * nx) xb_add(&bar[XB_TOPGEN], 1u);
            else XB_SPIN(xb_ld(&bar[XB_TOPGEN]) == tg, bar);
            __builtin_amdgcn_fence(__ATOMIC_ACQUIRE, "agent");
            xb_add(&bar[XB_XGEN(b.x)], 1u);
            asm volatile("s_waitcnt vmcnt(0)" ::: "memory");
        } else {
            XB_SPIN(xb_ld(&bar[XB_XGEN(b.x)]) == gen, bar);
            __builtin_amdgcn_fence(__ATOMIC_ACQUIRE, "agent");
            asm volatile("s_waitcnt vmcnt(0)" ::: "memory");
        }
    }
    __syncthreads();
}

struct Frame {
    LAS unsigned char* lds;
    int tid, lane, wave, vcu, G;
    unsigned char* ws;
    const float* const* in;
    float* out;
};
#define WSP(T, off) ((T*)(F.ws + (off)))
enum InIdx { I_X = 0, I_C, I_CTX, I_CCTX, I_ADAW, I_ADAB, I_N1G, I_WIN, I_CONVW, I_LRE, I_LIM, I_LDT, I_BRE, I_BIM, I_CRE, I_CIM, I_SSMD, I_WGLU, I_ONCG, I_ONSG, I_WOUT, I_N2G, I_RW, I_WG, I_WU, I_WD, I_FNG };

using pg8::Unit;
struct EpiProj {
    static constexpr bool PERM = true, AFTER_DRAIN = false;
    bf16* proj; bf16* u2;
    __device__ __forceinline__ void operator()(const f32x4 (&acc)[2][2][4][2], const Unit& u, int wr, int wc, int fr, int fq) const {
        const int row0 = u.pm * 256 + wr * 64 + fr, col0 = u.pn * 256 + wc * 32 + 8 * fq;
#pragma unroll
        for (int ai = 0; ai < 2; ++ai)
#pragma unroll
            for (int m = 0; m < 4; ++m) { const int row = row0 + ai * 128 + m * 16;
#pragma unroll
                for (int bj = 0; bj < 2; ++bj) { const f32x4 v0 = acc[ai][bj][m][0], v1 = acc[ai][bj][m][1]; const int col = col0 + bj * 128;
                    v4u w; w.x = pg8::cvt_pk_bf16(v0[0], v0[1]); w.y = pg8::cvt_pk_bf16(v0[2], v0[3]); w.z = pg8::cvt_pk_bf16(v1[0], v1[1]); w.w = pg8::cvt_pk_bf16(v1[2], v1[3]);
                    bf16* dst;
                    if (u.pn < 18) dst = proj + (size_t)row * (3 * DCONV) + col;
                    else { const int cc = col - 3 * DCONV, g = cc >> 4, i0 = cc & 15; dst = u2 + ((size_t)(g * NINST + (row >> 6)) * KS2 + (row & 63) * 16 + i0); }
                    *(GAS v4u*)dst = w; } }
    }
};
struct EpiF32 {
    static constexpr bool PERM = false, AFTER_DRAIN = false;
    float* C; int ldc; size_t cstride;
    __device__ __forceinline__ void operator()(const f32x4 (&acc)[2][2][4][2], const Unit& u, int wr, int wc, int fr, int fq) const {
        float* base = C + (size_t)u.aux * cstride; const int row0 = u.pm * 256 + wr * 64 + fr, col0 = u.pn * 256 + wc * 32 + 4 * fq;
#pragma unroll
        for (int ai = 0; ai < 2; ++ai)
#pragma unroll
            for (int m = 0; m < 4; ++m) { float* rowp = base + (size_t)(row0 + ai * 128 + m * 16) * ldc + col0;
#pragma unroll
                for (int bj = 0; bj < 2; ++bj)
#pragma unroll
                    for (int n = 0; n < 2; ++n) *(GAS f32x4*)(rowp + bj * 128 + n * 16) = acc[ai][bj][m][n]; }
    }
};
struct EpiS2 {
    static constexpr bool PERM = true, AFTER_DRAIN = false;
    const bf16* u2; const float* dsk; bf16* z;
    __device__ __forceinline__ void operator()(const f32x4 (&acc)[2][2][4][2], const Unit& u, int wr, int wc, int fr, int fq) const {
        const int g = u.aux, inst0 = u.pm * 256 + wr * 64 + fr, c0 = u.pn * 256 + wc * 32 + 8 * fq;
#pragma unroll
        for (int bj = 0; bj < 2; ++bj) { const int cidx = c0 + bj * 128, t = cidx >> 4, o0 = cidx & 15;
            const f32x4 d0 = *(const GAS f32x4*)(dsk + g * 16 + o0), d1 = *(const GAS f32x4*)(dsk + g * 16 + o0 + 4);
#pragma unroll
            for (int ai = 0; ai < 2; ++ai)
#pragma unroll
                for (int m = 0; m < 4; ++m) { const int inst = inst0 + ai * 128 + m * 16;
                    if (inst < MT / 64) {
                        const v4u uu = *(const GAS v4u*)(u2 + ((size_t)(g * NINST + inst) * KS2 + cidx));
                        const f32x4 a0 = acc[ai][bj][m][0], a1 = acc[ai][bj][m][1];
                        const float y0 = a0[0] + d0[0] * bflo(uu.x), y1 = a0[1] + d0[1] * bfhi(uu.x), y2 = a0[2] + d0[2] * bflo(uu.y), y3 = a0[3] + d0[3] * bfhi(uu.y);
                        const float y4 = a1[0] + d1[0] * bflo(uu.z), y5 = a1[1] + d1[1] * bfhi(uu.z), y6 = a1[2] + d1[2] * bflo(uu.w), y7 = a1[3] + d1[3] * bfhi(uu.w);
                        v4u w; w.x = pg8::cvt_pk_bf16(gelu_tanh(y0), gelu_tanh(y1)); w.y = pg8::cvt_pk_bf16(gelu_tanh(y2), gelu_tanh(y3));
                        w.z = pg8::cvt_pk_bf16(gelu_tanh(y4), gelu_tanh(y5)); w.w = pg8::cvt_pk_bf16(gelu_tanh(y6), gelu_tanh(y7));
                        *(GAS v4u*)(z + ((size_t)(inst * 64 + t) * DSSM + g * 16 + o0)) = w; } } }
    }
};
struct EpiGlu {
    static constexpr bool PERM = true, AFTER_DRAIN = true;
    const bf16* z; const float* gain; bf16* concat;
    __device__ __forceinline__ void operator()(const f32x4 (&)[2][2][4][2], const Unit&, int, int, int, int) const {}
    __device__ __forceinline__ void fused(f32x4 (&acc)[2][2][4][2], const Unit& u, int wr, int wc, int fr, int fq, LAS unsigned char* lds, int wid, int lane) const {
        LAS float* P = (LAS float*)lds;
        const int row0 = u.pm * 256 + wr * 64 + fr, col0 = u.pn * 256 + wc * 32 + 8 * fq;
#pragma unroll
        for (int ai = 0; ai < 2; ++ai)
#pragma unroll
            for (int m = 0; m < 4; ++m) { const int row = row0 + ai * 128 + m * 16, rt = ai * 128 + wr * 64 + m * 16 + fr;
#pragma unroll
                for (int bj = 0; bj < 2; ++bj) { const v4u zz = *(const GAS v4u*)(z + (size_t)row * DSSM + col0 + bj * 128);
                    f32x4 a0 = acc[ai][bj][m][0], a1 = acc[ai][bj][m][1];
                    a0[0] = bflo(zz.x) * sigmoidf_(a0[0]); a0[1] = bfhi(zz.x) * sigmoidf_(a0[1]); a0[2] = bflo(zz.y) * sigmoidf_(a0[2]); a0[3] = bfhi(zz.y) * sigmoidf_(a0[3]);
                    a1[0] = bflo(zz.z) * sigmoidf_(a1[0]); a1[1] = bfhi(zz.z) * sigmoidf_(a1[1]); a1[2] = bflo(zz.w) * sigmoidf_(a1[2]); a1[3] = bfhi(zz.w) * sigmoidf_(a1[3]);
                    acc[ai][bj][m][0] = a0; acc[ai][bj][m][1] = a1;
                    float s = (a0[0] * a0[0] + a0[1] * a0[1]) + (a0[2] * a0[2] + a0[3] * a0[3]) + (a1[0] * a1[0] + a1[1] * a1[1]) + (a1[2] * a1[2] + a1[3] * a1[3]);
                    s += __shfl_xor(s, 16); s += __shfl_xor(s, 32);
                    if (fq == 0) P[(rt * 2 + bj) * 4 + wc] = s; } }
        LDS_WAIT(); __builtin_amdgcn_s_barrier(); asm volatile("" ::: "memory");
#pragma unroll
        for (int bj = 0; bj < 2; ++bj) { const int col = col0 + bj * 128;
            const f32x4 g0 = *(const GAS f32x4*)(gain + col), g1 = *(const GAS f32x4*)(gain + col + 4);
#pragma unroll
            for (int ai = 0; ai < 2; ++ai)
#pragma unroll
                for (int m = 0; m < 4; ++m) { const int row = row0 + ai * 128 + m * 16, rt = ai * 128 + wr * 64 + m * 16 + fr;
                    const f32x4 p = *(const LAS f32x4*)(P + (rt * 2 + bj) * 4);
                    const float rs = 1.0f / sqrtf(((p[0] + p[1]) + (p[2] + p[3])) * (1.0f / 128.0f) + EPS);
                    const f32x4 a0 = acc[ai][bj][m][0] * rs * g0, a1 = acc[ai][bj][m][1] * rs * g1;
                    v4u w; w.x = pg8::cvt_pk_bf16(a0[0], a0[1]); w.y = pg8::cvt_pk_bf16(a0[2], a0[3]); w.z = pg8::cvt_pk_bf16(a1[0], a1[1]); w.w = pg8::cvt_pk_bf16(a1[2], a1[3]);
                    *(GAS v4u*)(concat + (size_t)row * DM + DCONV + col) = w; } }
    }
};
template <bool XBF16> struct EpiOut {
    static constexpr bool PERM = true, AFTER_DRAIN = false;
    const void* xlat; const void* xctx; const float* mod; bf16* xm;
    __device__ __forceinline__ void operator()(const f32x4 (&acc)[2][2][4][2], const Unit& u, int wr, int wc, int fr, int fq) const {
        const int rb = u.pm < 64 ? (u.pm >> 3) : 8; const float* g1 = mod + (size_t)(rb * 6 + 2) * DM;
        const size_t rowoff = u.pm < 64 ? (size_t)u.pm * 256 * DM : (size_t)(u.pm - 64) * 256 * DM; const void* xbase = u.pm < 64 ? xlat : xctx;
        bf16* xo = xm + (size_t)u.pm * 256 * DM;
        const int r0 = wr * 64 + fr, col0 = u.pn * 256 + wc * 32 + 8 * fq;
        f32x4 gv[2][2];
#pragma unroll
        for (int bj = 0; bj < 2; ++bj)
#pragma unroll
            for (int n = 0; n < 2; ++n) gv[bj][n] = *(const GAS f32x4*)(g1 + col0 + bj * 128 + n * 4);
#pragma unroll
        for (int am = 0; am < 4; ++am) { const int ai = am >> 1, m0 = (am & 1) * 2; f32x4 xv[2][2][2];
#pragma unroll
            for (int mm = 0; mm < 2; ++mm) { const size_t off = rowoff + (size_t)(r0 + ai * 128 + (m0 + mm) * 16) * DM + col0;
#pragma unroll
                for (int bj = 0; bj < 2; ++bj) {
                    if constexpr (XBF16) { const v4u w = *(const GAS v4u*)((const bf16*)xbase + off + bj * 128); xv[mm][bj][0] = (f32x4){bflo(w.x), bfhi(w.x), bflo(w.y), bfhi(w.y)}; xv[mm][bj][1] = (f32x4){bflo(w.z), bfhi(w.z), bflo(w.w), bfhi(w.w)}; }
                    else { xv[mm][bj][0] = *(const GAS f32x4*)((const float*)xbase + off + bj * 128); xv[mm][bj][1] = *(const GAS f32x4*)((const float*)xbase + off + bj * 128 + 4); } } }
#pragma unroll
            for (int mm = 0; mm < 2; ++mm) { const int m = m0 + mm; const size_t off = (size_t)(r0 + ai * 128 + m * 16) * DM + col0;
#pragma unroll
                for (int bj = 0; bj < 2; ++bj) { const f32x4 o0 = xv[mm][bj][0] + gv[bj][0] * acc[ai][bj][m][0], o1 = xv[mm][bj][1] + gv[bj][1] * acc[ai][bj][m][1];
                    v4u w; w.x = pg8::cvt_pk_bf16(o0[0], o0[1]); w.y = pg8::cvt_pk_bf16(o0[2], o0[3]); w.z = pg8::cvt_pk_bf16(o1[0], o1[1]); w.w = pg8::cvt_pk_bf16(o1[2], o1[3]);
                    *(GAS v4u*)(xo + off + bj * 128) = w; } }
            asm volatile("" ::: "memory"); }
    }
};
constexpr float FP8_SW = 64.f, FP8_SH = 16.f, FP8_SA = 8.f;
__device__ __forceinline__ unsigned pk4_fp8(float a, float b, float c, float d) {
    a = __builtin_amdgcn_fmed3f(a, -448.f, 448.f); b = __builtin_amdgcn_fmed3f(b, -448.f, 448.f); c = __builtin_amdgcn_fmed3f(c, -448.f, 448.f); d = __builtin_amdgcn_fmed3f(d, -448.f, 448.f);
    unsigned w = (unsigned)__builtin_amdgcn_cvt_pk_fp8_f32(a, b, 0, false); return (unsigned)__builtin_amdgcn_cvt_pk_fp8_f32(c, d, (int)w, true); }
struct EpiMoe1 {
    static constexpr bool PERM = true, AFTER_DRAIN = false;
    unsigned char* act;
    __device__ __forceinline__ void operator()(const f32x4 (&acc)[2][2][4][2], const Unit& u, int wr, int wc, int fr, int fq) const {
        const int row0 = u.pm * 256 + wr * 64 + fr, f0 = u.pn * 128 + wc * 32 + 8 * fq; constexpr float sg = 1.0f / (FP8_SW * FP8_SH);
#pragma unroll
        for (int ai = 0; ai < 2; ++ai)
#pragma unroll
            for (int m = 0; m < 4; ++m) { const f32x4 g0 = acc[ai][0][m][0] * sg, g1 = acc[ai][0][m][1] * sg, u0 = acc[ai][1][m][0] * (sg * FP8_SA), u1 = acc[ai][1][m][1] * (sg * FP8_SA);
                float r[8];
#pragma unroll
                for (int j = 0; j < 4; ++j) { r[j] = g0[j] * sigmoidf_(g0[j]) * u0[j]; r[4 + j] = g1[j] * sigmoidf_(g1[j]) * u1[j]; }
                v2u w; w.x = pk4_fp8(r[0], r[1], r[2], r[3]); w.y = pk4_fp8(r[4], r[5], r[6], r[7]);
                *(GAS v2u*)(act + (size_t)(row0 + ai * 128 + m * 16) * DF + f0) = w; }
    }
};
struct EpiBf16 {
    static constexpr bool PERM = true, AFTER_DRAIN = false;
    bf16* O; int ldc; float scale;
    __device__ __forceinline__ void operator()(const f32x4 (&acc)[2][2][4][2], const Unit& u, int wr, int wc, int fr, int fq) const {
        const int row0 = u.pm * 256 + wr * 64 + fr, col0 = u.pn * 256 + wc * 32 + 8 * fq;
#pragma unroll
        for (int ai = 0; ai < 2; ++ai)
#pragma unroll
            for (int m = 0; m < 4; ++m) { bf16* rowp = O + (size_t)(row0 + ai * 128 + m * 16) * ldc + col0;
#pragma unroll
                for (int bj = 0; bj < 2; ++bj) { const f32x4 v0 = acc[ai][bj][m][0] * scale, v1 = acc[ai][bj][m][1] * scale;
                    v4u w; w.x = pg8::cvt_pk_bf16(v0[0], v0[1]); w.y = pg8::cvt_pk_bf16(v0[2], v0[3]); w.z = pg8::cvt_pk_bf16(v1[0], v1[1]); w.w = pg8::cvt_pk_bf16(v1[2], v1[3]);
                    *(GAS v4u*)(rowp + bj * 128) = w; } }
    }
};

struct SchedProj {
    const char* A; const char* B; int G, c, layer;
    __device__ __forceinline__ bool next(int i, Unit& u) const {
        const int L = i * G + c; int rt, ct;
        if (layer == 0) { if (L >= 1440) return false; rt = (L / 160) * 8 + (L & 7); ct = (L % 160) >> 3; }
        else { if (L >= 1296) return false; if (L < 1280) { rt = (L / 160) * 8 + (L & 7); ct = (L % 160) >> 3; } else { const int j = L - 1280; rt = 64 + (j & 7); ct = 18 + (j >> 3); } }
        u.pm = rt; u.pn = ct; u.aux = 0; u.a = A + (size_t)rt * 256 * DM * 2; u.b = B + (size_t)ct * 256 * DM * 2; return true; }
};
struct SchedF {
    const char* A; const char* B; int G, c;
    __device__ __forceinline__ bool next(int i, Unit& u) const {
        const int j = c - (G - 64); if (i != 0 || j < 0) return false;
        const int g = j >> 1, rt = j & 1; u.pm = rt; u.pn = 0; u.aux = g; u.a = A + (size_t)(g * NINST + rt * 256) * KS2 * 2; u.b = B + (size_t)g * 256 * 1024 * 2; return true; }
};
struct SchedS2 {
    const char* A; const char* B; int G, c, layer;
    __device__ __forceinline__ bool next(int i, Unit& u) const {
        const int L = i * G + c; int g, rt, ct;
        if (layer == 0) { if (L >= 256) return false; g = L >> 3; rt = (L >> 2) & 1; ct = L & 3; } else { if (L >= 128) return false; g = L >> 2; rt = 0; ct = L & 3; }
        u.pm = rt; u.pn = ct; u.aux = g; u.a = A + (size_t)(g * NINST + rt * 256) * KS2 * 2; u.b = B + (size_t)(g * 1024 + ct * 256) * KS2 * 2; return true; }
};
struct SchedGlu {
    const char* A; const char* B; int G, c, nrt;
    __device__ __forceinline__ bool next(int i, Unit& u) const {
        const int L = i * G + c; if (L >= nrt * 2) return false;
        u.pm = L >> 1; u.pn = L & 1; u.aux = 0; u.a = A + (size_t)u.pm * 256 * DSSM * 2; u.b = B + (size_t)u.pn * 256 * DSSM * 2; return true; }
};
struct SchedOut {
    const char* A; const char* B; int G, c, nrt;
    __device__ __forceinline__ bool next(int i, Unit& u) const {
        const int L = i * G + c; if (L >= nrt * 8) return false;
        u.pm = (L >> 6) * 8 + (L & 7); u.pn = (L & 63) >> 3; u.aux = 0; u.a = A + (size_t)u.pm * 256 * DM * 2; u.b = B + (size_t)u.pn * 256 * DM * 2; return true; }
};
struct SchedMoe {
    const char* A; const char* B; int G, c, nct, layer, gather;
    __device__ __forceinline__ bool next(int i, Unit& u) const {
        const int L = i * G + c, per = 8 * nct, nlat = NE * per; int e, rtile, ct;
        if (L < nlat) { e = L / per; const int w = L % per; ct = (w >> 5) * 4 + (w & 3); rtile = e * 8 + ((w & 31) >> 2); }
        else { const int j = L - nlat; if (layer != 0 || j >= NE * nct) return false; e = j / nct; ct = j % nct; rtile = NE * 8 + e; }
        u.pm = rtile; u.pn = ct; u.aux = e; u.a = gather ? A : A + (size_t)rtile * 256 * 2048; u.b = B + ((size_t)e * nct + ct) * 256 * 2048; return true; }
};

struct CvtItem { const float* src; unsigned char* dst; int N, ldwt, fp8; };
__device__ __forceinline__ void cvt_decode(Frame& F, long it, CvtItem& d) {
    constexpr long I_EXP = 32 * 64;
    constexpr long N_GATE = 2L * NE * I_EXP, N_WIN = 2L * 32 * 160, N_WOUT = 2L * I_EXP;
    long r = it;
    if (r < 2 * N_GATE) {
        const int kind = r >= N_GATE; if (kind) r -= N_GATE;
        const int le = (int)(r / I_EXP), q = (int)(r % I_EXP), kb = q >> 6, n0 = (q & 63) * 32;
        d.src = F.in[kind ? I_WU : I_WG] + (size_t)le * DM * DF + (size_t)(kb * 64) * DF + n0; d.N = DF; d.ldwt = DM; d.fp8 = 1;
        d.dst = WSP(unsigned char, WS_WGU) + ((size_t)le * 4096 + (n0 >> 7) * 256 + kind * 128 + (n0 & 127)) * DM + kb * 64; return; }
    r -= 2 * N_GATE;
    if (r < N_GATE) { const int le = (int)(r / I_EXP), q = (int)(r % I_EXP), kb = q >> 6, n0 = (q & 63) * 32;
        d.src = F.in[I_WD] + (size_t)le * DF * DM + (size_t)(kb * 64) * DM + n0; d.N = DM; d.ldwt = DF; d.fp8 = 1;
        d.dst = WSP(unsigned char, WS_WDN) + ((size_t)le * DM + n0) * DF + kb * 64; return; }
    r -= N_GATE; d.fp8 = 0;
    if (r < N_WIN) { const int l = (int)(r / (32 * 160)), q = (int)(r % (32 * 160)), kb = q / 160, n0 = (q % 160) * 32;
        d.src = F.in[I_WIN] + (size_t)l * DM * DINP + (size_t)(kb * 64) * DINP + n0; d.N = DINP; d.ldwt = DM * 2;
        d.dst = (unsigned char*)(WSP(bf16, WS_WIN) + ((size_t)l * DINP + n0) * DM + kb * 64); return; }
    r -= N_WIN;
    if (r < N_WOUT) { const int l = (int)(r / I_EXP), q = (int)(r % I_EXP), kb = q >> 6, n0 = (q & 63) * 32;
        d.src = F.in[I_WOUT] + (size_t)l * DM * DM + (size_t)(kb * 64) * DM + n0; d.N = DM; d.ldwt = DM * 2;
        d.dst = (unsigned char*)(WSP(bf16, WS_WOUT) + ((size_t)l * DM + n0) * DM + kb * 64); return; }
    r -= N_WOUT;
    { const int l = (int)(r / 128), q = (int)(r % 128), kb = q >> 4, n0 = (q & 15) * 32;
        d.src = F.in[I_WGLU] + (size_t)l * DSSM * DSSM + (size_t)(kb * 64) * DSSM + n0; d.N = DSSM; d.ldwt = DSSM * 2;
        d.dst = (unsigned char*)(WSP(bf16, WS_WGLU) + ((size_t)l * DSSM + n0) * DSSM + kb * 64); }
}
__device__ __forceinline__ void cvt_load(const CvtItem& d, int lane, float (&t)[32]) {
    const float* src = d.src + (size_t)(lane >> 5) * d.N + (lane & 31);
#pragma unroll
    for (int i = 0; i < 32; ++i) t[i] = *(const GAS float*)(src + (size_t)(2 * i) * d.N);
}
template <bool FP8>
__device__ __forceinline__ void cvt_store(const CvtItem& d, LAS float* scr, int lane, const float (&t)[32]) {
    constexpr float sc = FP8 ? FP8_SW : 1.0f;
#pragma unroll
    for (int i = 0; i < 32; ++i) scr[(2 * i + (lane >> 5)) * 33 + (lane & 31)] = t[i] * sc;
    LDS_WAIT(); asm volatile("" ::: "memory");
    const int c = lane & 7;
#pragma unroll
    for (int j = 0; j < 4; ++j) { const int n = (lane >> 3) + 8 * j; const LAS float* s = scr + (8 * c) * 33 + n;
        const float v0 = s[0 * 33], v1 = s[1 * 33], v2 = s[2 * 33], v3 = s[3 * 33], v4 = s[4 * 33], v5 = s[5 * 33], v6 = s[6 * 33], v7 = s[7 * 33];
        if constexpr (FP8) { v2u o; o.x = pk4_fp8(v0, v1, v2, v3); o.y = pk4_fp8(v4, v5, v6, v7); *(GAS v2u*)(d.dst + (size_t)n * d.ldwt + 8 * c) = o; }
        else { v4u o; o.x = pk2(v0, v1); o.y = pk2(v2, v3); o.z = pk2(v4, v5); o.w = pk2(v6, v7); *(GAS v4u*)(d.dst + (size_t)n * d.ldwt + 16 * c) = o; } }
    LDS_WAIT(); asm volatile("" ::: "memory");
}
constexpr long CVT_NFP8 = 3L * (2L * NE * 2048), CVT_NITEMS = CVT_NFP8 + 2L * 32 * 160 + 2L * 2048 + 2L * 128;
constexpr unsigned CVT_CHUNK = 8;
struct CvtQ { unsigned next, left; };
__device__ __forceinline__ long cvt_pull(Frame& F, CvtQ& q, unsigned* ctr, long lo, long hi) {
    if (q.left == 0u) { unsigned b = 0u; if (F.lane == 0) b = __hip_atomic_fetch_add(ctr, CVT_CHUNK, __ATOMIC_RELAXED, __HIP_MEMORY_SCOPE_AGENT);
        q.next = (unsigned)__builtin_amdgcn_readfirstlane((int)b); q.left = CVT_CHUNK; }
    const long it = lo + (long)q.next; ++q.next; --q.left; return it < hi ? it : -1;
}
template <bool FP8>
__device__ __forceinline__ void cvt_run(Frame& F, LAS float* scr, int rep) {
    unsigned* ctr = (unsigned*)(F.ws + WS_CTL) + (FP8 ? 64 : 128) + 256 * rep;     const long lo = FP8 ? 0 : CVT_NFP8, hi = FP8 ? CVT_NFP8 : CVT_NITEMS;
    CvtItem A, B; float ta[32], tb[32]; CvtQ q{0u, 0u};
    long ia = cvt_pull(F, q, ctr, lo, hi);
    if (ia < 0) return;
    cvt_decode(F, ia, A); cvt_load(A, F.lane, ta);
    for (;;) {
        long ib = cvt_pull(F, q, ctr, lo, hi); const bool vb = ib >= 0; ib = vb ? ib : ia;
        cvt_decode(F, ib, B); cvt_load(B, F.lane, tb);
        cvt_store<FP8>(A, scr, F.lane, ta);
        if (!vb) break;
        ia = cvt_pull(F, q, ctr, lo, hi); const bool va = ia >= 0; ia = va ? ia : ib;
        cvt_decode(F, ia, A); cvt_load(A, F.lane, ta);
        cvt_store<FP8>(B, scr, F.lane, tb);
        if (!va) break;
    }
}
constexpr int CVT_NTILES = 96 * 128;
struct CvtTile { const float* src; unsigned char* dst; int kind, n0; };
__device__ __forceinline__ void cvt_tile_decode(Frame& F, int T, CvtTile& d) {
    const int m = T >> 7, q = T & 127, kt = q >> 3, nt = q & 7, kind = m >> 5, le = m & 31;
    d.kind = kind; d.n0 = nt * 256;
    d.src = F.in[kind == 0 ? I_WG : (kind == 1 ? I_WU : I_WD)] + (size_t)le * DM * DF + (size_t)(kt * 128) * 2048 + nt * 256;
    d.dst = (kind < 2 ? WSP(unsigned char, WS_WGU) + (size_t)le * 4096 * DM : WSP(unsigned char, WS_WDN) + (size_t)le * DM * DF) + kt * 128;
}
__device__ __forceinline__ void cvt_tile_load(const CvtTile& d, int wave, int lane, f32x4 (&v)[16]) {
#pragma unroll
    for (int i = 0; i < 4; ++i)
#pragma unroll
        for (int r = 0; r < 4; ++r) v[4 * i + r] = *(const GAS f32x4*)(d.src + (size_t)(4 * (wave + 8 * i) + r) * 2048 + 4 * lane);
}
__device__ __forceinline__ void cvt_tile_put(LAS unsigned char* buf, int wave, int lane, const f32x4 (&v)[16]) {
#pragma unroll
    for (int i = 0; i < 4; ++i) { const int kq = wave + 8 * i; unsigned d[4];
#pragma unroll
        for (int r = 0; r < 4; ++r) { const f32x4 x = v[4 * i + r] * FP8_SW; d[r] = pk4_fp8(x[0], x[1], x[2], x[3]); }
        const unsigned t01l = __builtin_amdgcn_perm(d[1], d[0], 0x05010400u), t01h = __builtin_amdgcn_perm(d[1], d[0], 0x07030602u);
        const unsigned t23l = __builtin_amdgcn_perm(d[3], d[2], 0x05010400u), t23h = __builtin_amdgcn_perm(d[3], d[2], 0x07030602u);
        unsigned o[4]; o[0] = __builtin_amdgcn_perm(t23l, t01l, 0x05040100u); o[1] = __builtin_amdgcn_perm(t23l, t01l, 0x07060302u);
        o[2] = __builtin_amdgcn_perm(t23h, t01h, 0x05040100u); o[3] = __builtin_amdgcn_perm(t23h, t01h, 0x07060302u);
        const int goff = ((((kq >> 2) ^ (lane & 7)) << 4) + ((kq & 3) << 2));
#pragma unroll
        for (int j = 0; j < 4; ++j) *(LAS unsigned*)(buf + (4 * lane + j) * 128 + goff) = o[j]; }
}
__device__ __forceinline__ void cvt_tile_get(const CvtTile& d, const LAS unsigned char* buf, int tid) {
#pragma unroll
    for (int i = 0; i < 4; ++i) { const int q = tid + 512 * i, n = q >> 3, c = q & 7, f = d.n0 + n;
        const v4u w = *(const LAS v4u*)(buf + n * 128 + ((c ^ ((n >> 2) & 7)) << 4));
        const int row = d.kind < 2 ? ((f >> 7) * 256 + d.kind * 128 + (f & 127)) : f;
        *(GAS v4u*)(d.dst + (size_t)row * 2048 + c * 16) = w; }
}
__device__ __forceinline__ void cvt_tiles(Frame& F, int rep) {
    unsigned* ctr = (unsigned*)(F.ws + WS_CTL) + 64 + 256 * rep;
    volatile LAS int* slot = (volatile LAS int*)(F.lds + MISC_OFF) + 16;
    LAS unsigned char* buf0 = F.lds; LAS unsigned char* buf1 = F.lds + 32768;
    if (F.tid == 0) { slot[0] = (int)__hip_atomic_fetch_add(ctr, 1u, __ATOMIC_RELAXED, __HIP_MEMORY_SCOPE_AGENT); slot[1] = (int)__hip_atomic_fetch_add(ctr, 1u, __ATOMIC_RELAXED, __HIP_MEMORY_SCOPE_AGENT); }
    __syncthreads();
    int ia = slot[0];
    if (ia >= CVT_NTILES) { __syncthreads(); return; }
    CvtTile A, B; f32x4 va[16], vb[16];
    cvt_tile_decode(F, ia, A); cvt_tile_load(A, F.wave, F.lane, va);
    for (int it = 0;; it += 2) {
        int ib = slot[(it + 1) & 3]; const bool vbv = ib < CVT_NTILES; ib = vbv ? ib : ia;
        if (F.tid == 0) slot[(it + 2) & 3] = (int)__hip_atomic_fetch_add(ctr, 1u, __ATOMIC_RELAXED, __HIP_MEMORY_SCOPE_AGENT);
        cvt_tile_decode(F, ib, B); cvt_tile_load(B, F.wave, F.lane, vb);
        cvt_tile_put(buf0, F.wave, F.lane, va);
        LDS_WAIT(); __syncthreads();
        cvt_tile_get(A, buf0, F.tid);
        if (!vbv) break;
        ia = slot[(it + 2) & 3]; const bool vav = ia < CVT_NTILES; ia = vav ? ia : ib;
        if (F.tid == 0) slot[(it + 3) & 3] = (int)__hip_atomic_fetch_add(ctr, 1u, __ATOMIC_RELAXED, __HIP_MEMORY_SCOPE_AGENT);
        cvt_tile_decode(F, ia, A); cvt_tile_load(A, F.wave, F.lane, va);
        cvt_tile_put(buf1, F.wave, F.lane, vb);
        LDS_WAIT(); __syncthreads();
        cvt_tile_get(B, buf1, F.tid);
        if (!vav) break;
    }
    LDS_WAIT(); __syncthreads();
}
__device__ __forceinline__ void p0_convert_weights(Frame& F, int rep) {
    cvt_tiles(F, rep);
    LAS float* scr = (LAS float*)(F.lds + F.wave * 16384);
    cvt_run<false>(F, scr, rep);
    __syncthreads();
}
__device__ __forceinline__ void p0_mod_task(Frame& F, int task) {
    const int l = task / 96, n0 = (task % 96) * 128;
    LAS float* sc = (LAS float*)F.lds;
    LAS float* red = (LAS float*)(F.lds + 9 * 2048 * 4);
    for (int i = F.tid; i < 9 * DM; i += 512) { const int r = i >> 11, k = i & 2047; const float v = r < 8 ? F.in[I_C][r * DM + k] : F.in[I_CCTX][k]; sc[i] = v * sigmoidf_(v); }
    __syncthreads();
    const float* W = F.in[I_ADAW] + (size_t)l * DM * 6 * DM + n0 + 2 * F.lane;
    float acc[9][2];
#pragma unroll
    for (int r = 0; r < 9; ++r) { acc[r][0] = 0.f; acc[r][1] = 0.f; }
    const int kbase = F.wave * 256;
#pragma unroll 8
    for (int kk = 0; kk < 256; ++kk) { const int k = kbase + kk; const f32x2 w = *(const GAS f32x2*)(W + (size_t)k * (6 * DM));
#pragma unroll
        for (int r = 0; r < 9; ++r) { const float s = sc[r * DM + k]; acc[r][0] += s * w.x; acc[r][1] += s * w.y; } }
#pragma unroll
    for (int r = 0; r < 9; ++r) { red[(F.wave * 9 + r) * 128 + 2 * F.lane] = acc[r][0]; red[(F.wave * 9 + r) * 128 + 2 * F.lane + 1] = acc[r][1]; }
    __syncthreads();
    float* mod = WSP(float, WS_MOD) + (size_t)l * 9 * 6 * DM;
    for (int i = F.tid; i < 9 * 128; i += 512) { const int r = i >> 7, n = i & 127; float s = F.in[I_ADAB][(size_t)l * 6 * DM + n0 + n];
#pragma unroll
        for (int w = 0; w < 8; ++w) s += red[(w * 9 + r) * 128 + n];
        mod[(size_t)r * 6 * DM + n0 + n] = s; }
    __syncthreads();
}
__device__ __forceinline__ void p0_s5_task(Frame& F, int task) {
    const int l = task >> 5, g = task & 31;
    LAS f32x2* PW = (LAS f32x2*)F.lds;
    LAS f32x2* BB = (LAS f32x2*)(F.lds + 33280);
    LAS f32x2* CC = (LAS f32x2*)(F.lds + 41472);
    LAS float* KD = (LAS float*)(F.lds + 49664);
    LAS bf16* KT = (LAS bf16*)(F.lds + 50688);
    bf16* WF = WSP(bf16, WS_WF) + (size_t)(l * NG + g) * 256 * 1024;
    bf16* W2 = WSP(bf16, WS_W2) + (size_t)(l * NG + g) * 1024 * KS2;
    for (int d = 0; d < 2; ++d) {
        const int ldg = (l * 2 + d) * NG + g;
        if (F.tid < 64) { const int p = F.tid;
            const double lr = (double)F.in[I_LRE][ldg * SP + p], li = (double)F.in[I_LIM][ldg * SP + p], dt = exp((double)F.in[I_LDT][ldg]);
            const double mag = exp(lr * dt), ar = mag * cos(li * dt), ai = mag * sin(li * dt), den = lr * lr + li * li, nr = ar - 1.0;
            const double kr = (nr * lr + ai * li) / den, ki = (ai * lr - nr * li) / den;
            double pr = 1.0, pi = 0.0;
            for (int e = 0; e <= 64; ++e) { PW[e * 64 + p] = (f32x2){(float)pr, (float)pi}; const double t = pr * ar - pi * ai; pi = pr * ai + pi * ar; pr = t; }
            if (true) { const f32x2 lt = PW[64 * 64 + p]; WSP(f32x2, WS_LT)[((l * NG + g) * 2 + d) * 64 + p] = lt; }
            for (int i = 0; i < SG; ++i) { const double br = (double)F.in[I_BRE][((size_t)ldg * SP + p) * SG + i], bi = (double)F.in[I_BIM][((size_t)ldg * SP + p) * SG + i];
                BB[p * 16 + i] = (f32x2){(float)(kr * br - ki * bi), (float)(kr * bi + ki * br)}; } }
        for (int i = F.tid; i < 1024; i += 512) CC[i] = (f32x2){F.in[I_CRE][(size_t)ldg * 1024 + i], F.in[I_CIM][(size_t)ldg * 1024 + i]};
        __syncthreads();
        { const int ph = F.tid & 1, q = F.tid >> 1, o = q >> 4, i = q & 15;
            float cbr[32], cbi[32];
#pragma unroll
            for (int p = 0; p < 32; ++p) { const f32x2 c = CC[o * 64 + ph * 32 + p], b = BB[(ph * 32 + p) * 16 + i]; cbr[p] = c.x * b.x - c.y * b.y; cbi[p] = c.x * b.y + c.y * b.x; }
#pragma unroll 1
            for (int j = 0; j < 64; ++j) { float s = 0.f;
#pragma unroll
                for (int p = 0; p < 32; p += 2) { const f32x4 P = *(const LAS f32x4*)(PW + j * 64 + ph * 32 + p); s += (cbr[p] * P[0] - cbi[p] * P[1]) + (cbr[p + 1] * P[2] - cbi[p + 1] * P[3]); }
                s += __shfl_xor(s, 1);
                if (ph == 0) { if (j == 0) { if (d == 0) KD[q] = s; else { s += KD[q]; KT[q] = (bf16)f2bf(s); } }
                               else KT[(d * 64 + j) * 256 + q] = (bf16)f2bf(s); } } }
        for (int it = F.tid; it < 128 * 128; it += 512) { const int n = it >> 7, k8 = it & 127, ri = n >> 6, p = n & 63, s = k8 >> 1, i0 = (k8 & 1) * 8, e = d == 0 ? 63 - s : s;
            const f32x2 P = PW[e * 64 + p]; float v[8];
#pragma unroll
            for (int j = 0; j < 8; ++j) { const f32x2 b = BB[p * 16 + i0 + j]; v[j] = ri == 0 ? (P.x * b.x - P.y * b.y) : (P.x * b.y + P.y * b.x); }
            v4u o; o.x = pk2(v[0], v[1]); o.y = pk2(v[2], v[3]); o.z = pk2(v[4], v[5]); o.w = pk2(v[6], v[7]);
            *(GAS v4u*)(WF + (size_t)(d * 128 + n) * 1024 + k8 * 8) = o; }
        for (int it = F.tid; it < 1024 * 16; it += 512) { const int n = it >> 4, c8 = it & 15, ri = c8 >> 3, p0 = (c8 & 7) * 8, t = n >> 4, o = n & 15, e = d == 0 ? t + 1 : 64 - t; float v[8];
#pragma unroll
            for (int j = 0; j < 8; ++j) { const f32x2 c = CC[o * 64 + p0 + j], P = PW[e * 64 + p0 + j]; v[j] = ri == 0 ? (c.x * P.x - c.y * P.y) : -(c.x * P.y + c.y * P.x); }
            v4u ov; ov.x = pk2(v[0], v[1]); ov.y = pk2(v[2], v[3]); ov.z = pk2(v[4], v[5]); ov.w = pk2(v[6], v[7]);
            *(GAS v4u*)(W2 + (size_t)n * KS2 + 1024 + d * 128 + c8 * 8) = ov; }
        __syncthreads();
    }
    for (int it = F.tid; it < 1024 * 128; it += 512) { const int n = it >> 7, k8 = it & 127, t = n >> 4, o = n & 15, s = k8 >> 1, i0 = (k8 & 1) * 8;
        const int dsel = s <= t ? 0 : 1, j = s <= t ? t - s : s - t;
        const v4u kv = *(const LAS v4u*)(KT + (dsel * 64 + j) * 256 + o * 16 + i0);
        *(GAS v4u*)(W2 + (size_t)n * KS2 + k8 * 8) = kv; }
    __syncthreads();
}
__device__ __forceinline__ void p0_router_t(Frame& F) {
    for (int i = (F.vcu * 512 + F.tid); i < 2 * 16 * DM; i += F.G * 512) { const int l = i >> 15, e = (i >> 11) & 15, k = i & 2047; WSP(float, WS_RWT)[i] = F.in[I_RW][((size_t)l * DM + k) * NE + e]; }
}

__device__ __forceinline__ int mbcnt64(unsigned long long m) { return (int)__builtin_amdgcn_mbcnt_hi((unsigned)(m >> 32), __builtin_amdgcn_mbcnt_lo((unsigned)m, 0u)); }
__device__ __forceinline__ void combine_row(Frame& F, int r, const float* g2, f32x4 (&x)[8]) {
    const int* sel = WSP(int, WS_SEL) + (size_t)r * NE; const float* vals = WSP(float, WS_VALS); const bf16* Y = WSP(bf16, WS_R1);
    const int mysel = F.lane < NE ? *(const GAS int*)(sel + F.lane) : -1;
    unsigned long long m = __ballot(mysel >= 0);
    f32x4 macc[8];
#pragma unroll
    for (int j = 0; j < 8; ++j) macc[j] = (f32x4){0.f, 0.f, 0.f, 0.f};
    while (m) { const int e = __builtin_ctzll(m); m &= m - 1;
        const int y = __builtin_amdgcn_readlane(mysel, e); const float val = *(const GAS float*)(vals + y); const bf16* yr = Y + (size_t)y * DM + 4 * F.lane;
#pragma unroll
        for (int j = 0; j < 8; ++j) { const v2u w = *(const GAS v2u*)(yr + j * 256); macc[j] += val * (f32x4){bflo(w.x), bfhi(w.x), bflo(w.y), bfhi(w.y)}; } }
#pragma unroll
    for (int j = 0; j < 8; ++j) x[j] += *(const GAS f32x4*)(g2 + j * 256 + 4 * F.lane) * macc[j];
}
__device__ __forceinline__ f32x4 ld_bf4(const bf16* p) { const v2u w = *(const GAS v2u*)p; return (f32x4){bflo(w.x), bfhi(w.x), bflo(w.y), bfhi(w.y)}; }
__device__ __forceinline__ float row_rs(const f32x4 (&x)[8]) {
    float s = 0.f;
#pragma unroll
    for (int j = 0; j < 8; ++j) s += (x[j][0] * x[j][0] + x[j][1] * x[j][1]) + (x[j][2] * x[j][2] + x[j][3] * x[j][3]);
    return 1.0f / sqrtf(wave_sum(s) * (1.0f / DM) + EPS);
}
__device__ __forceinline__ void phase_norm1(Frame& F, int l) {
    const float* modl = WSP(float, WS_MOD) + (size_t)l * 9 * 6 * DM; const float* gn = F.in[I_N1G] + (size_t)l * DM;
    for (int r = F.vcu * NWAVES + F.wave; r < MT; r += F.G * NWAVES) {
        const int rb = r < ML ? (r >> 11) : 8;
        f32x4 x[8];
        if (l == 0) { const float* xr = r < ML ? F.in[I_X] + (size_t)r * DM : F.in[I_CTX] + (size_t)(r - ML) * DM;
#pragma unroll
            for (int j = 0; j < 8; ++j) x[j] = *(const GAS f32x4*)(xr + j * 256 + 4 * F.lane); }
        else { const bf16* xr = WSP(bf16, WS_XM) + (size_t)r * DM;
#pragma unroll
            for (int j = 0; j < 8; ++j) x[j] = ld_bf4(xr + j * 256 + 4 * F.lane); }
        if (l == 1) { combine_row(F, r, WSP(float, WS_MOD) + (size_t)(rb * 6 + 5) * DM, x);
            bf16* xo = WSP(bf16, WS_XL) + (size_t)r * DM;
#pragma unroll
            for (int j = 0; j < 8; ++j) { v2u w; w.x = pk2(x[j][0], x[j][1]); w.y = pk2(x[j][2], x[j][3]); *(GAS v2u*)(xo + j * 256 + 4 * F.lane) = w; } }
        const float rs = row_rs(x); const float* sh = modl + (size_t)(rb * 6 + 0) * DM; const float* sc = modl + (size_t)(rb * 6 + 1) * DM;
        bf16* ho = WSP(bf16, WS_H) + (size_t)r * DM;
#pragma unroll
        for (int j = 0; j < 8; ++j) { const int c = j * 256 + 4 * F.lane; const f32x4 g = *(const GAS f32x4*)(gn + c), s1 = *(const GAS f32x4*)(sc + c), s0 = *(const GAS f32x4*)(sh + c);
            const f32x4 h = x[j] * rs * g * (1.0f + s1) + s0; v2u w; w.x = pk2(h[0], h[1]); w.y = pk2(h[2], h[3]); *(GAS v2u*)(ho + c) = w; }
    }
}
__device__ __forceinline__ void phase_final(Frame& F) {
    const float* gn = F.in[I_FNG];
    for (int r = F.vcu * NWAVES + F.wave; r < ML; r += F.G * NWAVES) {
        const int rb = r >> 11; const bf16* xr = WSP(bf16, WS_XM) + (size_t)r * DM;
        f32x4 x[8];
#pragma unroll
        for (int j = 0; j < 8; ++j) x[j] = ld_bf4(xr + j * 256 + 4 * F.lane);
        combine_row(F, r, WSP(float, WS_MOD) + (size_t)((9 + rb) * 6 + 5) * DM, x);
        const float rs = row_rs(x); float* o = F.out + (size_t)r * DM;
#pragma unroll
        for (int j = 0; j < 8; ++j) { const int c = j * 256 + 4 * F.lane; *(GAS f32x4*)(o + c) = x[j] * rs * *(const GAS f32x4*)(gn + c); }
    }
}
__device__ __forceinline__ void phase_norm2(Frame& F, int l) {
    LAS float* rwt = (LAS float*)F.lds;
    { const float* src = WSP(float, WS_RWT) + (size_t)l * NE * DM;
        for (int i = F.tid; i < NE * DM / 4; i += 512) *(LAS f32x4*)(rwt + 4 * i) = *(const GAS f32x4*)(src + 4 * i); }
    __syncthreads();
    const float* modl = WSP(float, WS_MOD) + (size_t)l * 9 * 6 * DM; const float* gn = F.in[I_N2G] + (size_t)l * DM;
    const int nrows = l == 0 ? MT : ML;
    for (int r = F.vcu * NWAVES + F.wave; r < nrows; r += F.G * NWAVES) {
        const int rb = r < ML ? (r >> 11) : 8; const bf16* xr = WSP(bf16, WS_XM) + (size_t)r * DM;
        f32x4 x[8];
#pragma unroll
        for (int j = 0; j < 8; ++j) x[j] = ld_bf4(xr + j * 256 + 4 * F.lane);
        const float rs = row_rs(x); const float* sh = modl + (size_t)(rb * 6 + 3) * DM; const float* sc = modl + (size_t)(rb * 6 + 4) * DM;
        unsigned char* ho = WSP(unsigned char, WS_H) + (size_t)r * DM;
#pragma unroll
        for (int j = 0; j < 8; ++j) { const int c = j * 256 + 4 * F.lane; const f32x4 g = *(const GAS f32x4*)(gn + c), s1 = *(const GAS f32x4*)(sc + c), s0 = *(const GAS f32x4*)(sh + c);
            x[j] = x[j] * rs * g * (1.0f + s1) + s0; *(GAS unsigned*)(ho + c) = pk4_fp8(x[j][0] * FP8_SH, x[j][1] * FP8_SH, x[j][2] * FP8_SH, x[j][3] * FP8_SH); }
        float p[NE];
#pragma unroll
        for (int eg = 0; eg < NE; eg += 2) { float s0 = 0.f, s1 = 0.f;
#pragma unroll
            for (int j = 0; j < 8; ++j) { const f32x4 w0 = *(const LAS f32x4*)(rwt + eg * DM + j * 256 + 4 * F.lane), w1 = *(const LAS f32x4*)(rwt + (eg + 1) * DM + j * 256 + 4 * F.lane);
                s0 += (x[j][0] * w0[0] + x[j][1] * w0[1]) + (x[j][2] * w0[2] + x[j][3] * w0[3]); s1 += (x[j][0] * w1[0] + x[j][1] * w1[1]) + (x[j][2] * w1[2] + x[j][3] * w1[3]); }
            p[eg] = s0; p[eg + 1] = s1; __builtin_amdgcn_sched_barrier(0); }
        const bool b5 = (F.lane & 32) != 0, b4 = (F.lane & 16) != 0, b3 = (F.lane & 8) != 0, b2 = (F.lane & 4) != 0;
        float q8[8], q4[4], q2[2];
#pragma unroll
        for (int i = 0; i < 8; ++i) { const float keep = b5 ? p[i + 8] : p[i], give = b5 ? p[i] : p[i + 8]; q8[i] = keep + __shfl_xor(give, 32); }
#pragma unroll
        for (int i = 0; i < 4; ++i) { const float keep = b4 ? q8[i + 4] : q8[i], give = b4 ? q8[i] : q8[i + 4]; q4[i] = keep + __shfl_xor(give, 16); }
#pragma unroll
        for (int i = 0; i < 2; ++i) { const float keep = b3 ? q4[i + 2] : q4[i], give = b3 ? q4[i] : q4[i + 2]; q2[i] = keep + __shfl_xor(give, 8); }
        float lg; { const float keep = b2 ? q2[1] : q2[0], give = b2 ? q2[0] : q2[1]; lg = keep + __shfl_xor(give, 4); }
        lg += __shfl_xor(lg, 2); lg += __shfl_xor(lg, 1);
        float mx = lg;
        mx = fmaxf(mx, __shfl_xor(mx, 4)); mx = fmaxf(mx, __shfl_xor(mx, 8)); mx = fmaxf(mx, __shfl_xor(mx, 16)); mx = fmaxf(mx, __shfl_xor(mx, 32));
        const float ex = __expf(lg - mx); float den = ex;
        den += __shfl_xor(den, 4); den += __shfl_xor(den, 8); den += __shfl_xor(den, 16); den += __shfl_xor(den, 32);
        const float mine = ex / den; const int ex_id = (F.lane >> 2) & 15;
        if ((F.lane & 3) == 0) { if (r < ML) WSP(float, WS_AFF)[((size_t)(rb * NE + ex_id) << 11) + (r & 2047)] = mine;
                                 else { const int q = r - ML; WSP(float, WS_AFFC)[((size_t)((q >> 8) * NE + ex_id) << 8) + (q & 255)] = mine; } }
    }
    __syncthreads();
}
__device__ __forceinline__ void unpack8(const v4u w, f32x4& lo, f32x4& hi) { lo = (f32x4){bflo(w.x), bfhi(w.x), bflo(w.y), bfhi(w.y)}; hi = (f32x4){bflo(w.z), bfhi(w.z), bflo(w.w), bfhi(w.w)}; }
__device__ __forceinline__ void phase_conv(Frame& F, int l, int nblk) {
    const bf16* P = WSP(bf16, WS_R1); bf16* cc = WSP(bf16, WS_R2);
    const float* cw = F.in[I_CONVW] + (size_t)l * 3 * DCONV; const float* gn = F.in[I_ONCG] + (size_t)l * DCONV;
    f32x4 w[3][3][2], g[3][2];
#pragma unroll
    for (int ch = 0; ch < 3; ++ch) { const int c0 = ch * 512 + 8 * F.lane;
#pragma unroll
        for (int t = 0; t < 3; ++t) { w[ch][t][0] = *(const GAS f32x4*)(cw + t * DCONV + c0); w[ch][t][1] = *(const GAS f32x4*)(cw + t * DCONV + c0 + 4); }
        g[ch][0] = *(const GAS f32x4*)(gn + c0); g[ch][1] = *(const GAS f32x4*)(gn + c0 + 4); }
    const int nrows = l == 0 ? MT : ML;
    for (int r = F.vcu * NWAVES + F.wave; r < nrows; r += nblk * NWAVES) {
        bool hp, hn; if (r < ML) { const int x = r & 63; hp = x > 0; hn = x < 63; } else { const int t = (r - ML) & 255; hp = t > 0; hn = t < 255; }
        const float mp = hp ? 1.f : 0.f, mn = hn ? 1.f : 0.f;
        const bf16* p0 = P + (size_t)r * (3 * DCONV); const bf16* pp = hp ? p0 - 3 * DCONV : p0; const bf16* pn = hn ? p0 + 3 * DCONV : p0;
        v4u raw[3][7];
#pragma unroll
        for (int ch = 0; ch < 3; ++ch) { const int c0 = ch * 512 + 8 * F.lane;
            raw[ch][0] = *(const GAS v4u*)(p0 + c0); raw[ch][1] = *(const GAS v4u*)(p0 + DCONV + c0); raw[ch][2] = *(const GAS v4u*)(p0 + 2 * DCONV + c0);
            raw[ch][3] = *(const GAS v4u*)(pp + DCONV + c0); raw[ch][4] = *(const GAS v4u*)(pp + 2 * DCONV + c0);
            raw[ch][5] = *(const GAS v4u*)(pn + DCONV + c0); raw[ch][6] = *(const GAS v4u*)(pn + 2 * DCONV + c0); }
#pragma unroll
        for (int ch = 0; ch < 3; ++ch) { const int c0 = ch * 512 + 8 * F.lane;
            f32x4 b0, b1, c0v, c1v, v0, v1, cp0, cp1, vp0, vp1, cn0, cn1, vn0, vn1;
            unpack8(raw[ch][0], b0, b1); unpack8(raw[ch][1], c0v, c1v); unpack8(raw[ch][2], v0, v1); unpack8(raw[ch][3], cp0, cp1); unpack8(raw[ch][4], vp0, vp1); unpack8(raw[ch][5], cn0, cn1); unpack8(raw[ch][6], vn0, vn1);
            const f32x4 y0 = b0 * (w[ch][0][0] * (mp * (cp0 * vp0)) + w[ch][1][0] * (c0v * v0) + w[ch][2][0] * (mn * (cn0 * vn0)));
            const f32x4 y1 = b1 * (w[ch][0][1] * (mp * (cp1 * vp1)) + w[ch][1][1] * (c1v * v1) + w[ch][2][1] * (mn * (cn1 * vn1)));
            float ss = (y0[0] * y0[0] + y0[1] * y0[1]) + (y0[2] * y0[2] + y0[3] * y0[3]) + (y1[0] * y1[0] + y1[1] * y1[1]) + (y1[2] * y1[2] + y1[3] * y1[3]);
            ss += __shfl_xor(ss, 1); ss += __shfl_xor(ss, 2); ss += __shfl_xor(ss, 4); ss += __shfl_xor(ss, 8);
            const float rs = 1.0f / sqrtf(ss * (1.0f / 128.0f) + EPS);
            const f32x4 o0 = y0 * rs * g[ch][0], o1 = y1 * rs * g[ch][1];
            v4u o; o.x = pk2(o0[0], o0[1]); o.y = pk2(o0[2], o0[3]); o.z = pk2(o1[0], o1[1]); o.w = pk2(o1[2], o1[3]);
            *(GAS v4u*)(cc + (size_t)r * DM + c0) = o; }
    }
}
__device__ __forceinline__ void phase_carry(Frame& F, int l) {
    const int gt = F.vcu * 512 + F.tid; if (gt >= NB * NG * 2 * SP) return;
    const int p = gt & 63, d = (gt >> 6) & 1, g = (gt >> 7) & 31, b = gt >> 12;
    const f32x2 lt = WSP(f32x2, WS_LT)[((l * NG + g) * 2 + d) * 64 + p];
    const float* Fb = WSP(float, WS_F); bf16* u2 = WSP(bf16, WS_U2);
    float hr = 0.f, hi = 0.f;
    for (int step = 0; step < 36; ++step) {
        int inst; if (step < 4) inst = 256 + b * 4 + (d == 0 ? step : 3 - step); else inst = b * 32 + (d == 0 ? step - 4 : 35 - step);
        const size_t row = (size_t)g * NINST + inst;
        u2[row * KS2 + 1024 + d * 128 + p] = (bf16)f2bf(hr); u2[row * KS2 + 1024 + d * 128 + 64 + p] = (bf16)f2bf(hi);
        const float fr = *(const GAS float*)(Fb + row * 256 + d * 128 + p), fi = *(const GAS float*)(Fb + row * 256 + d * 128 + 64 + p);
        const float nr = lt.x * hr - lt.y * hi + fr; hi = lt.x * hi + lt.y * hr + fi; hr = nr; }
}
template <int NJ>
__device__ __forceinline__ void topk_wave(Frame& F, const float* aff, int k, int srcrow0, int yrow0, int e, LAS unsigned* av) {
#pragma unroll 1
    for (int j = 0; j < NJ; ++j) av[j * 64 + F.lane] = __builtin_bit_cast(unsigned, *(const GAS float*)(aff + j * 64 + F.lane));
    LDS_WAIT();
    unsigned T = 0u;
#pragma unroll 1
    for (int bit = 30; bit >= 0; --bit) { const unsigned cand = T | (1u << bit); int cnt = 0;
#pragma unroll 4
        for (int j = 0; j < NJ; ++j) cnt += __popcll(__ballot(av[j * 64 + F.lane] >= cand));
        if (cnt >= k) T = cand; }
    int ngt = 0, neq = 0;
#pragma unroll 2
    for (int j = 0; j < NJ; ++j) { const unsigned a = av[j * 64 + F.lane]; ngt += (a > T) ? 1 : 0; neq += (a == T) ? 1 : 0; }
    const int packed = (ngt << 16) | neq; int incl = packed;
#pragma unroll
    for (int o = 1; o < 64; o <<= 1) { const int t = __shfl_up(incl, o); incl += (F.lane >= o) ? t : 0; }
    const int excl = incl - packed, pgt = excl >> 16, peq = excl & 0xffff;
    const int need = k - (__builtin_amdgcn_readlane(incl, 63) >> 16);
    int slot = pgt + (peq < need ? peq : need), eqr = peq;
    int* IDX = WSP(int, WS_IDX); float* VALS = WSP(float, WS_VALS); int* SEL = WSP(int, WS_SEL);
#pragma unroll 1
    for (int j = 0; j < NJ; ++j) { const unsigned a = av[j * 64 + F.lane]; const bool gt = a > T, eq = a == T; const bool sl = gt || (eq && eqr < need); eqr += eq ? 1 : 0;
        const int src = srcrow0 + j * 64 + F.lane;
        if (sl) { IDX[yrow0 + slot] = src; VALS[yrow0 + slot] = __builtin_bit_cast(float, a); }
        SEL[(size_t)src * NE + e] = sl ? yrow0 + slot : -1;
        slot += sl ? 1 : 0; }
}
__device__ __forceinline__ void phase_topk(Frame& F, int l) {
    const int ntask = l == 0 ? 256 : 128;
    LAS unsigned* av = (LAS unsigned*)(F.lds + F.wave * 8192);
    for (int task = F.wave * F.G + F.vcu; task < ntask; task += F.G * NWAVES) {
        const bool isctx = task >= 128; const int q = task & 127, b = q >> 4, e = q & 15;
        const int yrow0 = isctx ? NE * NB * CAPL + e * (NB * CAPC) + b * CAPC : (e * NB + b) * CAPL;
        if (isctx) topk_wave<4>(F, WSP(float, WS_AFFC) + (size_t)(b * NE + e) * CTXL, CAPC, ML + b * CTXL, yrow0, e, av);
        else topk_wave<32>(F, WSP(float, WS_AFF) + (size_t)(b * NE + e) * SEQL, CAPL, b * SEQL, yrow0, e, av);
    }
}
template <class T> __device__ __forceinline__ T* opaque_ptr(T* p) { unsigned long long v = (unsigned long long)p; unsigned lo = (unsigned)v, hi = (unsigned)(v >> 32); asm volatile("" : "+v"(lo), "+v"(hi));
    lo = __builtin_amdgcn_readfirstlane(lo); hi = __builtin_amdgcn_readfirstlane(hi); return (T*)(((unsigned long long)hi << 32) | lo); }
__device__ __forceinline__ void launder(Frame& F) { F.ws = opaque_ptr(F.ws); F.out = opaque_ptr(F.out);
    int t = F.tid; asm volatile("" : "+v"(t)); F.tid = t; F.lane = t & 63; F.wave = __builtin_amdgcn_readfirstlane(t >> 6);
    int g = gridDim.x, bx = blockIdx.x; asm volatile("" : "+v"(g), "+v"(bx)); g = __builtin_amdgcn_readfirstlane(g); bx = __builtin_amdgcn_readfirstlane(bx);
    F.G = g; F.vcu = (g % 8 == 0) ? (bx % 8) * (g / 8) + bx / 8 : bx; }
__device__ __forceinline__ void grid_seam(Frame& F) {
    XcdBarrier b; b.bar = (unsigned*)(F.ws + WS_CTL) + CW_BAR; b.x = xb_xcc_id(); b.st = (volatile LAS unsigned*)(F.lds + MISC_OFF) + 8;
    xcd_barrier(b);
}
constexpr int NPHASE = 24;
struct Args { const float* in[27]; float* out; unsigned char* ws; };
#define IN(k) (LO <= (k) && (k) < HI)
#ifndef PROBE_SUB
#define PROBE_SUB 0
#endif
#ifndef PROBE_MASK
#define PROBE_MASK 0u
#endif
#define PHASE(k) if constexpr (IN(k)) for (int rep_ = 0; rep_ < (((PROBE_MASK >> (k)) & 1u) ? 2 : 1); ++rep_)
#define SEAM(k) do { if constexpr (IN(k) && IN((k) + 1)) grid_seam(F); } while (0)
template <int LO, int HI, int l>
__device__ __forceinline__ void layer_phases(Frame& F) {
    constexpr int pb = 1 + 11 * l;
    PHASE(pb + 0) { launder(F); phase_norm1(F, l); }
    SEAM(pb + 0);
    PHASE(pb + 1) {
        launder(F);
        SchedProj S{(const char*)WSP(bf16, WS_H), (const char*)(WSP(bf16, WS_WIN) + (size_t)l * DINP * DM), F.G, F.vcu, l};
        EpiProj E{WSP(bf16, WS_R1), WSP(bf16, WS_U2)};
        pg8::gemm_phase<EpiProj, SchedProj, true>(F.lds, F.tid, pg8::Dims{DM * 2, DM * 2, DM * 2, nullptr}, S, E);
    }
    SEAM(pb + 1);
    PHASE(pb + 2) {
        launder(F);
        if (F.vcu < F.G - 64) phase_conv(F, l, F.G - 64);
        else { SchedF S{(const char*)WSP(bf16, WS_U2), (const char*)(WSP(bf16, WS_WF) + (size_t)l * NG * 256 * 1024), F.G, F.vcu};
            EpiF32 E{WSP(float, WS_F), 256, (size_t)NINST * 256};
            pg8::gemm_phase<EpiF32, SchedF, false>(F.lds, F.tid, pg8::Dims{KS2 * 2, 1024 * 2, 1024 * 2, nullptr}, S, E); }
    }
    SEAM(pb + 2);
    PHASE(pb + 3) { launder(F); phase_carry(F, l); }
    SEAM(pb + 3);
    PHASE(pb + 4) {
        launder(F);
        SchedS2 S{(const char*)WSP(bf16, WS_U2), (const char*)(WSP(bf16, WS_W2) + (size_t)l * NG * 1024 * KS2), F.G, F.vcu, l};
        EpiS2 E{WSP(bf16, WS_U2), F.in[I_SSMD] + (size_t)l * DSSM, WSP(bf16, WS_Z)};
        pg8::gemm_phase<EpiS2, SchedS2, true>(F.lds, F.tid, pg8::Dims{KS2 * 2, KS2 * 2, KS2 * 2, nullptr}, S, E);
    }
    SEAM(pb + 4);
    PHASE(pb + 5) {
        launder(F);
        SchedGlu S{(const char*)WSP(bf16, WS_Z), (const char*)(WSP(bf16, WS_WGLU) + (size_t)l * DSSM * DSSM), F.G, F.vcu, l == 0 ? 72 : 64};
        EpiGlu E{WSP(bf16, WS_Z), F.in[I_ONSG] + (size_t)l * DSSM, WSP(bf16, WS_R2)};
        if (F.G >= 144) pg8::gemm_phase<EpiGlu, SchedGlu, false>(F.lds, F.tid, pg8::Dims{DSSM * 2, DSSM * 2, DSSM * 2, nullptr}, S, E);
    }
    SEAM(pb + 5);
    PHASE(pb + 6) {
        launder(F);
        SchedOut S{(const char*)WSP(bf16, WS_R2), (const char*)(WSP(bf16, WS_WOUT) + (size_t)l * DM * DM), F.G, F.vcu, l == 0 ? 72 : 64};
        EpiOut<l == 1> E{l == 0 ? (const void*)F.in[I_X] : (const void*)WSP(bf16, WS_XL), l == 0 ? (const void*)F.in[I_CTX] : (const void*)(WSP(bf16, WS_XL) + (size_t)ML * DM), WSP(float, WS_MOD) + (size_t)l * 9 * 6 * DM, WSP(bf16, WS_XM)};
        pg8::gemm_phase<EpiOut<l == 1>, SchedOut, true>(F.lds, F.tid, pg8::Dims{DM * 2, DM * 2, DM * 2, nullptr}, S, E);
    }
    SEAM(pb + 6);
    PHASE(pb + 7) { launder(F); phase_norm2(F, l); }
    SEAM(pb + 7);
    PHASE(pb + 8) { launder(F); phase_topk(F, l); }
    SEAM(pb + 8);
    PHASE(pb + 9) {
        launder(F);
        SchedMoe S{(const char*)WSP(unsigned char, WS_H), (const char*)(WSP(unsigned char, WS_WGU) + (size_t)l * NE * 4096 * DM), F.G, F.vcu, 16, l, 1};
        EpiMoe1 E{WSP(unsigned char, WS_R2)};
        pg8::gemm_phase<EpiMoe1, SchedMoe, true, true, true>(F.lds, F.tid, pg8::Dims{DM, DM, DM, WSP(int, WS_IDX)}, S, E);
    }
    SEAM(pb + 9);
    PHASE(pb + 10) {
        launder(F);
        SchedMoe S{(const char*)WSP(unsigned char, WS_R2), (const char*)(WSP(unsigned char, WS_WDN) + (size_t)l * NE * DM * DF), F.G, F.vcu, 8, l, 0};
        EpiBf16 E{WSP(bf16, WS_R1), DM, 1.0f / (FP8_SW * FP8_SA)};
        pg8::gemm_phase<EpiBf16, SchedMoe, true, true>(F.lds, F.tid, pg8::Dims{DF, DF, DF, nullptr}, S, E);
    }
    SEAM(pb + 10);
}
template <int LO, int HI>
__global__ void __launch_bounds__(NWAVES * 64, 2) trunk_fwd(Args args) {
    extern __shared__ __attribute__((aligned(16))) unsigned char lds[];
    Frame F;
    F.lds = (LAS unsigned char*)lds;
    F.tid = threadIdx.x; F.lane = F.tid & 63; F.wave = __builtin_amdgcn_readfirstlane(F.tid >> 6);
    F.G = gridDim.x; { const int bx = blockIdx.x; F.vcu = (F.G % 8 == 0) ? (bx % 8) * (F.G / 8) + bx / 8 : bx; }
    F.ws = args.ws; F.out = args.out; F.in = args.in;
    for (int u = F.tid; u < (LDS_BYTES - LDSCTL_OFF) / 4; u += NWAVES * 64) ((LAS unsigned*)(F.lds + LDSCTL_OFF))[u] = 0u;
    __syncthreads();
    if constexpr (HI - LO > 1) (void)xcd_barrier_post((unsigned*)(F.ws + WS_CTL) + CW_BAR, (volatile LAS unsigned*)(F.lds + MISC_OFF) + 8);

    PHASE(0) {
        launder(F);
        for (int q_ = 0; q_ < ((PROBE_SUB & 1) ? 2 : 1); ++q_) if (F.vcu < 192) { for (int t = F.vcu; t < 192; t += 192) p0_mod_task(F, t); }
        for (int q_ = 0; q_ < ((PROBE_SUB & 2) ? 2 : 1); ++q_) if (F.vcu >= 192) { for (int t = F.vcu - 192; t < 64; t += F.G - 192) p0_s5_task(F, t); }
        p0_router_t(F);
        for (int q_ = 0; q_ < ((PROBE_SUB & 4) ? 2 : 1); ++q_) p0_convert_weights(F, 2 * rep_ + q_);
    }
    SEAM(0);
    layer_phases<LO, HI, 0>(F);
    layer_phases<LO, HI, 1>(F);
    PHASE(23) { launder(F); phase_final(F); }
}
#undef IN
#undef PHASE
#undef SEAM

template <int P> static void launch_phase(int grid, hipStream_t stream, const Args& a) {
    hipLaunchKernelGGL((trunk_fwd<P, P + 1>), dim3(grid), dim3(NWAVES * 64), LDS_BYTES, stream, a);
}
template <int P> static void set_attr_phase() { (void)hipFuncSetAttribute((const void*)trunk_fwd<P, P + 1>, hipFuncAttributeMaxDynamicSharedMemorySize, LDS_BYTES); }
template <int... Ps> static void launch_all(std::integer_sequence<int, Ps...>, int grid, hipStream_t stream, const Args& a) { (launch_phase<Ps>(grid, stream, a), ...); }
template <int... Ps> static void set_attr_all(std::integer_sequence<int, Ps...>) { (set_attr_phase<Ps>(), ...); }
extern "C" void kernel_launch(void* const* d_in, const int* in_sizes, int n_in, void* d_out, int out_size, void* d_ws, size_t ws_size, hipStream_t stream) {
    static int grid = 0;
    if (grid == 0) {
        if (n_in != 27 || out_size != ML * DM || ws_size < WS_END) { fprintf(stderr, "kernel_launch: expected 27 inputs, %d outputs, >= %zu workspace bytes; got %d, %d, %zu\n", ML * DM, (size_t)WS_END, n_in, out_size, ws_size); grid = -1; return; }
        int dev = 0, cus = 0, per_cu = 0;
        if (hipGetDevice(&dev) != hipSuccess || hipDeviceGetAttribute(&cus, hipDeviceAttributeMultiprocessorCount, dev) != hipSuccess) { grid = -1; return; }
#if MK_N_LAUNCHES == 1
        if (hipFuncSetAttribute((const void*)trunk_fwd<0, NPHASE>, hipFuncAttributeMaxDynamicSharedMemorySize, LDS_BYTES) != hipSuccess) { fprintf(stderr, "kernel_launch: hipFuncSetAttribute failed\n"); grid = -1; return; }
        if (hipOccupancyMaxActiveBlocksPerMultiprocessor(&per_cu, (const void*)trunk_fwd<0, NPHASE>, NWAVES * 64, LDS_BYTES) != hipSuccess || per_cu < 1) fprintf(stderr, "kernel_launch: occupancy query reports %d\n", per_cu);
#else
        set_attr_all(std::make_integer_sequence<int, NPHASE>{});
#endif
        (void)hipGetLastError();
        grid = cus;
        if (grid < 256 || grid % 8 != 0) { fprintf(stderr, "kernel_launch: unexpected CU count %d\n", cus); }
    }
    if (grid < 0) return;
    (void)hipMemsetAsync((char*)d_ws + WS_CTL, 0, CTL_ZERO_BYTES, stream);
    Args a{};
    for (int i = 0; i < 27; ++i) a.in[i] = (const float*)d_in[i];
    a.out = (float*)d_out; a.ws = (unsigned char*)d_ws;
#if MK_N_LAUNCHES == 1
    hipLaunchKernelGGL((trunk_fwd<0, NPHASE>), dim3(grid), dim3(NWAVES * 64), LDS_BYTES, stream, a);
#else
    launch_all(std::make_integer_sequence<int, NPHASE>{}, grid, stream, a);
#endif
    const hipError_t le = hipPeekAtLastError();
    if (le != hipSuccess) fprintf(stderr, "kernel_launch: launch failed: %s\n", hipGetErrorName(le));
}
```

```cpp
#include <hip/hip_runtime.h>
#include <cstdio>
#include <cstdint>
#include <utility>

#define GAS __attribute__((address_space(1)))
#define LAS __attribute__((address_space(3)))
typedef unsigned short bf16;
typedef unsigned v4u __attribute__((ext_vector_type(4)));
typedef unsigned v2u __attribute__((ext_vector_type(2)));
typedef float f32x4 __attribute__((ext_vector_type(4)));
typedef float f32x2 __attribute__((ext_vector_type(2)));
typedef short bf16x8 __attribute__((ext_vector_type(8)));
typedef GAS unsigned gu32;

#ifndef MK_N_LAUNCHES
#define MK_N_LAUNCHES 1
#endif

constexpr int NB = 8, SEQL = 2048, CTXL = 256, DM = 2048;
constexpr int ML = NB * SEQL, MC = NB * CTXL, MT = ML + MC;
constexpr int DCONV = 1536, DSSM = 512, DINP = 3 * DCONV + DSSM;
constexpr int NG = 32, SG = 16, SP = 64, TCH = 64;
constexpr int NE = 16, DF = 2048, CAPL = 256, CAPC = 32;
constexpr int NINST = 512, KS2 = 1280;
constexpr int YROWS = NE * NB * CAPL + NE * NB * CAPC;
constexpr float EPS = 1e-6f;

constexpr size_t MiB = 1u << 20;
constexpr size_t WS_CTL = 0, CTL_ZERO_BYTES = 1 * MiB;
constexpr size_t WS_MOD = 1 * MiB;
constexpr size_t WS_RWT = 2 * MiB;
constexpr size_t WS_LT = 2 * MiB + 512 * 1024;
constexpr size_t WS_AFF = 3 * MiB;
constexpr size_t WS_AFFC = 4 * MiB;
constexpr size_t WS_IDX = 5 * MiB;
constexpr size_t WS_VALS = 5 * MiB + 256 * 1024;
constexpr size_t WS_SEL = 6 * MiB;
constexpr size_t WS_WGLU = 8 * MiB;
constexpr size_t WS_WOUT = 9 * MiB;
constexpr size_t WS_WIN = 25 * MiB;
constexpr size_t WS_WF = 65 * MiB;
constexpr size_t WS_W2 = 97 * MiB;
constexpr size_t WS_WGU = 257 * MiB;
constexpr size_t WS_WDN = 769 * MiB;
constexpr size_t WS_XL = 1025 * MiB;
constexpr size_t WS_XM = 1169 * MiB;
constexpr size_t WS_H = 1313 * MiB;
constexpr size_t WS_F = 1385 * MiB;
constexpr size_t WS_R1 = 1401 * MiB;
constexpr size_t WS_R2 = 1563 * MiB;
constexpr size_t WS_U2 = WS_R2 + 72 * MiB;
constexpr size_t WS_Z = WS_R2 + 112 * MiB;
constexpr size_t WS_END = 1707 * MiB;
constexpr int CW_BAR = 4096;

constexpr int RING_BYTES = 131072;
constexpr int LDSCTL_OFF = RING_BYTES, MISC_OFF = LDSCTL_OFF + 320;
constexpr int LDS_BYTES = 147456;
constexpr int NWAVES = 8;

#define LDS_WAIT() asm volatile("s_waitcnt lgkmcnt(0)" ::: "memory")
#define VM_WAIT() asm volatile("s_waitcnt vmcnt(0)" ::: "memory")
__device__ __forceinline__ unsigned f2bf(float f) { unsigned u = __builtin_bit_cast(unsigned, f); return (u + 0x7fffu + ((u >> 16) & 1u)) >> 16; }
__device__ __forceinline__ unsigned pk2(float lo, float hi) { return f2bf(lo) | (f2bf(hi) << 16); }
__device__ __forceinline__ float bflo(unsigned w) { return __builtin_bit_cast(float, w << 16); }
__device__ __forceinline__ float bfhi(unsigned w) { return __builtin_bit_cast(float, w & 0xffff0000u); }
__device__ __forceinline__ float wave_sum(float v) {
#pragma unroll
    for (int o = 1; o < 64; o <<= 1) v += __shfl_xor(v, o);
    return v;
}
__device__ __forceinline__ float sigmoidf_(float x) { return 1.0f / (1.0f + __expf(-x)); }
__device__ __forceinline__ float gelu_tanh(float y) { const float a = 1.5957691216f * (y + 0.044715f * y * y * y); return y * sigmoidf_(a); }

#ifndef FP8_SCALE1
#define FP8_SCALE1 0x7f7f7f7f
#endif
namespace pg8 {
constexpr int BM = 256, BK = 64, HALF = 128, HTB = HALF * BK * 2, STAGE_BYTES = 8 * HTB;
__host__ __device__ __forceinline__ int lds_byte(int r, int c) { const int st = (r >> 4) * 2 + (c >> 5), rr = r & 15, cc = c & 31, ob = rr * 64 + cc * 2; return st * 1024 + (ob ^ (((ob >> 9) & 1) << 5)); }
__host__ __device__ __forceinline__ void stage_rc(int b, int& R, int& C) { const int st = b / 1024, sb = b % 1024, swz = sb ^ (((sb >> 9) & 1) << 5); R = (st >> 1) * 16 + swz / 64; C = (st & 1) * 32 + (swz % 64) / 2; }
__host__ __device__ __forceinline__ int perm32(int rho) { const int n = rho >> 4, i = rho & 15; return 8 * (i >> 2) + 4 * n + (i & 3); }
__device__ __forceinline__ unsigned cvt_pk_bf16(float lo, float hi) { unsigned r; asm volatile("v_cvt_pk_bf16_f32 %0, %1, %2" : "=v"(r) : "v"(lo), "v"(hi)); return r; }

struct Unit { const char* a; const char* b; int pm, pn, aux; };
struct Dims { int lda, ldb, K; const int* gidx; };
typedef int v4i_t __attribute__((ext_vector_type(4)));
typedef int v8i_t __attribute__((ext_vector_type(8)));
template <bool FP8> struct Frag { bf16x8 k[2]; };
template <> struct Frag<true> { v8i_t v; };

template <class Epi, class Sched, bool ALIGN_EPI, bool FP8 = false, bool GATHER = false>
__device__ __forceinline__ void gemm_phase(LAS unsigned char* lds, const int tid, const Dims g, const Sched& S, const Epi& E) {
    const int wid = __builtin_amdgcn_readfirstlane(tid >> 6), lane = tid & 63, wr = wid >> 2, wc = wid & 3, fr = lane & 15, fq = lane >> 4;
    const int nt = g.K / (BK * 2);
    unsigned voffA[2], voffB[2];
#pragma unroll
    for (int i = 0; i < 2; ++i) { int R, C; stage_rc(tid * 16 + i * 8192, R, C); const int Rb = Epi::PERM ? ((R & ~31) + perm32(R & 31)) : R;
        voffA[i] = (unsigned)(R * g.lda + C * 2); voffB[i] = (unsigned)(Rb * g.ldb + C * 2); }
    const size_t kstep = (size_t)(BK * 2);
    const size_t hstepA = (size_t)HALF * g.lda, hstepB = (size_t)HALF * g.ldb;
    const unsigned ldsw = (unsigned)wid * 1024u;
    const int aoff = lds_byte(wr * 64 + fr, fq * 8), boff = lds_byte(wc * 32 + fr, fq * 8);
#define PG8_SA(b, h) (((b) * 2 + (h)) * HTB)
#define PG8_SB(b, h) ((4 + (b) * 2 + (h)) * HTB)
#define PG8_STAGE(bufoff, gbase, voff) do { _Pragma("unroll") for (int _i = 0; _i < 2; ++_i) \
        __builtin_amdgcn_global_load_lds((const unsigned*)((const char*)(gbase) + (voff)[_i]), (LAS unsigned*)(lds + (bufoff) + ldsw + _i * 8192), 16, 0, 0); } while (0)
#define PG8_STAGE_A(bufoff, gbase, h, isnext) do { if constexpr (GATHER) { if (isnext) PG8_STAGE(bufoff, gbase, gAn[h]); else PG8_STAGE(bufoff, gbase, gA[h]); } \
        else PG8_STAGE(bufoff, (gbase) + ((h) ? hstepA : (size_t)0), voffA); } while (0)
#define PG8_GIDX(dst, u) do { _Pragma("unroll") for (int h_ = 0; h_ < 2; ++h_) _Pragma("unroll") for (int i_ = 0; i_ < 2; ++i_) { int R_, C_; stage_rc(tid * 16 + i_ * 8192, R_, C_); \
        dst[h_][i_] = (unsigned)(*(const GAS int*)(g.gidx + (u).pm * 256 + h_ * 128 + R_)) * (unsigned)g.lda + (unsigned)(C_ * 2); } } while (0)
#define PG8_LD1(dst, p) do { if constexpr (FP8) { const v4i_t lo_ = *(const LAS v4i_t*)(p), hi_ = *(const LAS v4i_t*)((p) + 1024); dst.v = __builtin_shufflevector(lo_, hi_, 0, 1, 2, 3, 4, 5, 6, 7); } \
        else { dst.k[0] = *(const LAS bf16x8*)(p); dst.k[1] = *(const LAS bf16x8*)((p) + 1024); } } while (0)
#define PG8_LDA(dst, b, h) do { _Pragma("unroll") for (int m = 0; m < 4; ++m) PG8_LD1(dst[m], lds + PG8_SA(b, h) + aoff + m * 2048); } while (0)
#define PG8_LDB(dst, b, h) do { _Pragma("unroll") for (int n = 0; n < 2; ++n) PG8_LD1(dst[n], lds + PG8_SB(b, h) + boff + n * 2048); } while (0)
#define PG8_MMA(ai, bj, At, Bt) do { __builtin_amdgcn_s_setprio(1); _Pragma("unroll") for (int m = 0; m < 4; ++m) _Pragma("unroll") for (int n = 0; n < 2; ++n) { \
        if constexpr (FP8) asm volatile("v_mfma_f32_16x16x128_f8f6f4 %0, %1, %2, %0" : "+v"(acc[ai][bj][m][n]) : "v"(Bt[n].v), "v"(At[m].v)); \
        else { _Pragma("unroll") for (int k = 0; k < 2; ++k) acc[ai][bj][m][n] = __builtin_amdgcn_mfma_f32_16x16x32_bf16(Bt[n].k[k], At[m].k[k], acc[ai][bj][m][n], 0, 0, 0); } } __builtin_amdgcn_s_setprio(0); } while (0)
#define PG8_WAIT_V(n) asm volatile("s_waitcnt vmcnt(" #n ")" ::: "memory")
#define PG8_WAIT_L(n) asm volatile("s_waitcnt lgkmcnt(" #n ")" ::: "memory")
#define PG8_BAR __builtin_amdgcn_s_barrier()
#define PG8_SCHED __builtin_amdgcn_sched_barrier(0)
    Unit cur, nxt; int ui = 0;
    if (!S.next(0, cur)) return;
    f32x4 acc[2][2][4][2];
#pragma unroll
    for (int a = 0; a < 2; ++a)
#pragma unroll
        for (int b = 0; b < 2; ++b)
#pragma unroll
            for (int m = 0; m < 4; ++m)
#pragma unroll
                for (int n = 0; n < 2; ++n) acc[a][b][m][n] = (f32x4){0.f, 0.f, 0.f, 0.f};
    Frag<FP8> At[4], B0[2], B1[2];
    const char* cA = cur.a; const char* cB = cur.b;
    unsigned gA[2][2], gAn[2][2];
    if constexpr (GATHER) { PG8_GIDX(gA, cur); _Pragma("unroll") for (int h_ = 0; h_ < 2; ++h_) _Pragma("unroll") for (int i_ = 0; i_ < 2; ++i_) gAn[h_][i_] = gA[h_][i_]; }
    PG8_STAGE(PG8_SB(0, 0), cB, voffB); PG8_STAGE(PG8_SB(0, 1), cB + hstepB, voffB); PG8_STAGE_A(PG8_SA(0, 0), cA, 0, false); PG8_STAGE_A(PG8_SA(0, 1), cA, 1, false);
    if (wr == 1) PG8_BAR;
    PG8_WAIT_V(2); PG8_BAR;
    PG8_STAGE(PG8_SB(1, 0), cB + kstep, voffB); PG8_STAGE_A(PG8_SA(1, 0), cA + kstep, 0, false); PG8_STAGE(PG8_SB(1, 1), cB + hstepB + kstep, voffB);
    PG8_WAIT_V(6); PG8_BAR;
    for (;;) {
        const bool has_next = S.next(ui + 1, nxt);
        const char* nA = has_next ? nxt.a : cA; const char* nB = has_next ? nxt.b : cB;
        for (int t = 0; t < nt; t += 2) {
            const bool last = (t == nt - 2);
            const char* a1 = cA + (size_t)(t + 1) * kstep;
            if constexpr (GATHER) { if (t == nt - 4 && has_next) PG8_GIDX(gAn, nxt); }
            const char* a2 = last ? nA : cA + (size_t)(t + 2) * kstep; const char* b2 = last ? nB : cB + (size_t)(t + 2) * kstep;
            const char* a3 = a2 + kstep; const char* b3 = b2 + kstep;
            PG8_LDB(B0, 0, 0); PG8_LDB(B1, 0, 1); PG8_SCHED; PG8_LDA(At, 0, 0); PG8_STAGE_A(PG8_SA(1, 1), a1, 1, false);
            PG8_WAIT_V(8); PG8_WAIT_L(0); PG8_BAR; PG8_MMA(0, 0, At, B0); PG8_MMA(0, 1, At, B1); PG8_BAR; PG8_SCHED;
            PG8_LDA(At, 0, 1); PG8_STAGE(PG8_SB(0, 0), b2, voffB); PG8_STAGE(PG8_SB(0, 1), b2 + hstepB, voffB); PG8_STAGE_A(PG8_SA(0, 0), a2, 0, last);
            PG8_WAIT_V(8); PG8_WAIT_L(0); PG8_BAR; PG8_MMA(1, 0, At, B0); PG8_MMA(1, 1, At, B1); PG8_BAR; PG8_SCHED;
            PG8_LDB(B0, 1, 0); PG8_LDB(B1, 1, 1); PG8_SCHED; PG8_LDA(At, 1, 0); PG8_STAGE_A(PG8_SA(0, 1), a2, 1, last);
            PG8_WAIT_V(8); PG8_WAIT_L(0); PG8_BAR; PG8_MMA(0, 0, At, B0); PG8_MMA(0, 1, At, B1); PG8_BAR; PG8_SCHED;
            PG8_LDA(At, 1, 1); PG8_STAGE(PG8_SB(1, 0), b3, voffB); PG8_STAGE(PG8_SB(1, 1), b3 + hstepB, voffB); PG8_STAGE_A(PG8_SA(1, 0), a3, 0, last);
            PG8_WAIT_V(8); PG8_WAIT_L(0); PG8_BAR; PG8_MMA(1, 0, At, B0); PG8_MMA(1, 1, At, B1); PG8_BAR; PG8_SCHED;
        }
        if constexpr (FP8) asm volatile("s_nop 15\n\ts_nop 7" ::: "memory");
        if constexpr (ALIGN_EPI) { if (wr == 0) PG8_BAR; }
        if constexpr (!Epi::AFTER_DRAIN) { E(acc, cur, wr, wc, fr, fq); }
        if (!has_next) break;
#pragma unroll
        for (int a = 0; a < 2; ++a)
#pragma unroll
            for (int b = 0; b < 2; ++b)
#pragma unroll
                for (int m = 0; m < 4; ++m)
#pragma unroll
                    for (int n = 0; n < 2; ++n) acc[a][b][m][n] = (f32x4){0.f, 0.f, 0.f, 0.f};
        cur = nxt; cA = nA; cB = nB; ++ui;
        if constexpr (GATHER) { _Pragma("unroll") for (int h_ = 0; h_ < 2; ++h_) _Pragma("unroll") for (int i_ = 0; i_ < 2; ++i_) gA[h_][i_] = gAn[h_][i_]; }
        if constexpr (ALIGN_EPI) { if (wr == 1) PG8_BAR; }
    }
    PG8_WAIT_V(0);
    if constexpr (!ALIGN_EPI) { if (wr == 0) PG8_BAR; }
    PG8_BAR;
    if constexpr (Epi::AFTER_DRAIN) { E.fused(acc, cur, wr, wc, fr, fq, lds, wid, lane); }
#undef PG8_SA
#undef PG8_SB
#undef PG8_STAGE
#undef PG8_STAGE_A
#undef PG8_GIDX
#undef PG8_LDA
#undef PG8_LDB
#undef PG8_MMA
#undef PG8_LD1
#undef PG8_WAIT_V
#undef PG8_WAIT_L
#undef PG8_BAR
#undef PG8_SCHED
}
}

#define XB_TMO      128
#define XB_XCNT(j)  (256  + 64 * (j))
#define XB_XSUB(j)  (1280 + 64 * (j))
#define XB_XGEN(j)  (2304 + 64 * (j))
#define XB_TOP      3328
#define XB_TOPGEN   3392
#define XCD_BAR_WORDS 3456
#define XB_SPIN_CAP (1u << 18)

__device__ __forceinline__ unsigned xb_ld(unsigned* p)              { return __hip_atomic_load(p, __ATOMIC_RELAXED, __HIP_MEMORY_SCOPE_AGENT); }
__device__ __forceinline__ unsigned xb_add(unsigned* p, unsigned v) { return __hip_atomic_fetch_add(p, v, __ATOMIC_RELAXED, __HIP_MEMORY_SCOPE_AGENT); }
__device__ __forceinline__ unsigned xb_xcc_id() { return (unsigned)__builtin_amdgcn_s_getreg((3 << 11) | 20) & 0xFu; }
#define XB_SPIN(cond, bar) do { unsigned _sp = 0; while (cond) { __builtin_amdgcn_s_sleep(1); \
    if ((++_sp & 255u) == 0u) { if (xb_ld(&(bar)[XB_TMO])) break; if (_sp > XB_SPIN_CAP) { atomicAdd(&(bar)[XB_TMO], 1u); break; } } } } while (0)

struct XcdBarrier {
    unsigned* bar; unsigned x;
    volatile LAS unsigned* st;
};
__device__ __forceinline__ XcdBarrier xcd_barrier_post(unsigned* bar, volatile LAS unsigned* st) {
    XcdBarrier b; b.bar = bar; b.x = xb_xcc_id(); b.st = st;
    if (threadIdx.x == 0) (void)xb_add(&bar[XB_XCNT(b.x)], 1u);
    return b;
}
__device__ __forceinline__ void xcd_barrier_complete(unsigned* bar, unsigned x, unsigned& nloc, unsigned& nx) {
    const unsigned G = gridDim.x * gridDim.y * gridDim.z;
    unsigned sum, cnt, mine, sp = 0u;
    for (;;) {
        sum = 0u; cnt = 0u; mine = 0u;
#pragma unroll
        for (unsigned j = 0; j < 16; ++j) { const unsigned c = xb_ld(&bar[XB_XCNT(j)]); sum += c; cnt += (c > 0u) ? 1u : 0u; mine = (j == x) ? c : mine; }
        if (sum == G) break;
        __builtin_amdgcn_s_sleep(1);
        if ((++sp & 255u) == 0u) { if (xb_ld(&bar[XB_TMO])) break; if (sp > XB_SPIN_CAP) { atomicAdd(&bar[XB_TMO], 1u); break; } }
    }
    nloc = mine > 0u ? mine : 1u; nx = cnt > 0u ? cnt : 1u;
}
__device__ __forceinline__ void xcd_barrier(const XcdBarrier& b) {
    asm volatile("s_waitcnt vmcnt(0)" ::: "memory");
    __syncthreads();
    if (threadIdx.x == 0) {
        unsigned* bar = b.bar;
        __builtin_amdgcn_s_waitcnt(0);
        unsigned nloc = b.st[0], nx = b.st[1];
        if (nloc == 0u) { xcd_barrier_complete(bar, b.x, nloc, nx); b.st[0] = nloc; b.st[1] = nx; }
        const unsigned old = xb_add(&bar[XB_XSUB(b.x)], 1u);
        const unsigned gen = old / nloc;
        if (old + 1u == (gen + 1u) * nloc) {
            __builtin_amdgcn_fence(__ATOMIC_RELEASE, "agent");
            asm volatile("s_waitcnt vmcnt(0)" ::: "memory");
            const unsigned og = xb_add(&bar[XB_TOP], 1u);
            const unsigned tg = og / nx;
            if (og + 1u == (tg + 1u) * nx) xb_add(&bar[XB_TOPGEN], 1u);
            else XB_SPIN(xb_ld(&bar[XB_TOPGEN]) == tg, bar);
            __builtin_amdgcn_fence(__ATOMIC_ACQUIRE, "agent");
            xb_add(&bar[XB_XGEN(b.x)], 1u);
            asm volatile("s_waitcnt vmcnt(0)" ::: "memory");
        } else {
            XB_SPIN(xb_ld(&bar[XB_XGEN(b.x)]) == gen, bar);
            __builtin_amdgcn_fence(__ATOMIC_ACQUIRE, "agent");
            asm volatile("s_waitcnt vmcnt(0)" ::: "memory");
        }
    }
    __syncthreads();
}

struct Frame {
    LAS unsigned char* lds;
    int tid, lane, wave, vcu, G;
    unsigned char* ws;
    const float* const* in;
    float* out;
};
#define WSP(T, off) ((T*)(F.ws + (off)))
enum InIdx { I_X = 0, I_C, I_CTX, I_CCTX, I_ADAW, I_ADAB, I_N1G, I_WIN, I_CONVW, I_LRE, I_LIM, I_LDT, I_BRE, I_BIM, I_CRE, I_CIM, I_SSMD, I_WGLU, I_ONCG, I_ONSG, I_WOUT, I_N2G, I_RW, I_WG, I_WU, I_WD, I_FNG };

using pg8::Unit;
struct EpiProj {
    static constexpr bool PERM = true, AFTER_DRAIN = false;
    bf16* proj; bf16* u2;
    __device__ __forceinline__ void operator()(const f32x4 (&acc)[2][2][4][2], const Unit& u, int wr, int wc, int fr, int fq) const {
        const int row0 = u.pm * 256 + wr * 64 + fr, col0 = u.pn * 256 + wc * 32 + 8 * fq;
#pragma unroll
        for (int ai = 0; ai < 2; ++ai)
#pragma unroll
            for (int m = 0; m < 4; ++m) { const int row = row0 + ai * 128 + m * 16;
#pragma unroll
                for (int bj = 0; bj < 2; ++bj) { const f32x4 v0 = acc[ai][bj][m][0], v1 = acc[ai][bj][m][1]; const int col = col0 + bj * 128;
                    v4u w; w.x = pg8::cvt_pk_bf16(v0[0], v0[1]); w.y = pg8::cvt_pk_bf16(v0[2], v0[3]); w.z = pg8::cvt_pk_bf16(v1[0], v1[1]); w.w = pg8::cvt_pk_bf16(v1[2], v1[3]);
                    bf16* dst;
                    if (u.pn < 18) dst = proj + (size_t)row * (3 * DCONV) + col;
                    else { const int cc = col - 3 * DCONV, g = cc >> 4, i0 = cc & 15; dst = u2 + ((size_t)(g * NINST + (row >> 6)) * KS2 + (row & 63) * 16 + i0); }
                    *(GAS v4u*)dst = w; } }
    }
};
struct EpiF32 {
    static constexpr bool PERM = false, AFTER_DRAIN = false;
    float* C; int ldc; size_t cstride;
    __device__ __forceinline__ void operator()(const f32x4 (&acc)[2][2][4][2], const Unit& u, int wr, int wc, int fr, int fq) const {
        float* base = C + (size_t)u.aux * cstride; const int row0 = u.pm * 256 + wr * 64 + fr, col0 = u.pn * 256 + wc * 32 + 4 * fq;
#pragma unroll
        for (int ai = 0; ai < 2; ++ai)
#pragma unroll
            for (int m = 0; m < 4; ++m) { float* rowp = base + (size_t)(row0 + ai * 128 + m * 16) * ldc + col0;
#pragma unroll
                for (int bj = 0; bj < 2; ++bj)
#pragma unroll
                    for (int n = 0; n < 2; ++n) *(GAS f32x4*)(rowp + bj * 128 + n * 16) = acc[ai][bj][m][n]; }
    }
};
struct EpiS2 {
    static constexpr bool PERM = true, AFTER_DRAIN = false;
    const bf16* u2; const float* dsk; bf16* z;
    __device__ __forceinline__ void operator()(const f32x4 (&acc)[2][2][4][2], const Unit& u, int wr, int wc, int fr, int fq) const {
        const int g = u.aux, inst0 = u.pm * 256 + wr * 64 + fr, c0 = u.pn * 256 + wc * 32 + 8 * fq;
#pragma unroll
        for (int bj = 0; bj < 2; ++bj) { const int cidx = c0 + bj * 128, t = cidx >> 4, o0 = cidx & 15;
            const f32x4 d0 = *(const GAS f32x4*)(dsk + g * 16 + o0), d1 = *(const GAS f32x4*)(dsk + g * 16 + o0 + 4);
#pragma unroll
            for (int ai = 0; ai < 2; ++ai)
#pragma unroll
                for (int m = 0; m < 4; ++m) { const int inst = inst0 + ai * 128 + m * 16;
                    if (inst < MT / 64) {
                        const v4u uu = *(const GAS v4u*)(u2 + ((size_t)(g * NINST + inst) * KS2 + cidx));
                        const f32x4 a0 = acc[ai][bj][m][0], a1 = acc[ai][bj][m][1];
                        const float y0 = a0[0] + d0[0] * bflo(uu.x), y1 = a0[1] + d0[1] * bfhi(uu.x), y2 = a0[2] + d0[2] * bflo(uu.y), y3 = a0[3] + d0[3] * bfhi(uu.y);
                        const float y4 = a1[0] + d1[0] * bflo(uu.z), y5 = a1[1] + d1[1] * bfhi(uu.z), y6 = a1[2] + d1[2] * bflo(uu.w), y7 = a1[3] + d1[3] * bfhi(uu.w);
                        v4u w; w.x = pg8::cvt_pk_bf16(gelu_tanh(y0), gelu_tanh(y1)); w.y = pg8::cvt_pk_bf16(gelu_tanh(y2), gelu_tanh(y3));
                        w.z = pg8::cvt_pk_bf16(gelu_tanh(y4), gelu_tanh(y5)); w.w = pg8::cvt_pk_bf16(gelu_tanh(y6), gelu_tanh(y7));
                        *(GAS v4u*)(z + ((size_t)(inst * 64 + t) * DSSM + g * 16 + o0)) = w; } } }
    }
};
struct EpiGlu {
    static constexpr bool PERM = true, AFTER_DRAIN = true;
    const bf16* z; const float* gain; bf16* concat;
    __device__ __forceinline__ void operator()(const f32x4 (&)[2][2][4][2], const Unit&, int, int, int, int) const {}
    __device__ __forceinline__ void fused(f32x4 (&acc)[2][2][4][2], const Unit& u, int wr, int wc, int fr, int fq, LAS unsigned char* lds, int wid, int lane) const {
        LAS float* P = (LAS float*)lds;
        const int row0 = u.pm * 256 + wr * 64 + fr, col0 = u.pn * 256 + wc * 32 + 8 * fq;
#pragma unroll
        for (int ai = 0; ai < 2; ++ai)
#pragma unroll
            for (int m = 0; m < 4; ++m) { const int row = row0 + ai * 128 + m * 16, rt = ai * 128 + wr * 64 + m * 16 + fr;
#pragma unroll
                for (int bj = 0; bj < 2; ++bj) { const v4u zz = *(const GAS v4u*)(z + (size_t)row * DSSM + col0 + bj * 128);
                    f32x4 a0 = acc[ai][bj][m][0], a1 = acc[ai][bj][m][1];
                    a0[0] = bflo(zz.x) * sigmoidf_(a0[0]); a0[1] = bfhi(zz.x) * sigmoidf_(a0[1]); a0[2] = bflo(zz.y) * sigmoidf_(a0[2]); a0[3] = bfhi(zz.y) * sigmoidf_(a0[3]);
                    a1[0] = bflo(zz.z) * sigmoidf_(a1[0]); a1[1] = bfhi(zz.z) * sigmoidf_(a1[1]); a1[2] = bflo(zz.w) * sigmoidf_(a1[2]); a1[3] = bfhi(zz.w) * sigmoidf_(a1[3]);
                    acc[ai][bj][m][0] = a0; acc[ai][bj][m][1] = a1;
                    float s = (a0[0] * a0[0] + a0[1] * a0[1]) + (a0[2] * a0[2] + a0[3] * a0[3]) + (a1[0] * a1[0] + a1[1] * a1[1]) + (a1[2] * a1[2] + a1[3] * a1[3]);
                    s += __shfl_xor(s, 16); s += __shfl_xor(s, 32);
                    if (fq == 0) P[(rt * 2 + bj) * 4 + wc] = s; } }
        LDS_WAIT(); __builtin_amdgcn_s_barrier(); asm volatile("" ::: "memory");
#pragma unroll
        for (int bj = 0; bj < 2; ++bj) { const int col = col0 + bj * 128;
            const f32x4 g0 = *(const GAS f32x4*)(gain + col), g1 = *(const GAS f32x4*)(gain + col + 4);
#pragma unroll
            for (int ai = 0; ai < 2; ++ai)
#pragma unroll
                for (int m = 0; m < 4; ++m) { const int row = row0 + ai * 128 + m * 16, rt = ai * 128 + wr * 64 + m * 16 + fr;
                    const f32x4 p = *(const LAS f32x4*)(P + (rt * 2 + bj) * 4);
                    const float rs = 1.0f / sqrtf(((p[0] + p[1]) + (p[2] + p[3])) * (1.0f / 128.0f) + EPS);
                    const f32x4 a0 = acc[ai][bj][m][0] * rs * g0, a1 = acc[ai][bj][m][1] * rs * g1;
                    v4u w; w.x = pg8::cvt_pk_bf16(a0[0], a0[1]); w.y = pg8::cvt_pk_bf16(a0[2], a0[3]); w.z = pg8::cvt_pk_bf16(a1[0], a1[1]); w.w = pg8::cvt_pk_bf16(a1[2], a1[3]);
                    *(GAS v4u*)(concat + (size_t)row * DM + DCONV + col) = w; } }
    }
};
template <bool XBF16> struct EpiOut {
    static constexpr bool PERM = true, AFTER_DRAIN = false;
    const void* xlat; const void* xctx; const float* mod; bf16* xm;
    __device__ __forceinline__ void operator()(const f32x4 (&acc)[2][2][4][2], const Unit& u, int wr, int wc, int fr, int fq) const {
        const int rb = u.pm < 64 ? (u.pm >> 3) : 8; const float* g1 = mod + (size_t)(rb * 6 + 2) * DM;
        const size_t rowoff = u.pm < 64 ? (size_t)u.pm * 256 * DM : (size_t)(u.pm - 64) * 256 * DM; const void* xbase = u.pm < 64 ? xlat : xctx;
        bf16* xo = xm + (size_t)u.pm * 256 * DM;
        const int r0 = wr * 64 + fr, col0 = u.pn * 256 + wc * 32 + 8 * fq;
        f32x4 gv[2][2];
#pragma unroll
        for (int bj = 0; bj < 2; ++bj)
#pragma unroll
            for (int n = 0; n < 2; ++n) gv[bj][n] = *(const GAS f32x4*)(g1 + col0 + bj * 128 + n * 4);
#pragma unroll
        for (int am = 0; am < 4; ++am) { const int ai = am >> 1, m0 = (am & 1) * 2; f32x4 xv[2][2][2];
#pragma unroll
            for (int mm = 0; mm < 2; ++mm) { const size_t off = rowoff + (size_t)(r0 + ai * 128 + (m0 + mm) * 16) * DM + col0;
#pragma unroll
                for (int bj = 0; bj < 2; ++bj) {
                    if constexpr (XBF16) { const v4u w = *(const GAS v4u*)((const bf16*)xbase + off + bj * 128); xv[mm][bj][0] = (f32x4){bflo(w.x), bfhi(w.x), bflo(w.y), bfhi(w.y)}; xv[mm][bj][1] = (f32x4){bflo(w.z), bfhi(w.z), bflo(w.w), bfhi(w.w)}; }
                    else { xv[mm][bj][0] = *(const GAS f32x4*)((const float*)xbase + off + bj * 128); xv[mm][bj][1] = *(const GAS f32x4*)((const float*)xbase + off + bj * 128 + 4); } } }
#pragma unroll
            for (int mm = 0; mm < 2; ++mm) { const int m = m0 + mm; const size_t off = (size_t)(r0 + ai * 128 + m * 16) * DM + col0;
#pragma unroll
                for (int bj = 0; bj < 2; ++bj) { const f32x4 o0 = xv[mm][bj][0] + gv[bj][0] * acc[ai][bj][m][0], o1 = xv[mm][bj][1] + gv[bj][1] * acc[ai][bj][m][1];
                    v4u w; w.x = pg8::cvt_pk_bf16(o0[0], o0[1]); w.y = pg8::cvt_pk_bf16(o0[2], o0[3]); w.z = pg8::cvt_pk_bf16(o1[0], o1[1]); w.w = pg8::cvt_pk_bf16(o1[2], o1[3]);
                    *(GAS v4u*)(xo + off + bj * 128) = w; } }
            asm volatile("" ::: "memory"); }
    }
};
constexpr float FP8_SW = 64.f, FP8_SH = 16.f, FP8_SA = 8.f;
__device__ __forceinline__ unsigned pk4_fp8(float a, float b, float c, float d) {
    a = __builtin_amdgcn_fmed3f(a, -448.f, 448.f); b = __builtin_amdgcn_fmed3f(b, -448.f, 448.f); c = __builtin_amdgcn_fmed3f(c, -448.f, 448.f); d = __builtin_amdgcn_fmed3f(d, -448.f, 448.f);
    unsigned w = (unsigned)__builtin_amdgcn_cvt_pk_fp8_f32(a, b, 0, false); return (unsigned)__builtin_amdgcn_cvt_pk_fp8_f32(c, d, (int)w, true); }
struct EpiMoe1 {
    static constexpr bool PERM = true, AFTER_DRAIN = false;
    unsigned char* act;
    __device__ __forceinline__ void operator()(const f32x4 (&acc)[2][2][4][2], const Unit& u, int wr, int wc, int fr, int fq) const {
        const int row0 = u.pm * 256 + wr * 64 + fr, f0 = u.pn * 128 + wc * 32 + 8 * fq; constexpr float sg = 1.0f / (FP8_SW * FP8_SH);
#pragma unroll
        for (int ai = 0; ai < 2; ++ai)
#pragma unroll
            for (int m = 0; m < 4; ++m) { const f32x4 g0 = acc[ai][0][m][0] * sg, g1 = acc[ai][0][m][1] * sg, u0 = acc[ai][1][m][0] * (sg * FP8_SA), u1 = acc[ai][1][m][1] * (sg * FP8_SA);
                float r[8];
#pragma unroll
                for (int j = 0; j < 4; ++j) { r[j] = g0[j] * sigmoidf_(g0[j]) * u0[j]; r[4 + j] = g1[j] * sigmoidf_(g1[j]) * u1[j]; }
                v2u w; w.x = pk4_fp8(r[0], r[1], r[2], r[3]); w.y = pk4_fp8(r[4], r[5], r[6], r[7]);
                *(GAS v2u*)(act + (size_t)(row0 + ai * 128 + m * 16) * DF + f0) = w; }
    }
};
constexpr float FP8_SY = 16.f;
struct EpiY8 {
    static constexpr bool PERM = true, AFTER_DRAIN = false;
    unsigned char* O; float scale;
    __device__ __forceinline__ void operator()(const f32x4 (&acc)[2][2][4][2], const Unit& u, int wr, int wc, int fr, int fq) const {
        const int row0 = u.pm * 256 + wr * 64 + fr, col0 = u.pn * 256 + wc * 32 + 8 * fq;
#pragma unroll
        for (int ai = 0; ai < 2; ++ai)
#pragma unroll
            for (int m = 0; m < 4; ++m) { unsigned char* rowp = O + (size_t)(row0 + ai * 128 + m * 16) * DM + col0;
#pragma unroll
                for (int bj = 0; bj < 2; ++bj) { const f32x4 v0 = acc[ai][bj][m][0] * scale, v1 = acc[ai][bj][m][1] * scale;
                    v2u w; w.x = pk4_fp8(v0[0], v0[1], v0[2], v0[3]); w.y = pk4_fp8(v1[0], v1[1], v1[2], v1[3]);
                    *(GAS v2u*)(rowp + bj * 128) = w; } }
    }
};

struct SchedProj {
    const char* A; const char* B; int G, c, layer;
    __device__ __forceinline__ bool next(int i, Unit& u) const {
        const int L = i * G + c; int rt, ct;
        if (layer == 0) { if (L >= 1440) return false; rt = (L / 160) * 8 + (L & 7); ct = (L % 160) >> 3; }
        else { if (L >= 1296) return false; if (L < 1280) { rt = (L / 160) * 8 + (L & 7); ct = (L % 160) >> 3; } else { const int j = L - 1280; rt = 64 + (j & 7); ct = 18 + (j >> 3); } }
        u.pm = rt; u.pn = ct; u.aux = 0; u.a = A + (size_t)rt * 256 * DM * 2; u.b = B + (size_t)ct * 256 * DM * 2; return true; }
};
struct SchedF {
    const char* A; const char* B; int G, c;
    __device__ __forceinline__ bool next(int i, Unit& u) const {
        const int j = c - (G - 64); if (i != 0 || j < 0) return false;
        const int g = j >> 1, rt = j & 1; u.pm = rt; u.pn = 0; u.aux = g; u.a = A + (size_t)(g * NINST + rt * 256) * KS2 * 2; u.b = B + (size_t)g * 256 * 1024 * 2; return true; }
};
struct SchedS2 {
    const char* A; const char* B; int G, c, layer;
    __device__ __forceinline__ bool next(int i, Unit& u) const {
        const int L = i * G + c; int g, rt, ct;
        if (layer == 0) { if (L >= 256) return false; g = L >> 3; rt = (L >> 2) & 1; ct = L & 3; } else { if (L >= 128) return false; g = L >> 2; rt = 0; ct = L & 3; }
        u.pm = rt; u.pn = ct; u.aux = g; u.a = A + (size_t)(g * NINST + rt * 256) * KS2 * 2; u.b = B + (size_t)(g * 1024 + ct * 256) * KS2 * 2; return true; }
};
struct SchedGlu {
    const char* A; const char* B; int G, c, nrt;
    __device__ __forceinline__ bool next(int i, Unit& u) const {
        const int L = i * G + c; if (L >= nrt * 2) return false;
        u.pm = L >> 1; u.pn = L & 1; u.aux = 0; u.a = A + (size_t)u.pm * 256 * DSSM * 2; u.b = B + (size_t)u.pn * 256 * DSSM * 2; return true; }
};
struct SchedOut {
    const char* A; const char* B; int G, c, nrt;
    __device__ __forceinline__ bool next(int i, Unit& u) const {
        const int L = i * G + c; if (L >= nrt * 8) return false;
        u.pm = (L >> 6) * 8 + (L & 7); u.pn = (L & 63) >> 3; u.aux = 0; u.a = A + (size_t)u.pm * 256 * DM * 2; u.b = B + (size_t)u.pn * 256 * DM * 2; return true; }
};
struct SchedMoe {
    const char* A; const char* B; int G, c, nct, layer, gather;
    __device__ __forceinline__ bool next(int i, Unit& u) const {
        const int L = i * G + c, per = 8 * nct, nlat = NE * per; int e, rtile, ct;
        if (L < nlat) { e = L / per; const int w = L % per; ct = (w >> 5) * 4 + (w & 3); rtile = e * 8 + ((w & 31) >> 2); }
        else { const int j = L - nlat; if (layer != 0 || j >= NE * nct) return false; e = j / nct; ct = j % nct; rtile = NE * 8 + e; }
        u.pm = rtile; u.pn = ct; u.aux = e; u.a = gather ? A : A + (size_t)rtile * 256 * 2048; u.b = B + ((size_t)e * nct + ct) * 256 * 2048; return true; }
};

struct CvtItem { const float* src; unsigned char* dst; int N, ldwt, fp8; };
__device__ __forceinline__ void cvt_decode(Frame& F, long it, CvtItem& d) {
    constexpr long I_EXP = 32 * 64;
    constexpr long N_GATE = 2L * NE * I_EXP, N_WIN = 2L * 32 * 160, N_WOUT = 2L * I_EXP;
    long r = it;
    if (r < 2 * N_GATE) {
        const int kind = r >= N_GATE; if (kind) r -= N_GATE;
        const int le = (int)(r / I_EXP), q = (int)(r % I_EXP), kb = q >> 6, n0 = (q & 63) * 32;
        d.src = F.in[kind ? I_WU : I_WG] + (size_t)le * DM * DF + (size_t)(kb * 64) * DF + n0; d.N = DF; d.ldwt = DM; d.fp8 = 1;
        d.dst = WSP(unsigned char, WS_WGU) + ((size_t)le * 4096 + (n0 >> 7) * 256 + kind * 128 + (n0 & 127)) * DM + kb * 64; return; }
    r -= 2 * N_GATE;
    if (r < N_GATE) { const int le = (int)(r / I_EXP), q = (int)(r % I_EXP), kb = q >> 6, n0 = (q & 63) * 32;
        d.src = F.in[I_WD] + (size_t)le * DF * DM + (size_t)(kb * 64) * DM + n0; d.N = DM; d.ldwt = DF; d.fp8 = 1;
        d.dst = WSP(unsigned char, WS_WDN) + ((size_t)le * DM + n0) * DF + kb * 64; return; }
    r -= N_GATE; d.fp8 = 0;
    if (r < N_WIN) { const int l = (int)(r / (32 * 160)), q = (int)(r % (32 * 160)), kb = q / 160, n0 = (q % 160) * 32;
        d.src = F.in[I_WIN] + (size_t)l * DM * DINP + (size_t)(kb * 64) * DINP + n0; d.N = DINP; d.ldwt = DM * 2;
        d.dst = (unsigned char*)(WSP(bf16, WS_WIN) + ((size_t)l * DINP + n0) * DM + kb * 64); return; }
    r -= N_WIN;
    if (r < N_WOUT) { const int l = (int)(r / I_EXP), q = (int)(r % I_EXP), kb = q >> 6, n0 = (q & 63) * 32;
        d.src = F.in[I_WOUT] + (size_t)l * DM * DM + (size_t)(kb * 64) * DM + n0; d.N = DM; d.ldwt = DM * 2;
        d.dst = (unsigned char*)(WSP(bf16, WS_WOUT) + ((size_t)l * DM + n0) * DM + kb * 64); return; }
    r -= N_WOUT;
    { const int l = (int)(r / 128), q = (int)(r % 128), kb = q >> 4, n0 = (q & 15) * 32;
        d.src = F.in[I_WGLU] + (size_t)l * DSSM * DSSM + (size_t)(kb * 64) * DSSM + n0; d.N = DSSM; d.ldwt = DSSM * 2;
        d.dst = (unsigned char*)(WSP(bf16, WS_WGLU) + ((size_t)l * DSSM + n0) * DSSM + kb * 64); }
}
__device__ __forceinline__ void cvt_load(const CvtItem& d, int lane, float (&t)[32]) {
    const float* src = d.src + (size_t)(lane >> 5) * d.N + (lane & 31);
#pragma unroll
    for (int i = 0; i < 32; ++i) t[i] = *(const GAS float*)(src + (size_t)(2 * i) * d.N);
}
template <bool FP8>
__device__ __forceinline__ void cvt_store(const CvtItem& d, LAS float* scr, int lane, const float (&t)[32]) {
    constexpr float sc = FP8 ? FP8_SW : 1.0f;
#pragma unroll
    for (int i = 0; i < 32; ++i) scr[(2 * i + (lane >> 5)) * 33 + (lane & 31)] = t[i] * sc;
    LDS_WAIT(); asm volatile("" ::: "memory");
    const int c = lane & 7;
#pragma unroll
    for (int j = 0; j < 4; ++j) { const int n = (lane >> 3) + 8 * j; const LAS float* s = scr + (8 * c) * 33 + n;
        const float v0 = s[0 * 33], v1 = s[1 * 33], v2 = s[2 * 33], v3 = s[3 * 33], v4 = s[4 * 33], v5 = s[5 * 33], v6 = s[6 * 33], v7 = s[7 * 33];
        if constexpr (FP8) { v2u o; o.x = pk4_fp8(v0, v1, v2, v3); o.y = pk4_fp8(v4, v5, v6, v7); *(GAS v2u*)(d.dst + (size_t)n * d.ldwt + 8 * c) = o; }
        else { v4u o; o.x = pk2(v0, v1); o.y = pk2(v2, v3); o.z = pk2(v4, v5); o.w = pk2(v6, v7); *(GAS v4u*)(d.dst + (size_t)n * d.ldwt + 16 * c) = o; } }
    LDS_WAIT(); asm volatile("" ::: "memory");
}
constexpr long CVT_NFP8 = 3L * (2L * NE * 2048), CVT_NITEMS = CVT_NFP8 + 2L * 32 * 160 + 2L * 2048 + 2L * 128;
constexpr unsigned CVT_CHUNK = 8;
struct CvtQ { unsigned next, left; };
__device__ __forceinline__ long cvt_pull(Frame& F, CvtQ& q, unsigned* ctr, long lo, long hi) {
    if (q.left == 0u) { unsigned b = 0u; if (F.lane == 0) b = __hip_atomic_fetch_add(ctr, CVT_CHUNK, __ATOMIC_RELAXED, __HIP_MEMORY_SCOPE_AGENT);
        q.next = (unsigned)__builtin_amdgcn_readfirstlane((int)b); q.left = CVT_CHUNK; }
    const long it = lo + (long)q.next; ++q.next; --q.left; return it < hi ? it : -1;
}
template <bool FP8>
__device__ __forceinline__ void cvt_run(Frame& F, LAS float* scr, int rep) {
    unsigned* ctr = (unsigned*)(F.ws + WS_CTL) + (FP8 ? 64 : 128) + 256 * rep;     const long lo = FP8 ? 0 : CVT_NFP8, hi = FP8 ? CVT_NFP8 : CVT_NITEMS;
    CvtItem A, B; float ta[32], tb[32]; CvtQ q{0u, 0u};
    long ia = cvt_pull(F, q, ctr, lo, hi);
    if (ia < 0) return;
    cvt_decode(F, ia, A); cvt_load(A, F.lane, ta);
    for (;;) {
        long ib = cvt_pull(F, q, ctr, lo, hi); const bool vb = ib >= 0; ib = vb ? ib : ia;
        cvt_decode(F, ib, B); cvt_load(B, F.lane, tb);
        cvt_store<FP8>(A, scr, F.lane, ta);
        if (!vb) break;
        ia = cvt_pull(F, q, ctr, lo, hi); const bool va = ia >= 0; ia = va ? ia : ib;
        cvt_decode(F, ia, A); cvt_load(A, F.lane, ta);
        cvt_store<FP8>(B, scr, F.lane, tb);
        if (!va) break;
    }
}
constexpr int CVT_NTILES = 96 * 128;
struct CvtTile { const float* src; unsigned char* dst; int kind, n0; };
__device__ __forceinline__ void cvt_tile_decode(Frame& F, int T, CvtTile& d) {
    const int m = T >> 7, q = T & 127, kt = q >> 3, nt = q & 7, kind = m >> 5, le = m & 31;
    d.kind = kind; d.n0 = nt * 256;
    d.src = F.in[kind == 0 ? I_WG : (kind == 1 ? I_WU : I_WD)] + (size_t)le * DM * DF + (size_t)(kt * 128) * 2048 + nt * 256;
    d.dst = (kind < 2 ? WSP(unsigned char, WS_WGU) + (size_t)le * 4096 * DM : WSP(unsigned char, WS_WDN) + (size_t)le * DM * DF) + kt * 128;
}
__device__ __forceinline__ void cvt_tile_load(const CvtTile& d, int wave, int lane, f32x4 (&v)[16]) {
#pragma unroll
    for (int i = 0; i < 4; ++i)
#pragma unroll
        for (int r = 0; r < 4; ++r) v[4 * i + r] = *(const GAS f32x4*)(d.src + (size_t)(4 * (wave + 8 * i) + r) * 2048 + 4 * lane);
}
__device__ __forceinline__ void cvt_tile_put(LAS unsigned char* buf, int wave, int lane, const f32x4 (&v)[16]) {
#pragma unroll
    for (int i = 0; i < 4; ++i) { const int kq = wave + 8 * i; unsigned d[4];
#pragma unroll
        for (int r = 0; r < 4; ++r) { const f32x4 x = v[4 * i + r] * FP8_SW; d[r] = pk4_fp8(x[0], x[1], x[2], x[3]); }
        const unsigned t01l = __builtin_amdgcn_perm(d[1], d[0], 0x05010400u), t01h = __builtin_amdgcn_perm(d[1], d[0], 0x07030602u);
        const unsigned t23l = __builtin_amdgcn_perm(d[3], d[2], 0x05010400u), t23h = __builtin_amdgcn_perm(d[3], d[2], 0x07030602u);
        unsigned o[4]; o[0] = __builtin_amdgcn_perm(t23l, t01l, 0x05040100u); o[1] = __builtin_amdgcn_perm(t23l, t01l, 0x07060302u);
        o[2] = __builtin_amdgcn_perm(t23h, t01h, 0x05040100u); o[3] = __builtin_amdgcn_perm(t23h, t01h, 0x07060302u);
        const int goff = ((((kq >> 2) ^ (lane & 7)) << 4) + ((kq & 3) << 2));
#pragma unroll
        for (int j = 0; j < 4; ++j) *(LAS unsigned*)(buf + (4 * lane + j) * 128 + goff) = o[j]; }
}
__device__ __forceinline__ void cvt_tile_get(const CvtTile& d, const LAS unsigned char* buf, int tid) {
#pragma unroll
    for (int i = 0; i < 4; ++i) { const int q = tid + 512 * i, n = q >> 3, c = q & 7, f = d.n0 + n;
        const v4u w = *(const LAS v4u*)(buf + n * 128 + ((c ^ ((n >> 2) & 7)) << 4));
        const int row = d.kind < 2 ? ((f >> 7) * 256 + d.kind * 128 + (f & 127)) : f;
        *(GAS v4u*)(d.dst + (size_t)row * 2048 + c * 16) = w; }
}
__device__ __forceinline__ void cvt_tiles(Frame& F, int rep) {
    unsigned* ctr = (unsigned*)(F.ws + WS_CTL) + 64 + 256 * rep;
    volatile LAS int* slot = (volatile LAS int*)(F.lds + MISC_OFF) + 16;
    LAS unsigned char* buf0 = F.lds; LAS unsigned char* buf1 = F.lds + 32768;
    if (F.tid == 0) { slot[0] = (int)__hip_atomic_fetch_add(ctr, 1u, __ATOMIC_RELAXED, __HIP_MEMORY_SCOPE_AGENT); slot[1] = (int)__hip_atomic_fetch_add(ctr, 1u, __ATOMIC_RELAXED, __HIP_MEMORY_SCOPE_AGENT); }
    __syncthreads();
    int ia = slot[0];
    if (ia >= CVT_NTILES) { __syncthreads(); return; }
    CvtTile A, B; f32x4 va[16], vb[16];
    cvt_tile_decode(F, ia, A); cvt_tile_load(A, F.wave, F.lane, va);
    for (int it = 0;; it += 2) {
        int ib = slot[(it + 1) & 3]; const bool vbv = ib < CVT_NTILES; ib = vbv ? ib : ia;
        if (F.tid == 0) slot[(it + 2) & 3] = (int)__hip_atomic_fetch_add(ctr, 1u, __ATOMIC_RELAXED, __HIP_MEMORY_SCOPE_AGENT);
        cvt_tile_decode(F, ib, B); cvt_tile_load(B, F.wave, F.lane, vb);
        cvt_tile_put(buf0, F.wave, F.lane, va);
        LDS_WAIT(); __syncthreads();
        cvt_tile_get(A, buf0, F.tid);
        if (!vbv) break;
        ia = slot[(it + 2) & 3]; const bool vav = ia < CVT_NTILES; ia = vav ? ia : ib;
        if (F.tid == 0) slot[(it + 3) & 3] = (int)__hip_atomic_fetch_add(ctr, 1u, __ATOMIC_RELAXED, __HIP_MEMORY_SCOPE_AGENT);
        cvt_tile_decode(F, ia, A); cvt_tile_load(A, F.wave, F.lane, va);
        cvt_tile_put(buf1, F.wave, F.lane, vb);
        LDS_WAIT(); __syncthreads();
        cvt_tile_get(B, buf1, F.tid);
        if (!vav) break;
    }
    LDS_WAIT(); __syncthreads();
}
__device__ __forceinline__ void p0_convert_weights(Frame& F, int rep) {
    cvt_tiles(F, rep);
    LAS float* scr = (LAS float*)(F.lds + F.wave * 16384);
    cvt_run<false>(F, scr, rep);
    __syncthreads();
}
__device__ __forceinline__ void p0_mod_task(Frame& F, int task) {
    const int l = task / 96, n0 = (task % 96) * 128;
    LAS float* sc = (LAS float*)F.lds;
    LAS float* red = (LAS float*)(F.lds + 9 * 2048 * 4);
    for (int i = F.tid; i < 9 * DM; i += 512) { const int r = i >> 11, k = i & 2047; const float v = r < 8 ? F.in[I_C][r * DM + k] : F.in[I_CCTX][k]; sc[i] = v * sigmoidf_(v); }
    __syncthreads();
    const float* W = F.in[I_ADAW] + (size_t)l * DM * 6 * DM + n0 + 2 * F.lane;
    float acc[9][2];
#pragma unroll
    for (int r = 0; r < 9; ++r) { acc[r][0] = 0.f; acc[r][1] = 0.f; }
    const int kbase = F.wave * 256;
#pragma unroll 8
    for (int kk = 0; kk < 256; ++kk) { const int k = kbase + kk; const f32x2 w = *(const GAS f32x2*)(W + (size_t)k * (6 * DM));
#pragma unroll
        for (int r = 0; r < 9; ++r) { const float s = sc[r * DM + k]; acc[r][0] += s * w.x; acc[r][1] += s * w.y; } }
#pragma unroll
    for (int r = 0; r < 9; ++r) { red[(F.wave * 9 + r) * 128 + 2 * F.lane] = acc[r][0]; red[(F.wave * 9 + r) * 128 + 2 * F.lane + 1] = acc[r][1]; }
    __syncthreads();
    float* mod = WSP(float, WS_MOD) + (size_t)l * 9 * 6 * DM;
    for (int i = F.tid; i < 9 * 128; i += 512) { const int r = i >> 7, n = i & 127; float s = F.in[I_ADAB][(size_t)l * 6 * DM + n0 + n];
#pragma unroll
        for (int w = 0; w < 8; ++w) s += red[(w * 9 + r) * 128 + n];
        mod[(size_t)r * 6 * DM + n0 + n] = s; }
    __syncthreads();
}
__device__ __forceinline__ void p0_s5_task(Frame& F, int task) {
    const int l = task >> 5, g = task & 31;
    LAS f32x2* PW = (LAS f32x2*)F.lds;
    LAS f32x2* BB = (LAS f32x2*)(F.lds + 33280);
    LAS f32x2* CC = (LAS f32x2*)(F.lds + 41472);
    LAS float* KD = (LAS float*)(F.lds + 49664);
    LAS bf16* KT = (LAS bf16*)(F.lds + 50688);
    bf16* WF = WSP(bf16, WS_WF) + (size_t)(l * NG + g) * 256 * 1024;
    bf16* W2 = WSP(bf16, WS_W2) + (size_t)(l * NG + g) * 1024 * KS2;
    for (int d = 0; d < 2; ++d) {
        const int ldg = (l * 2 + d) * NG + g;
        if (F.tid < 64) { const int p = F.tid;
            const double lr = (double)F.in[I_LRE][ldg * SP + p], li = (double)F.in[I_LIM][ldg * SP + p], dt = exp((double)F.in[I_LDT][ldg]);
            const double mag = exp(lr * dt), ar = mag * cos(li * dt), ai = mag * sin(li * dt), den = lr * lr + li * li, nr = ar - 1.0;
            const double kr = (nr * lr + ai * li) / den, ki = (ai * lr - nr * li) / den;
            double pr = 1.0, pi = 0.0;
            for (int e = 0; e <= 64; ++e) { PW[e * 64 + p] = (f32x2){(float)pr, (float)pi}; const double t = pr * ar - pi * ai; pi = pr * ai + pi * ar; pr = t; }
            if (true) { const f32x2 lt = PW[64 * 64 + p]; WSP(f32x2, WS_LT)[((l * NG + g) * 2 + d) * 64 + p] = lt; }
            for (int i = 0; i < SG; ++i) { const double br = (double)F.in[I_BRE][((size_t)ldg * SP + p) * SG + i], bi = (double)F.in[I_BIM][((size_t)ldg * SP + p) * SG + i];
                BB[p * 16 + i] = (f32x2){(float)(kr * br - ki * bi), (float)(kr * bi + ki * br)}; } }
        for (int i = F.tid; i < 1024; i += 512) CC[i] = (f32x2){F.in[I_CRE][(size_t)ldg * 1024 + i], F.in[I_CIM][(size_t)ldg * 1024 + i]};
        __syncthreads();
        { const int ph = F.tid & 1, q = F.tid >> 1, o = q >> 4, i = q & 15;
            float cbr[32], cbi[32];
#pragma unroll
            for (int p = 0; p < 32; ++p) { const f32x2 c = CC[o * 64 + ph * 32 + p], b = BB[(ph * 32 + p) * 16 + i]; cbr[p] = c.x * b.x - c.y * b.y; cbi[p] = c.x * b.y + c.y * b.x; }
#pragma unroll 1
            for (int j = 0; j < 64; ++j) { float s = 0.f;
#pragma unroll
                for (int p = 0; p < 32; p += 2) { const f32x4 P = *(const LAS f32x4*)(PW + j * 64 + ph * 32 + p); s += (cbr[p] * P[0] - cbi[p] * P[1]) + (cbr[p + 1] * P[2] - cbi[p + 1] * P[3]); }
                s += __shfl_xor(s, 1);
                if (ph == 0) { if (j == 0) { if (d == 0) KD[q] = s; else { s += KD[q]; KT[q] = (bf16)f2bf(s); } }
                               else KT[(d * 64 + j) * 256 + q] = (bf16)f2bf(s); } } }
        for (int it = F.tid; it < 128 * 128; it += 512) { const int n = it >> 7, k8 = it & 127, ri = n >> 6, p = n & 63, s = k8 >> 1, i0 = (k8 & 1) * 8, e = d == 0 ? 63 - s : s;
            const f32x2 P = PW[e * 64 + p]; float v[8];
#pragma unroll
            for (int j = 0; j < 8; ++j) { const f32x2 b = BB[p * 16 + i0 + j]; v[j] = ri == 0 ? (P.x * b.x - P.y * b.y) : (P.x * b.y + P.y * b.x); }
            v4u o; o.x = pk2(v[0], v[1]); o.y = pk2(v[2], v[3]); o.z = pk2(v[4], v[5]); o.w = pk2(v[6], v[7]);
            *(GAS v4u*)(WF + (size_t)(d * 128 + n) * 1024 + k8 * 8) = o; }
        for (int it = F.tid; it < 1024 * 16; it += 512) { const int n = it >> 4, c8 = it & 15, ri = c8 >> 3, p0 = (c8 & 7) * 8, t = n >> 4, o = n & 15, e = d == 0 ? t + 1 : 64 - t; float v[8];
#pragma unroll
            for (int j = 0; j < 8; ++j) { const f32x2 c = CC[o * 64 + p0 + j], P = PW[e * 64 + p0 + j]; v[j] = ri == 0 ? (c.x * P.x - c.y * P.y) : -(c.x * P.y + c.y * P.x); }
            v4u ov; ov.x = pk2(v[0], v[1]); ov.y = pk2(v[2], v[3]); ov.z = pk2(v[4], v[5]); ov.w = pk2(v[6], v[7]);
            *(GAS v4u*)(W2 + (size_t)n * KS2 + 1024 + d * 128 + c8 * 8) = ov; }
        __syncthreads();
    }
    for (int it = F.tid; it < 1024 * 128; it += 512) { const int n = it >> 7, k8 = it & 127, t = n >> 4, o = n & 15, s = k8 >> 1, i0 = (k8 & 1) * 8;
        const int dsel = s <= t ? 0 : 1, j = s <= t ? t - s : s - t;
        const v4u kv = *(const LAS v4u*)(KT + (dsel * 64 + j) * 256 + o * 16 + i0);
        *(GAS v4u*)(W2 + (size_t)n * KS2 + k8 * 8) = kv; }
    __syncthreads();
}
__device__ __forceinline__ void p0_router_t(Frame& F) {
    for (int i = (F.vcu * 512 + F.tid); i < 2 * 16 * DM; i += F.G * 512) { const int l = i >> 15, e = (i >> 11) & 15, k = i & 2047; WSP(float, WS_RWT)[i] = F.in[I_RW][((size_t)l * DM + k) * NE + e]; }
}

__device__ __forceinline__ int mbcnt64(unsigned long long m) { return (int)__builtin_amdgcn_mbcnt_hi((unsigned)(m >> 32), __builtin_amdgcn_mbcnt_lo((unsigned)m, 0u)); }
__device__ __forceinline__ void combine_row(Frame& F, int r, const float* g2, f32x4 (&x)[8]) {
    const int* sel = WSP(int, WS_SEL) + (size_t)r * NE; const float* vals = WSP(float, WS_VALS); const unsigned char* Y = WSP(unsigned char, WS_R1);
    const int mysel = F.lane < NE ? *(const GAS int*)(sel + F.lane) : -1;
    unsigned long long m = __ballot(mysel >= 0);
    f32x4 macc[8];
#pragma unroll
    for (int j = 0; j < 8; ++j) macc[j] = (f32x4){0.f, 0.f, 0.f, 0.f};
    while (m) { const int e = __builtin_ctzll(m); m &= m - 1;
        const int y = __builtin_amdgcn_readlane(mysel, e); const float val = *(const GAS float*)(vals + y) * (1.0f / FP8_SY); const unsigned char* yr = Y + (size_t)y * DM + 4 * F.lane;
#pragma unroll
        for (int j = 0; j < 8; ++j) { const unsigned w = *(const GAS unsigned*)(yr + j * 256); const f32x2 lo = __builtin_amdgcn_cvt_pk_f32_fp8((int)w, false), hi = __builtin_amdgcn_cvt_pk_f32_fp8((int)w, true);
            macc[j] += val * (f32x4){lo.x, lo.y, hi.x, hi.y}; } }
#pragma unroll
    for (int j = 0; j < 8; ++j) x[j] += *(const GAS f32x4*)(g2 + j * 256 + 4 * F.lane) * macc[j];
}
__device__ __forceinline__ f32x4 ld_bf4(const bf16* p) { const v2u w = *(const GAS v2u*)p; return (f32x4){bflo(w.x), bfhi(w.x), bflo(w.y), bfhi(w.y)}; }
__device__ __forceinline__ float row_rs(const f32x4 (&x)[8]) {
    float s = 0.f;
#pragma unroll
    for (int j = 0; j < 8; ++j) s += (x[j][0] * x[j][0] + x[j][1] * x[j][1]) + (x[j][2] * x[j][2] + x[j][3] * x[j][3]);
    return 1.0f / sqrtf(wave_sum(s) * (1.0f / DM) + EPS);
}
__device__ __forceinline__ void phase_norm1(Frame& F, int l) {
    const float* modl = WSP(float, WS_MOD) + (size_t)l * 9 * 6 * DM; const float* gn = F.in[I_N1G] + (size_t)l * DM;
    for (int r = F.vcu * NWAVES + F.wave; r < MT; r += F.G * NWAVES) {
        const int rb = r < ML ? (r >> 11) : 8;
        f32x4 x[8];
        if (l == 0) { const float* xr = r < ML ? F.in[I_X] + (size_t)r * DM : F.in[I_CTX] + (size_t)(r - ML) * DM;
#pragma unroll
            for (int j = 0; j < 8; ++j) x[j] = *(const GAS f32x4*)(xr + j * 256 + 4 * F.lane); }
        else { const bf16* xr = WSP(bf16, WS_XM) + (size_t)r * DM;
#pragma unroll
            for (int j = 0; j < 8; ++j) x[j] = ld_bf4(xr + j * 256 + 4 * F.lane); }
        if (l == 1) { combine_row(F, r, WSP(float, WS_MOD) + (size_t)(rb * 6 + 5) * DM, x);
            bf16* xo = WSP(bf16, WS_XL) + (size_t)r * DM;
#pragma unroll
            for (int j = 0; j < 8; ++j) { v2u w; w.x = pk2(x[j][0], x[j][1]); w.y = pk2(x[j][2], x[j][3]); *(GAS v2u*)(xo + j * 256 + 4 * F.lane) = w; } }
        const float rs = row_rs(x); const float* sh = modl + (size_t)(rb * 6 + 0) * DM; const float* sc = modl + (size_t)(rb * 6 + 1) * DM;
        bf16* ho = WSP(bf16, WS_H) + (size_t)r * DM;
#pragma unroll
        for (int j = 0; j < 8; ++j) { const int c = j * 256 + 4 * F.lane; const f32x4 g = *(const GAS f32x4*)(gn + c), s1 = *(const GAS f32x4*)(sc + c), s0 = *(const GAS f32x4*)(sh + c);
            const f32x4 h = x[j] * rs * g * (1.0f + s1) + s0; v2u w; w.x = pk2(h[0], h[1]); w.y = pk2(h[2], h[3]); *(GAS v2u*)(ho + c) = w; }
    }
}
__device__ __forceinline__ void phase_final(Frame& F) {
    const float* gn = F.in[I_FNG];
    for (int r = F.vcu * NWAVES + F.wave; r < ML; r += F.G * NWAVES) {
        const int rb = r >> 11; const bf16* xr = WSP(bf16, WS_XM) + (size_t)r * DM;
        f32x4 x[8];
#pragma unroll
        for (int j = 0; j < 8; ++j) x[j] = ld_bf4(xr + j * 256 + 4 * F.lane);
        combine_row(F, r, WSP(float, WS_MOD) + (size_t)((9 + rb) * 6 + 5) * DM, x);
        const float rs = row_rs(x); float* o = F.out + (size_t)r * DM;
#pragma unroll
        for (int j = 0; j < 8; ++j) { const int c = j * 256 + 4 * F.lane; *(GAS f32x4*)(o + c) = x[j] * rs * *(const GAS f32x4*)(gn + c); }
    }
}
__device__ __forceinline__ void phase_norm2(Frame& F, int l) {
    LAS float* rwt = (LAS float*)F.lds;
    { const float* src = WSP(float, WS_RWT) + (size_t)l * NE * DM;
        for (int i = F.tid; i < NE * DM / 4; i += 512) *(LAS f32x4*)(rwt + 4 * i) = *(const GAS f32x4*)(src + 4 * i); }
    __syncthreads();
    const float* modl = WSP(float, WS_MOD) + (size_t)l * 9 * 6 * DM; const float* gn = F.in[I_N2G] + (size_t)l * DM;
    const int nrows = l == 0 ? MT : ML;
    for (int r = F.vcu * NWAVES + F.wave; r < nrows; r += F.G * NWAVES) {
        const int rb = r < ML ? (r >> 11) : 8; const bf16* xr = WSP(bf16, WS_XM) + (size_t)r * DM;
        f32x4 x[8];
#pragma unroll
        for (int j = 0; j < 8; ++j) x[j] = ld_bf4(xr + j * 256 + 4 * F.lane);
        const float rs = row_rs(x); const float* sh = modl + (size_t)(rb * 6 + 3) * DM; const float* sc = modl + (size_t)(rb * 6 + 4) * DM;
        unsigned char* ho = WSP(unsigned char, WS_H) + (size_t)r * DM;
#pragma unroll
        for (int j = 0; j < 8; ++j) { const int c = j * 256 + 4 * F.lane; const f32x4 g = *(const GAS f32x4*)(gn + c), s1 = *(const GAS f32x4*)(sc + c), s0 = *(const GAS f32x4*)(sh + c);
            x[j] = x[j] * rs * g * (1.0f + s1) + s0; *(GAS unsigned*)(ho + c) = pk4_fp8(x[j][0] * FP8_SH, x[j][1] * FP8_SH, x[j][2] * FP8_SH, x[j][3] * FP8_SH); }
        float p[NE];
#pragma unroll
        for (int eg = 0; eg < NE; eg += 2) { float s0 = 0.f, s1 = 0.f;
#pragma unroll
            for (int j = 0; j < 8; ++j) { const f32x4 w0 = *(const LAS f32x4*)(rwt + eg * DM + j * 256 + 4 * F.lane), w1 = *(const LAS f32x4*)(rwt + (eg + 1) * DM + j * 256 + 4 * F.lane);
                s0 += (x[j][0] * w0[0] + x[j][1] * w0[1]) + (x[j][2] * w0[2] + x[j][3] * w0[3]); s1 += (x[j][0] * w1[0] + x[j][1] * w1[1]) + (x[j][2] * w1[2] + x[j][3] * w1[3]); }
            p[eg] = s0; p[eg + 1] = s1; __builtin_amdgcn_sched_barrier(0); }
        const bool b5 = (F.lane & 32) != 0, b4 = (F.lane & 16) != 0, b3 = (F.lane & 8) != 0, b2 = (F.lane & 4) != 0;
        float q8[8], q4[4], q2[2];
#pragma unroll
        for (int i = 0; i < 8; ++i) { const float keep = b5 ? p[i + 8] : p[i], give = b5 ? p[i] : p[i + 8]; q8[i] = keep + __shfl_xor(give, 32); }
#pragma unroll
        for (int i = 0; i < 4; ++i) { const float keep = b4 ? q8[i + 4] : q8[i], give = b4 ? q8[i] : q8[i + 4]; q4[i] = keep + __shfl_xor(give, 16); }
#pragma unroll
        for (int i = 0; i < 2; ++i) { const float keep = b3 ? q4[i + 2] : q4[i], give = b3 ? q4[i] : q4[i + 2]; q2[i] = keep + __shfl_xor(give, 8); }
        float lg; { const float keep = b2 ? q2[1] : q2[0], give = b2 ? q2[0] : q2[1]; lg = keep + __shfl_xor(give, 4); }
        lg += __shfl_xor(lg, 2); lg += __shfl_xor(lg, 1);
        float mx = lg;
        mx = fmaxf(mx, __shfl_xor(mx, 4)); mx = fmaxf(mx, __shfl_xor(mx, 8)); mx = fmaxf(mx, __shfl_xor(mx, 16)); mx = fmaxf(mx, __shfl_xor(mx, 32));
        const float ex = __expf(lg - mx); float den = ex;
        den += __shfl_xor(den, 4); den += __shfl_xor(den, 8); den += __shfl_xor(den, 16); den += __shfl_xor(den, 32);
        const float mine = ex / den; const int ex_id = (F.lane >> 2) & 15;
        if ((F.lane & 3) == 0) { if (r < ML) WSP(float, WS_AFF)[((size_t)(rb * NE + ex_id) << 11) + (r & 2047)] = mine;
                                 else { const int q = r - ML; WSP(float, WS_AFFC)[((size_t)((q >> 8) * NE + ex_id) << 8) + (q & 255)] = mine; } }
    }
    __syncthreads();
}
__device__ __forceinline__ void unpack8(const v4u w, f32x4& lo, f32x4& hi) { lo = (f32x4){bflo(w.x), bfhi(w.x), bflo(w.y), bfhi(w.y)}; hi = (f32x4){bflo(w.z), bfhi(w.z), bflo(w.w), bfhi(w.w)}; }
__device__ __forceinline__ void phase_conv(Frame& F, int l, int nblk) {
    const bf16* P = WSP(bf16, WS_R1); bf16* cc = WSP(bf16, WS_R2);
    const float* cw = F.in[I_CONVW] + (size_t)l * 3 * DCONV; const float* gn = F.in[I_ONCG] + (size_t)l * DCONV;
    f32x4 w[3][3][2], g[3][2];
#pragma unroll
    for (int ch = 0; ch < 3; ++ch) { const int c0 = ch * 512 + 8 * F.lane;
#pragma unroll
        for (int t = 0; t < 3; ++t) { w[ch][t][0] = *(const GAS f32x4*)(cw + t * DCONV + c0); w[ch][t][1] = *(const GAS f32x4*)(cw + t * DCONV + c0 + 4); }
        g[ch][0] = *(const GAS f32x4*)(gn + c0); g[ch][1] = *(const GAS f32x4*)(gn + c0 + 4); }
    const int nrows = l == 0 ? MT : ML;
    for (int r = F.vcu * NWAVES + F.wave; r < nrows; r += nblk * NWAVES) {
        bool hp, hn; if (r < ML) { const int x = r & 63; hp = x > 0; hn = x < 63; } else { const int t = (r - ML) & 255; hp = t > 0; hn = t < 255; }
        const float mp = hp ? 1.f : 0.f, mn = hn ? 1.f : 0.f;
        const bf16* p0 = P + (size_t)r * (3 * DCONV); const bf16* pp = hp ? p0 - 3 * DCONV : p0; const bf16* pn = hn ? p0 + 3 * DCONV : p0;
        v4u raw[3][7];
#pragma unroll
        for (int ch = 0; ch < 3; ++ch) { const int c0 = ch * 512 + 8 * F.lane;
            raw[ch][0] = *(const GAS v4u*)(p0 + c0); raw[ch][1] = *(const GAS v4u*)(p0 + DCONV + c0); raw[ch][2] = *(const GAS v4u*)(p0 + 2 * DCONV + c0);
            raw[ch][3] = *(const GAS v4u*)(pp + DCONV + c0); raw[ch][4] = *(const GAS v4u*)(pp + 2 * DCONV + c0);
            raw[ch][5] = *(const GAS v4u*)(pn + DCONV + c0); raw[ch][6] = *(const GAS v4u*)(pn + 2 * DCONV + c0); }
#pragma unroll
        for (int ch = 0; ch < 3; ++ch) { const int c0 = ch * 512 + 8 * F.lane;
            f32x4 b0, b1, c0v, c1v, v0, v1, cp0, cp1, vp0, vp1, cn0, cn1, vn0, vn1;
            unpack8(raw[ch][0], b0, b1); unpack8(raw[ch][1], c0v, c1v); unpack8(raw[ch][2], v0, v1); unpack8(raw[ch][3], cp0, cp1); unpack8(raw[ch][4], vp0, vp1); unpack8(raw[ch][5], cn0, cn1); unpack8(raw[ch][6], vn0, vn1);
            const f32x4 y0 = b0 * (w[ch][0][0] * (mp * (cp0 * vp0)) + w[ch][1][0] * (c0v * v0) + w[ch][2][0] * (mn * (cn0 * vn0)));
            const f32x4 y1 = b1 * (w[ch][0][1] * (mp * (cp1 * vp1)) + w[ch][1][1] * (c1v * v1) + w[ch][2][1] * (mn * (cn1 * vn1)));
            float ss = (y0[0] * y0[0] + y0[1] * y0[1]) + (y0[2] * y0[2] + y0[3] * y0[3]) + (y1[0] * y1[0] + y1[1] * y1[1]) + (y1[2] * y1[2] + y1[3] * y1[3]);
            ss += __shfl_xor(ss, 1); ss += __shfl_xor(ss, 2); ss += __shfl_xor(ss, 4); ss += __shfl_xor(ss, 8);
            const float rs = 1.0f / sqrtf(ss * (1.0f / 128.0f) + EPS);
            const f32x4 o0 = y0 * rs * g[ch][0], o1 = y1 * rs * g[ch][1];
            v4u o; o.x = pk2(o0[0], o0[1]); o.y = pk2(o0[2], o0[3]); o.z = pk2(o1[0], o1[1]); o.w = pk2(o1[2], o1[3]);
            *(GAS v4u*)(cc + (size_t)r * DM + c0) = o; }
    }
}
__device__ __forceinline__ void phase_carry(Frame& F, int l) {
    const int gt = F.vcu * 512 + F.tid; if (gt >= NB * NG * 2 * SP) return;
    const int p = gt & 63, d = (gt >> 6) & 1, g = (gt >> 7) & 31, b = gt >> 12;
    const f32x2 lt = WSP(f32x2, WS_LT)[((l * NG + g) * 2 + d) * 64 + p];
    const float* Fb = WSP(float, WS_F); bf16* u2 = WSP(bf16, WS_U2);
    float hr = 0.f, hi = 0.f;
    for (int step = 0; step < 36; ++step) {
        int inst; if (step < 4) inst = 256 + b * 4 + (d == 0 ? step : 3 - step); else inst = b * 32 + (d == 0 ? step - 4 : 35 - step);
        const size_t row = (size_t)g * NINST + inst;
        u2[row * KS2 + 1024 + d * 128 + p] = (bf16)f2bf(hr); u2[row * KS2 + 1024 + d * 128 + 64 + p] = (bf16)f2bf(hi);
        const float fr = *(const GAS float*)(Fb + row * 256 + d * 128 + p), fi = *(const GAS float*)(Fb + row * 256 + d * 128 + 64 + p);
        const float nr = lt.x * hr - lt.y * hi + fr; hi = lt.x * hi + lt.y * hr + fi; hr = nr; }
}
template <int NJ>
__device__ __forceinline__ void topk_wave(Frame& F, const float* aff, int k, int srcrow0, int yrow0, int e, LAS unsigned* av) {
#pragma unroll 1
    for (int j = 0; j < NJ; ++j) av[j * 64 + F.lane] = __builtin_bit_cast(unsigned, *(const GAS float*)(aff + j * 64 + F.lane));
    LDS_WAIT();
    unsigned T = 0u;
#pragma unroll 1
    for (int bit = 30; bit >= 0; --bit) { const unsigned cand = T | (1u << bit); int cnt = 0;
#pragma unroll 4
        for (int j = 0; j < NJ; ++j) cnt += __popcll(__ballot(av[j * 64 + F.lane] >= cand));
        if (cnt >= k) T = cand; }
    int ngt = 0, neq = 0;
#pragma unroll 2
    for (int j = 0; j < NJ; ++j) { const unsigned a = av[j * 64 + F.lane]; ngt += (a > T) ? 1 : 0; neq += (a == T) ? 1 : 0; }
    const int packed = (ngt << 16) | neq; int incl = packed;
#pragma unroll
    for (int o = 1; o < 64; o <<= 1) { const int t = __shfl_up(incl, o); incl += (F.lane >= o) ? t : 0; }
    const int excl = incl - packed, pgt = excl >> 16, peq = excl & 0xffff;
    const int need = k - (__builtin_amdgcn_readlane(incl, 63) >> 16);
    int slot = pgt + (peq < need ? peq : need), eqr = peq;
    int* IDX = WSP(int, WS_IDX); float* VALS = WSP(float, WS_VALS); int* SEL = WSP(int, WS_SEL);
#pragma unroll 1
    for (int j = 0; j < NJ; ++j) { const unsigned a = av[j * 64 + F.lane]; const bool gt = a > T, eq = a == T; const bool sl = gt || (eq && eqr < need); eqr += eq ? 1 : 0;
        const int src = srcrow0 + j * 64 + F.lane;
        if (sl) { IDX[yrow0 + slot] = src; VALS[yrow0 + slot] = __builtin_bit_cast(float, a); }
        SEL[(size_t)src * NE + e] = sl ? yrow0 + slot : -1;
        slot += sl ? 1 : 0; }
}
__device__ __forceinline__ void phase_topk(Frame& F, int l) {
    const int ntask = l == 0 ? 256 : 128;
    LAS unsigned* av = (LAS unsigned*)(F.lds + F.wave * 8192);
    for (int task = F.wave * F.G + F.vcu; task < ntask; task += F.G * NWAVES) {
        const bool isctx = task >= 128; const int q = task & 127, b = q >> 4, e = q & 15;
        const int yrow0 = isctx ? NE * NB * CAPL + e * (NB * CAPC) + b * CAPC : (e * NB + b) * CAPL;
        if (isctx) topk_wave<4>(F, WSP(float, WS_AFFC) + (size_t)(b * NE + e) * CTXL, CAPC, ML + b * CTXL, yrow0, e, av);
        else topk_wave<32>(F, WSP(float, WS_AFF) + (size_t)(b * NE + e) * SEQL, CAPL, b * SEQL, yrow0, e, av);
    }
}
template <class T> __device__ __forceinline__ T* opaque_ptr(T* p) { unsigned long long v = (unsigned long long)p; unsigned lo = (unsigned)v, hi = (unsigned)(v >> 32); asm volatile("" : "+v"(lo), "+v"(hi));
    lo = __builtin_amdgcn_readfirstlane(lo); hi = __builtin_amdgcn_readfirstlane(hi); return (T*)(((unsigned long long)hi << 32) | lo); }
__device__ __forceinline__ void launder(Frame& F) { F.ws = opaque_ptr(F.ws); F.out = opaque_ptr(F.out);
    int t = F.tid; asm volatile("" : "+v"(t)); F.tid = t; F.lane = t & 63; F.wave = __builtin_amdgcn_readfirstlane(t >> 6);
    int g = gridDim.x, bx = blockIdx.x; asm volatile("" : "+v"(g), "+v"(bx)); g = __builtin_amdgcn_readfirstlane(g); bx = __builtin_amdgcn_readfirstlane(bx);
    F.G = g; F.vcu = (g % 8 == 0) ? (bx % 8) * (g / 8) + bx / 8 : bx; }
__device__ __forceinline__ void grid_seam(Frame& F) {
    XcdBarrier b; b.bar = (unsigned*)(F.ws + WS_CTL) + CW_BAR; b.x = xb_xcc_id(); b.st = (volatile LAS unsigned*)(F.lds + MISC_OFF) + 8;
    xcd_barrier(b);
}
constexpr int NPHASE = 24;
struct Args { const float* in[27]; float* out; unsigned char* ws; };
#define IN(k) (LO <= (k) && (k) < HI)
#ifndef PROBE_SUB
#define PROBE_SUB 0
#endif
#ifndef PROBE_MASK
#define PROBE_MASK 0u
#endif
#define PHASE(k) if constexpr (IN(k)) for (int rep_ = 0; rep_ < (((PROBE_MASK >> (k)) & 1u) ? 2 : 1); ++rep_)
#define SEAM(k) do { if constexpr (IN(k) && IN((k) + 1)) grid_seam(F); } while (0)
template <int LO, int HI, int l>
__device__ __forceinline__ void layer_phases(Frame& F) {
    constexpr int pb = 1 + 11 * l;
    PHASE(pb + 0) { launder(F); phase_norm1(F, l); }
    SEAM(pb + 0);
    PHASE(pb + 1) {
        launder(F);
        SchedProj S{(const char*)WSP(bf16, WS_H), (const char*)(WSP(bf16, WS_WIN) + (size_t)l * DINP * DM), F.G, F.vcu, l};
        EpiProj E{WSP(bf16, WS_R1), WSP(bf16, WS_U2)};
        pg8::gemm_phase<EpiProj, SchedProj, true>(F.lds, F.tid, pg8::Dims{DM * 2, DM * 2, DM * 2, nullptr}, S, E);
    }
    SEAM(pb + 1);
    PHASE(pb + 2) {
        launder(F);
        if (F.vcu < F.G - 64) phase_conv(F, l, F.G - 64);
        else { SchedF S{(const char*)WSP(bf16, WS_U2), (const char*)(WSP(bf16, WS_WF) + (size_t)l * NG * 256 * 1024), F.G, F.vcu};
            EpiF32 E{WSP(float, WS_F), 256, (size_t)NINST * 256};
            pg8::gemm_phase<EpiF32, SchedF, false>(F.lds, F.tid, pg8::Dims{KS2 * 2, 1024 * 2, 1024 * 2, nullptr}, S, E); }
    }
    SEAM(pb + 2);
    PHASE(pb + 3) { launder(F); phase_carry(F, l); }
    SEAM(pb + 3);
    PHASE(pb + 4) {
        launder(F);
        SchedS2 S{(const char*)WSP(bf16, WS_U2), (const char*)(WSP(bf16, WS_W2) + (size_t)l * NG * 1024 * KS2), F.G, F.vcu, l};
        EpiS2 E{WSP(bf16, WS_U2), F.in[I_SSMD] + (size_t)l * DSSM, WSP(bf16, WS_Z)};
        pg8::gemm_phase<EpiS2, SchedS2, true>(F.lds, F.tid, pg8::Dims{KS2 * 2, KS2 * 2, KS2 * 2, nullptr}, S, E);
    }
    SEAM(pb + 4);
    PHASE(pb + 5) {
        launder(F);
        SchedGlu S{(const char*)WSP(bf16, WS_Z), (const char*)(WSP(bf16, WS_WGLU) + (size_t)l * DSSM * DSSM), F.G, F.vcu, l == 0 ? 72 : 64};
        EpiGlu E{WSP(bf16, WS_Z), F.in[I_ONSG] + (size_t)l * DSSM, WSP(bf16, WS_R2)};
        if (F.G >= 144) pg8::gemm_phase<EpiGlu, SchedGlu, false>(F.lds, F.tid, pg8::Dims{DSSM * 2, DSSM * 2, DSSM * 2, nullptr}, S, E);
    }
    SEAM(pb + 5);
    PHASE(pb + 6) {
        launder(F);
        SchedOut S{(const char*)WSP(bf16, WS_R2), (const char*)(WSP(bf16, WS_WOUT) + (size_t)l * DM * DM), F.G, F.vcu, l == 0 ? 72 : 64};
        EpiOut<l == 1> E{l == 0 ? (const void*)F.in[I_X] : (const void*)WSP(bf16, WS_XL), l == 0 ? (const void*)F.in[I_CTX] : (const void*)(WSP(bf16, WS_XL) + (size_t)ML * DM), WSP(float, WS_MOD) + (size_t)l * 9 * 6 * DM, WSP(bf16, WS_XM)};
        pg8::gemm_phase<EpiOut<l == 1>, SchedOut, true>(F.lds, F.tid, pg8::Dims{DM * 2, DM * 2, DM * 2, nullptr}, S, E);
    }
    SEAM(pb + 6);
    PHASE(pb + 7) { launder(F); phase_norm2(F, l); }
    SEAM(pb + 7);
    PHASE(pb + 8) { launder(F); phase_topk(F, l); }
    SEAM(pb + 8);
    PHASE(pb + 9) {
        launder(F);
        SchedMoe S{(const char*)WSP(unsigned char, WS_H), (const char*)(WSP(unsigned char, WS_WGU) + (size_t)l * NE * 4096 * DM), F.G, F.vcu, 16, l, 1};
        EpiMoe1 E{WSP(unsigned char, WS_R2)};
        pg8::gemm_phase<EpiMoe1, SchedMoe, true, true, true>(F.lds, F.tid, pg8::Dims{DM, DM, DM, WSP(int, WS_IDX)}, S, E);
    }
    SEAM(pb + 9);
    PHASE(pb + 10) {
        launder(F);
        SchedMoe S{(const char*)WSP(unsigned char, WS_R2), (const char*)(WSP(unsigned char, WS_WDN) + (size_t)l * NE * DM * DF), F.G, F.vcu, 8, l, 0};
        EpiY8 E{WSP(unsigned char, WS_R1), FP8_SY / (FP8_SW * FP8_SA)};
        pg8::gemm_phase<EpiY8, SchedMoe, true, true>(F.lds, F.tid, pg8::Dims{DF, DF, DF, nullptr}, S, E);
    }
    SEAM(pb + 10);
}
template <int LO, int HI>
__global__ void __launch_bounds__(NWAVES * 64, 2) trunk_fwd(Args args) {
    extern __shared__ __attribute__((aligned(16))) unsigned char lds[];
    Frame F;
    F.lds = (LAS unsigned char*)lds;
    F.tid = threadIdx.x; F.lane = F.tid & 63; F.wave = __builtin_amdgcn_readfirstlane(F.tid >> 6);
    F.G = gridDim.x; { const int bx = blockIdx.x; F.vcu = (F.G % 8 == 0) ? (bx % 8) * (F.G / 8) + bx / 8 : bx; }
    F.ws = args.ws; F.out = args.out; F.in = args.in;
    for (int u = F.tid; u < (LDS_BYTES - LDSCTL_OFF) / 4; u += NWAVES * 64) ((LAS unsigned*)(F.lds + LDSCTL_OFF))[u] = 0u;
    __syncthreads();
    if constexpr (HI - LO > 1) (void)xcd_barrier_post((unsigned*)(F.ws + WS_CTL) + CW_BAR, (volatile LAS unsigned*)(F.lds + MISC_OFF) + 8);

    PHASE(0) {
        launder(F);
        for (int q_ = 0; q_ < ((PROBE_SUB & 1) ? 2 : 1); ++q_) if (F.vcu < 192) { for (int t = F.vcu; t < 192; t += 192) p0_mod_task(F, t); }
        for (int q_ = 0; q_ < ((PROBE_SUB & 2) ? 2 : 1); ++q_) if (F.vcu >= 192) { for (int t = F.vcu - 192; t < 64; t += F.G - 192) p0_s5_task(F, t); }
        p0_router_t(F);
        for (int q_ = 0; q_ < ((PROBE_SUB & 4) ? 2 : 1); ++q_) p0_convert_weights(F, 2 * rep_ + q_);
    }
    SEAM(0);
    layer_phases<LO, HI, 0>(F);
    layer_phases<LO, HI, 1>(F);
    PHASE(23) { launder(F); phase_final(F); }
}
#undef IN
#undef PHASE
#undef SEAM

template <int P> static void launch_phase(int grid, hipStream_t stream, const Args& a) {
    hipLaunchKernelGGL((trunk_fwd<P, P + 1>), dim3(grid), dim3(NWAVES * 64), LDS_BYTES, stream, a);
}
template <int P> static void set_attr_phase() { (void)hipFuncSetAttribute((const void*)trunk_fwd<P, P + 1>, hipFuncAttributeMaxDynamicSharedMemorySize, LDS_BYTES); }
template <int... Ps> static void launch_all(std::integer_sequence<int, Ps...>, int grid, hipStream_t stream, const Args& a) { (launch_phase<Ps>(grid, stream, a), ...); }
template <int... Ps> static void set_attr_all(std::integer_sequence<int, Ps...>) { (set_attr_phase<Ps>(), ...); }
extern "C" void kernel_launch(void* const* d_in, const int* in_sizes, int n_in, void* d_out, int out_size, void* d_ws, size_t ws_size, hipStream_t stream) {
    static int grid = 0;
    if (grid == 0) {
        if (n_in != 27 || out_size != ML * DM || ws_size < WS_END) { fprintf(stderr, "kernel_launch: expected 27 inputs, %d outputs, >= %zu workspace bytes; got %d, %d, %zu\n", ML * DM, (size_t)WS_END, n_in, out_size, ws_size); grid = -1; return; }
        int dev = 0, cus = 0, per_cu = 0;
        if (hipGetDevice(&dev) != hipSuccess || hipDeviceGetAttribute(&cus, hipDeviceAttributeMultiprocessorCount, dev) != hipSuccess) { grid = -1; return; }
#if MK_N_LAUNCHES == 1
        if (hipFuncSetAttribute((const void*)trunk_fwd<0, NPHASE>, hipFuncAttributeMaxDynamicSharedMemorySize, LDS_BYTES) != hipSuccess) { fprintf(stderr, "kernel_launch: hipFuncSetAttribute failed\n"); grid = -1; return; }
        if (hipOccupancyMaxActiveBlocksPerMultiprocessor(&per_cu, (const void*)trunk_fwd<0, NPHASE>, NWAVES * 64, LDS_BYTES) != hipSuccess || per_cu < 1) fprintf(stderr, "kernel_launch: occupancy query reports %d\n", per_cu);
#else
        set_attr_all(std::make_integer_sequence<int, NPHASE>{});
#endif
        (void)hipGetLastError();
        grid = cus;
        if (grid < 256 || grid % 8 != 0) { fprintf(stderr, "kernel_launch: unexpected CU count %d\n", cus); }
    }
    if (grid < 0) return;
    (void)hipMemsetAsync((char*)d_ws + WS_CTL, 0, CTL_ZERO_BYTES, stream);
    Args a{};
    for (int i = 0; i < 27; ++i) a.in[i] = (const float*)d_in[i];
    a.out = (float*)d_out; a.ws = (unsigned char*)d_ws;
#if MK_N_LAUNCHES == 1
    hipLaunchKernelGGL((trunk_fwd<0, NPHASE>), dim3(grid), dim3(NWAVES * 64), LDS_BYTES, stream, a);
#else
    launch_all(std::make_integer_sequence<int, NPHASE>{}, grid, stream, a);
#endif
    const hipError_t le = hipPeekAtLastError();
    if (le != hipSuccess) fprintf(stderr, "kernel_launch: launch failed: %s\n", hipGetErrorName(le));
}
```

```cpp
#include <hip/hip_runtime.h>
#include <cstdio>
#include <cstdint>
#include <utility>

#define GAS __attribute__((address_space(1)))
#define LAS __attribute__((address_space(3)))
typedef unsigned short bf16;
typedef unsigned v4u __attribute__((ext_vector_type(4)));
typedef unsigned v2u __attribute__((ext_vector_type(2)));
typedef float f32x4 __attribute__((ext_vector_type(4)));
typedef float f32x2 __attribute__((ext_vector_type(2)));
typedef short bf16x8 __attribute__((ext_vector_type(8)));
typedef GAS unsigned gu32;

#ifndef MK_N_LAUNCHES
#define MK_N_LAUNCHES 1
#endif

constexpr int NB = 8, SEQL = 2048, CTXL = 256, DM = 2048;
constexpr int ML = NB * SEQL, MC = NB * CTXL, MT = ML + MC;
constexpr int DCONV = 1536, DSSM = 512, DINP = 3 * DCONV + DSSM;
constexpr int NG = 32, SG = 16, SP = 64, TCH = 64;
constexpr int NE = 16, DF = 2048, CAPL = 256, CAPC = 32;
constexpr int NINST = 512, KS2 = 1280;
constexpr int YROWS = NE * NB * CAPL + NE * NB * CAPC;
constexpr float EPS = 1e-6f;

constexpr size_t MiB = 1u << 20;
constexpr size_t WS_CTL = 0, CTL_ZERO_BYTES = 1 * MiB;
constexpr size_t WS_MOD = 1 * MiB;
constexpr size_t WS_RWT = 2 * MiB;
constexpr size_t WS_LT = 2 * MiB + 512 * 1024;
constexpr size_t WS_AFF = 3 * MiB;
constexpr size_t WS_AFFC = 4 * MiB;
constexpr size_t WS_IDX = 5 * MiB;
constexpr size_t WS_VALS = 5 * MiB + 256 * 1024;
constexpr size_t WS_SEL = 6 * MiB;
constexpr size_t WS_WGLU = 8 * MiB;
constexpr size_t WS_WOUT = 9 * MiB;
constexpr size_t WS_WIN = 25 * MiB;
constexpr size_t WS_WF = 65 * MiB;
constexpr size_t WS_W2 = 97 * MiB;
constexpr size_t WS_WGU = 257 * MiB;
constexpr size_t WS_WDN = 769 * MiB;
constexpr size_t WS_XL = 1025 * MiB;
constexpr size_t WS_XM = 1169 * MiB;
constexpr size_t WS_H = 1313 * MiB;
constexpr size_t WS_F = 1385 * MiB;
constexpr size_t WS_R1 = 1401 * MiB;
constexpr size_t WS_R2 = 1563 * MiB;
constexpr size_t WS_U2 = WS_R2 + 72 * MiB;
constexpr size_t WS_Z = WS_R2 + 112 * MiB;
constexpr size_t WS_END = 1707 * MiB;
constexpr int CW_BAR = 4096;

constexpr int RING_BYTES = 131072;
constexpr int LDSCTL_OFF = RING_BYTES, MISC_OFF = LDSCTL_OFF + 320;
constexpr int LDS_BYTES = 147456;
constexpr int NWAVES = 8;

#define LDS_WAIT() asm volatile("s_waitcnt lgkmcnt(0)" ::: "memory")
#define VM_WAIT() asm volatile("s_waitcnt vmcnt(0)" ::: "memory")
__device__ __forceinline__ unsigned f2bf(float f) { unsigned u = __builtin_bit_cast(unsigned, f); return (u + 0x7fffu + ((u >> 16) & 1u)) >> 16; }
__device__ __forceinline__ unsigned pk2(float lo, float hi) { return f2bf(lo) | (f2bf(hi) << 16); }
__device__ __forceinline__ float bflo(unsigned w) { return __builtin_bit_cast(float, w << 16); }
__device__ __forceinline__ float bfhi(unsigned w) { return __builtin_bit_cast(float, w & 0xffff0000u); }
__device__ __forceinline__ float wave_sum(float v) {
#pragma unroll
    for (int o = 1; o < 64; o <<= 1) v += __shfl_xor(v, o);
    return v;
}
__device__ __forceinline__ float sigmoidf_(float x) { return 1.0f / (1.0f + __expf(-x)); }
__device__ __forceinline__ float gelu_tanh(float y) { const float a = 1.5957691216f * (y + 0.044715f * y * y * y); return y * sigmoidf_(a); }

#ifndef FP8_SCALE1
#define FP8_SCALE1 0x7f7f7f7f
#endif
namespace pg8 {
constexpr int BM = 256, BK = 64, HALF = 128, HTB = HALF * BK * 2, STAGE_BYTES = 8 * HTB;
__host__ __device__ __forceinline__ int lds_byte(int r, int c) { const int st = (r >> 4) * 2 + (c >> 5), rr = r & 15, cc = c & 31, ob = rr * 64 + cc * 2; return st * 1024 + (ob ^ (((ob >> 9) & 1) << 5)); }
__host__ __device__ __forceinline__ void stage_rc(int b, int& R, int& C) { const int st = b / 1024, sb = b % 1024, swz = sb ^ (((sb >> 9) & 1) << 5); R = (st >> 1) * 16 + swz / 64; C = (st & 1) * 32 + (swz % 64) / 2; }
__host__ __device__ __forceinline__ int perm32(int rho) { const int n = rho >> 4, i = rho & 15; return 8 * (i >> 2) + 4 * n + (i & 3); }
__device__ __forceinline__ unsigned cvt_pk_bf16(float lo, float hi) { unsigned r; asm volatile("v_cvt_pk_bf16_f32 %0, %1, %2" : "=v"(r) : "v"(lo), "v"(hi)); return r; }

struct Unit { const char* a; const char* b; int pm, pn, aux; };
struct Dims { int lda, ldb, K; const int* gidx; };
typedef int v4i_t __attribute__((ext_vector_type(4)));
typedef int v8i_t __attribute__((ext_vector_type(8)));
template <bool FP8> struct Frag { bf16x8 k[2]; };
template <> struct Frag<true> { v8i_t v; };

template <class Epi, class Sched, bool ALIGN_EPI, bool FP8 = false, bool GATHER = false>
__device__ __forceinline__ void gemm_phase(LAS unsigned char* lds, const int tid, const Dims g, const Sched& S, const Epi& E) {
    const int wid = __builtin_amdgcn_readfirstlane(tid >> 6), lane = tid & 63, wr = wid >> 2, wc = wid & 3, fr = lane & 15, fq = lane >> 4;
    const int nt = g.K / (BK * 2);
    unsigned voffA[2], voffB[2];
#pragma unroll
    for (int i = 0; i < 2; ++i) { int R, C; stage_rc(tid * 16 + i * 8192, R, C); const int Rb = Epi::PERM ? ((R & ~31) + perm32(R & 31)) : R;
        voffA[i] = (unsigned)(R * g.lda + C * 2); voffB[i] = (unsigned)(Rb * g.ldb + C * 2); }
    const size_t kstep = (size_t)(BK * 2);
    const size_t hstepA = (size_t)HALF * g.lda, hstepB = (size_t)HALF * g.ldb;
    const unsigned ldsw = (unsigned)wid * 1024u;
    const int aoff = lds_byte(wr * 64 + fr, fq * 8), boff = lds_byte(wc * 32 + fr, fq * 8);
#define PG8_SA(b, h) (((b) * 2 + (h)) * HTB)
#define PG8_SB(b, h) ((4 + (b) * 2 + (h)) * HTB)
#define PG8_STAGE(bufoff, gbase, voff) do { _Pragma("unroll") for (int _i = 0; _i < 2; ++_i) \
        __builtin_amdgcn_global_load_lds((const unsigned*)((const char*)(gbase) + (voff)[_i]), (LAS unsigned*)(lds + (bufoff) + ldsw + _i * 8192), 16, 0, 0); } while (0)
#define PG8_STAGE_A(bufoff, gbase, h, isnext) do { if constexpr (GATHER) { if (isnext) PG8_STAGE(bufoff, gbase, gAn[h]); else PG8_STAGE(bufoff, gbase, gA[h]); } \
        else PG8_STAGE(bufoff, (gbase) + ((h) ? hstepA : (size_t)0), voffA); } while (0)
#define PG8_GIDX(dst, u) do { _Pragma("unroll") for (int h_ = 0; h_ < 2; ++h_) _Pragma("unroll") for (int i_ = 0; i_ < 2; ++i_) { int R_, C_; stage_rc(tid * 16 + i_ * 8192, R_, C_); \
        dst[h_][i_] = (unsigned)(*(const GAS int*)(g.gidx + (u).pm * 256 + h_ * 128 + R_)) * (unsigned)g.lda + (unsigned)(C_ * 2); } } while (0)
#define PG8_LD1(dst, p) do { if constexpr (FP8) { const v4i_t lo_ = *(const LAS v4i_t*)(p), hi_ = *(const LAS v4i_t*)((p) + 1024); dst.v = __builtin_shufflevector(lo_, hi_, 0, 1, 2, 3, 4, 5, 6, 7); } \
        else { dst.k[0] = *(const LAS bf16x8*)(p); dst.k[1] = *(const LAS bf16x8*)((p) + 1024); } } while (0)
#define PG8_LDA(dst, b, h) do { _Pragma("unroll") for (int m = 0; m < 4; ++m) PG8_LD1(dst[m], lds + PG8_SA(b, h) + aoff + m * 2048); } while (0)
#define PG8_LDB(dst, b, h) do { _Pragma("unroll") for (int n = 0; n < 2; ++n) PG8_LD1(dst[n], lds + PG8_SB(b, h) + boff + n * 2048); } while (0)
#define PG8_MMA(ai, bj, At, Bt) do { __builtin_amdgcn_s_setprio(1); _Pragma("unroll") for (int m = 0; m < 4; ++m) _Pragma("unroll") for (int n = 0; n < 2; ++n) { \
        if constexpr (FP8) asm volatile("v_mfma_f32_16x16x128_f8f6f4 %0, %1, %2, %0" : "+v"(acc[ai][bj][m][n]) : "v"(Bt[n].v), "v"(At[m].v)); \
        else { _Pragma("unroll") for (int k = 0; k < 2; ++k) acc[ai][bj][m][n] = __builtin_amdgcn_mfma_f32_16x16x32_bf16(Bt[n].k[k], At[m].k[k], acc[ai][bj][m][n], 0, 0, 0); } } __builtin_amdgcn_s_setprio(0); } while (0)
#define PG8_WAIT_V(n) asm volatile("s_waitcnt vmcnt(" #n ")" ::: "memory")
#define PG8_WAIT_L(n) asm volatile("s_waitcnt lgkmcnt(" #n ")" ::: "memory")
#define PG8_BAR __builtin_amdgcn_s_barrier()
#define PG8_SCHED __builtin_amdgcn_sched_barrier(0)
    Unit cur, nxt; int ui = 0;
    if (!S.next(0, cur)) return;
    f32x4 acc[2][2][4][2];
#pragma unroll
    for (int a = 0; a < 2; ++a)
#pragma unroll
        for (int b = 0; b < 2; ++b)
#pragma unroll
            for (int m = 0; m < 4; ++m)
#pragma unroll
                for (int n = 0; n < 2; ++n) acc[a][b][m][n] = (f32x4){0.f, 0.f, 0.f, 0.f};
    Frag<FP8> At[4], B0[2], B1[2];
    const char* cA = cur.a; const char* cB = cur.b;
    unsigned gA[2][2], gAn[2][2];
    if constexpr (GATHER) { PG8_GIDX(gA, cur); _Pragma("unroll") for (int h_ = 0; h_ < 2; ++h_) _Pragma("unroll") for (int i_ = 0; i_ < 2; ++i_) gAn[h_][i_] = gA[h_][i_]; }
    PG8_STAGE(PG8_SB(0, 0), cB, voffB); PG8_STAGE(PG8_SB(0, 1), cB + hstepB, voffB); PG8_STAGE_A(PG8_SA(0, 0), cA, 0, false); PG8_STAGE_A(PG8_SA(0, 1), cA, 1, false);
    if (wr == 1) PG8_BAR;
    PG8_WAIT_V(2); PG8_BAR;
    PG8_STAGE(PG8_SB(1, 0), cB + kstep, voffB); PG8_STAGE_A(PG8_SA(1, 0), cA + kstep, 0, false); PG8_STAGE(PG8_SB(1, 1), cB + hstepB + kstep, voffB);
    PG8_WAIT_V(6); PG8_BAR;
    for (;;) {
        const bool has_next = S.next(ui + 1, nxt);
        const char* nA = has_next ? nxt.a : cA; const char* nB = has_next ? nxt.b : cB;
        for (int t = 0; t < nt; t += 2) {
            const bool last = (t == nt - 2);
            const char* a1 = cA + (size_t)(t + 1) * kstep;
            if constexpr (GATHER) { if (t == nt - 4 && has_next) PG8_GIDX(gAn, nxt); }
            const char* a2 = last ? nA : cA + (size_t)(t + 2) * kstep; const char* b2 = last ? nB : cB + (size_t)(t + 2) * kstep;
            const char* a3 = a2 + kstep; const char* b3 = b2 + kstep;
            PG8_LDB(B0, 0, 0); PG8_LDB(B1, 0, 1); PG8_SCHED; PG8_LDA(At, 0, 0); PG8_STAGE_A(PG8_SA(1, 1), a1, 1, false);
            PG8_WAIT_V(8); PG8_WAIT_L(0); PG8_BAR; PG8_MMA(0, 0, At, B0); PG8_MMA(0, 1, At, B1); PG8_BAR; PG8_SCHED;
            PG8_LDA(At, 0, 1); PG8_STAGE(PG8_SB(0, 0), b2, voffB); PG8_STAGE(PG8_SB(0, 1), b2 + hstepB, voffB); PG8_STAGE_A(PG8_SA(0, 0), a2, 0, last);
            PG8_WAIT_V(8); PG8_WAIT_L(0); PG8_BAR; PG8_MMA(1, 0, At, B0); PG8_MMA(1, 1, At, B1); PG8_BAR; PG8_SCHED;
            PG8_LDB(B0, 1, 0); PG8_LDB(B1, 1, 1); PG8_SCHED; PG8_LDA(At, 1, 0); PG8_STAGE_A(PG8_SA(0, 1), a2, 1, last);
            PG8_WAIT_V(8); PG8_WAIT_L(0); PG8_BAR; PG8_MMA(0, 0, At, B0); PG8_MMA(0, 1, At, B1); PG8_BAR; PG8_SCHED;
            PG8_LDA(At, 1, 1); PG8_STAGE(PG8_SB(1, 0), b3, voffB); PG8_STAGE(PG8_SB(1, 1), b3 + hstepB, voffB); PG8_STAGE_A(PG8_SA(1, 0), a3, 0, last);
            PG8_WAIT_V(8); PG8_WAIT_L(0); PG8_BAR; PG8_MMA(1, 0, At, B0); PG8_MMA(1, 1, At, B1); PG8_BAR; PG8_SCHED;
        }
        if constexpr (FP8) asm volatile("s_nop 15\n\ts_nop 7" ::: "memory");
        if constexpr (ALIGN_EPI) { if (wr == 0) PG8_BAR; }
        if constexpr (!Epi::AFTER_DRAIN) { E(acc, cur, wr, wc, fr, fq);
#ifdef PROBE_EPI2
            E(acc, cur, wr, wc, fr, fq);
#endif
        }
        if (!has_next) break;
#pragma unroll
        for (int a = 0; a < 2; ++a)
#pragma unroll
            for (int b = 0; b < 2; ++b)
#pragma unroll
                for (int m = 0; m < 4; ++m)
#pragma unroll
                    for (int n = 0; n < 2; ++n) acc[a][b][m][n] = (f32x4){0.f, 0.f, 0.f, 0.f};
        cur = nxt; cA = nA; cB = nB; ++ui;
        if constexpr (GATHER) { _Pragma("unroll") for (int h_ = 0; h_ < 2; ++h_) _Pragma("unroll") for (int i_ = 0; i_ < 2; ++i_) gA[h_][i_] = gAn[h_][i_]; }
        if constexpr (ALIGN_EPI) { if (wr == 1) PG8_BAR; }
    }
    PG8_WAIT_V(0);
    if constexpr (!ALIGN_EPI) { if (wr == 0) PG8_BAR; }
    PG8_BAR;
    if constexpr (Epi::AFTER_DRAIN) { E.fused(acc, cur, wr, wc, fr, fq, lds, wid, lane); }
#undef PG8_SA
#undef PG8_SB
#undef PG8_STAGE
#undef PG8_STAGE_A
#undef PG8_GIDX
#undef PG8_LDA
#undef PG8_LDB
#undef PG8_MMA
#undef PG8_LD1
#undef PG8_WAIT_V
#undef PG8_WAIT_L
#undef PG8_BAR
#undef PG8_SCHED
}
}

#define XB_TMO      128
#define XB_XCNT(j)  (256  + 64 * (j))
#define XB_XSUB(j)  (1280 + 64 * (j))
#define XB_XGEN(j)  (2304 + 64 * (j))
#define XB_TOP      3328
#define XB_TOPGEN   3392
#define XCD_BAR_WORDS 3456
#define XB_SPIN_CAP (1u << 18)

__device__ __forceinline__ unsigned xb_ld(unsigned* p)              { return __hip_atomic_load(p, __ATOMIC_RELAXED, __HIP_MEMORY_SCOPE_AGENT); }
__device__ __forceinline__ unsigned xb_add(unsigned* p, unsigned v) { return __hip_atomic_fetch_add(p, v, __ATOMIC_RELAXED, __HIP_MEMORY_SCOPE_AGENT); }
__device__ __forceinline__ unsigned xb_xcc_id() { return (unsigned)__builtin_amdgcn_s_getreg((3 << 11) | 20) & 0xFu; }
#define XB_SPIN(cond, bar) do { unsigned _sp = 0; while (cond) { __builtin_amdgcn_s_sleep(1); \
    if ((++_sp & 255u) == 0u) { if (xb_ld(&(bar)[XB_TMO])) break; if (_sp > XB_SPIN_CAP) { atomicAdd(&(bar)[XB_TMO], 1u); break; } } } } while (0)

struct XcdBarrier {
    unsigned* bar; unsigned x;
    volatile LAS unsigned* st;
};
__device__ __forceinline__ XcdBarrier xcd_barrier_post(unsigned* bar, volatile LAS unsigned* st) {
    XcdBarrier b; b.bar = bar; b.x = xb_xcc_id(); b.st = st;
    if (threadIdx.x == 0) (void)xb_add(&bar[XB_XCNT(b.x)], 1u);
    return b;
}
__device__ __forceinline__ void xcd_barrier_complete(unsigned* bar, unsigned x, unsigned& nloc, unsigned& nx) {
    const unsigned G = gridDim.x * gridDim.y * gridDim.z;
    unsigned sum, cnt, mine, sp = 0u;
    for (;;) {
        sum = 0u; cnt = 0u; mine = 0u;
#pragma unroll
        for (unsigned j = 0; j < 16; ++j) { const unsigned c = xb_ld(&bar[XB_XCNT(j)]); sum += c; cnt += (c > 0u) ? 1u : 0u; mine = (j == x) ? c : mine; }
        if (sum == G) break;
        __builtin_amdgcn_s_sleep(1);
        if ((++sp & 255u) == 0u) { if (xb_ld(&bar[XB_TMO])) break; if (sp > XB_SPIN_CAP) { atomicAdd(&bar[XB_TMO], 1u); break; } }
    }
    nloc = mine > 0u ? mine : 1u; nx = cnt > 0u ? cnt : 1u;
}
__device__ __forceinline__ void xcd_barrier(const XcdBarrier& b) {
    asm volatile("s_waitcnt vmcnt(0)" ::: "memory");
    __syncthreads();
    if (threadIdx.x == 0) {
        unsigned* bar = b.bar;
        __builtin_amdgcn_s_waitcnt(0);
        unsigned nloc = b.st[0], nx = b.st[1];
        if (nloc == 0u) { xcd_barrier_complete(bar, b.x, nloc, nx); b.st[0] = nloc; b.st[1] = nx; }
        const unsigned old = xb_add(&bar[XB_XSUB(b.x)], 1u);
        const unsigned gen = old / nloc;
        if (old + 1u == (gen + 1u) * nloc) {
            __builtin_amdgcn_fence(__ATOMIC_RELEASE, "agent");
            asm volatile("s_waitcnt vmcnt(0)" ::: "memory");
            const unsigned og = xb_add(&bar[XB_TOP], 1u);
            const unsigned tg = og / nx;
            if (og + 1u == (tg + 1u) * nx) xb_add(&bar[XB_TOPGEN], 1u);
            else XB_SPIN(xb_ld(&bar[XB_TOPGEN]) == tg, bar);
            __builtin_amdgcn_fence(__ATOMIC_ACQUIRE, "agent");
            xb_add(&bar[XB_XGEN(b.x)], 1u);
            asm volatile("s_waitcnt vmcnt(0)" ::: "memory");
        } else {
            XB_SPIN(xb_ld(&bar[XB_XGEN(b.x)]) == gen, bar);
            __builtin_amdgcn_fence(__ATOMIC_ACQUIRE, "agent");
            asm volatile("s_waitcnt vmcnt(0)" ::: "memory");
        }
    }
    __syncthreads();
}

struct Frame {
    LAS unsigned char* lds;
    int tid, lane, wave, vcu, G;
    unsigned char* ws;
    const float* const* in;
    float* out;
};
#define WSP(T, off) ((T*)(F.ws + (off)))
enum InIdx { I_X = 0, I_C, I_CTX, I_CCTX, I_ADAW, I_ADAB, I_N1G, I_WIN, I_CONVW, I_LRE, I_LIM, I_LDT, I_BRE, I_BIM, I_CRE, I_CIM, I_SSMD, I_WGLU, I_ONCG, I_ONSG, I_WOUT, I_N2G, I_RW, I_WG, I_WU, I_WD, I_FNG };

using pg8::Unit;
struct EpiProj {
    static constexpr bool PERM = true, AFTER_DRAIN = false;
    bf16* proj; bf16* u2;
    __device__ __forceinline__ void operator()(const f32x4 (&acc)[2][2][4][2], const Unit& u, int wr, int wc, int fr, int fq) const {
        const int row0 = u.pm * 256 + wr * 64 + fr, col0 = u.pn * 256 + wc * 32 + 8 * fq;
#pragma unroll
        for (int ai = 0; ai < 2; ++ai)
#pragma unroll
            for (int m = 0; m < 4; ++m) { const int row = row0 + ai * 128 + m * 16;
#pragma unroll
                for (int bj = 0; bj < 2; ++bj) { const f32x4 v0 = acc[ai][bj][m][0], v1 = acc[ai][bj][m][1]; const int col = col0 + bj * 128;
                    v4u w; w.x = pg8::cvt_pk_bf16(v0[0], v0[1]); w.y = pg8::cvt_pk_bf16(v0[2], v0[3]); w.z = pg8::cvt_pk_bf16(v1[0], v1[1]); w.w = pg8::cvt_pk_bf16(v1[2], v1[3]);
                    bf16* dst;
                    if (u.pn < 18) dst = proj + (size_t)row * (3 * DCONV) + col;
                    else { const int cc = col - 3 * DCONV, g = cc >> 4, i0 = cc & 15; dst = u2 + ((size_t)(g * NINST + (row >> 6)) * KS2 + (row & 63) * 16 + i0); }
                    *(GAS v4u*)dst = w; } }
    }
};
struct EpiF32 {
    static constexpr bool PERM = false, AFTER_DRAIN = false;
    float* C; int ldc; size_t cstride;
    __device__ __forceinline__ void operator()(const f32x4 (&acc)[2][2][4][2], const Unit& u, int wr, int wc, int fr, int fq) const {
        float* base = C + (size_t)u.aux * cstride; const int row0 = u.pm * 256 + wr * 64 + fr, col0 = u.pn * 256 + wc * 32 + 4 * fq;
#pragma unroll
        for (int ai = 0; ai < 2; ++ai)
#pragma unroll
            for (int m = 0; m < 4; ++m) { float* rowp = base + (size_t)(row0 + ai * 128 + m * 16) * ldc + col0;
#pragma unroll
                for (int bj = 0; bj < 2; ++bj)
#pragma unroll
                    for (int n = 0; n < 2; ++n) *(GAS f32x4*)(rowp + bj * 128 + n * 16) = acc[ai][bj][m][n]; }
    }
};
struct EpiS2 {
    static constexpr bool PERM = true, AFTER_DRAIN = false;
    const bf16* u2; const float* dsk; bf16* z;
    __device__ __forceinline__ void operator()(const f32x4 (&acc)[2][2][4][2], const Unit& u, int wr, int wc, int fr, int fq) const {
        const int g = u.aux, inst0 = u.pm * 256 + wr * 64 + fr, c0 = u.pn * 256 + wc * 32 + 8 * fq;
#pragma unroll
        for (int bj = 0; bj < 2; ++bj) { const int cidx = c0 + bj * 128, t = cidx >> 4, o0 = cidx & 15;
            const f32x4 d0 = *(const GAS f32x4*)(dsk + g * 16 + o0), d1 = *(const GAS f32x4*)(dsk + g * 16 + o0 + 4);
#pragma unroll
            for (int ai = 0; ai < 2; ++ai)
#pragma unroll
                for (int m = 0; m < 4; ++m) { const int inst = inst0 + ai * 128 + m * 16;
                    if (inst < MT / 64) {
                        const v4u uu = *(const GAS v4u*)(u2 + ((size_t)(g * NINST + inst) * KS2 + cidx));
                        const f32x4 a0 = acc[ai][bj][m][0], a1 = acc[ai][bj][m][1];
                        const float y0 = a0[0] + d0[0] * bflo(uu.x), y1 = a0[1] + d0[1] * bfhi(uu.x), y2 = a0[2] + d0[2] * bflo(uu.y), y3 = a0[3] + d0[3] * bfhi(uu.y);
                        const float y4 = a1[0] + d1[0] * bflo(uu.z), y5 = a1[1] + d1[1] * bfhi(uu.z), y6 = a1[2] + d1[2] * bflo(uu.w), y7 = a1[3] + d1[3] * bfhi(uu.w);
                        v4u w; w.x = pg8::cvt_pk_bf16(gelu_tanh(y0), gelu_tanh(y1)); w.y = pg8::cvt_pk_bf16(gelu_tanh(y2), gelu_tanh(y3));
                        w.z = pg8::cvt_pk_bf16(gelu_tanh(y4), gelu_tanh(y5)); w.w = pg8::cvt_pk_bf16(gelu_tanh(y6), gelu_tanh(y7));
                        *(GAS v4u*)(z + ((size_t)(inst * 64 + t) * DSSM + g * 16 + o0)) = w; } } }
    }
};
struct EpiGlu {
    static constexpr bool PERM = true, AFTER_DRAIN = true;
    const bf16* z; const float* gain; bf16* concat;
    __device__ __forceinline__ void operator()(const f32x4 (&)[2][2][4][2], const Unit&, int, int, int, int) const {}
    __device__ __forceinline__ void fused(f32x4 (&acc)[2][2][4][2], const Unit& u, int wr, int wc, int fr, int fq, LAS unsigned char* lds, int wid, int lane) const {
        LAS float* P = (LAS float*)lds;
        const int row0 = u.pm * 256 + wr * 64 + fr, col0 = u.pn * 256 + wc * 32 + 8 * fq;
#pragma unroll
        for (int ai = 0; ai < 2; ++ai)
#pragma unroll
            for (int m = 0; m < 4; ++m) { const int row = row0 + ai * 128 + m * 16, rt = ai * 128 + wr * 64 + m * 16 + fr;
#pragma unroll
                for (int bj = 0; bj < 2; ++bj) { const v4u zz = *(const GAS v4u*)(z + (size_t)row * DSSM + col0 + bj * 128);
                    f32x4 a0 = acc[ai][bj][m][0], a1 = acc[ai][bj][m][1];
                    a0[0] = bflo(zz.x) * sigmoidf_(a0[0]); a0[1] = bfhi(zz.x) * sigmoidf_(a0[1]); a0[2] = bflo(zz.y) * sigmoidf_(a0[2]); a0[3] = bfhi(zz.y) * sigmoidf_(a0[3]);
                    a1[0] = bflo(zz.z) * sigmoidf_(a1[0]); a1[1] = bfhi(zz.z) * sigmoidf_(a1[1]); a1[2] = bflo(zz.w) * sigmoidf_(a1[2]); a1[3] = bfhi(zz.w) * sigmoidf_(a1[3]);
                    acc[ai][bj][m][0] = a0; acc[ai][bj][m][1] = a1;
                    float s = (a0[0] * a0[0] + a0[1] * a0[1]) + (a0[2] * a0[2] + a0[3] * a0[3]) + (a1[0] * a1[0] + a1[1] * a1[1]) + (a1[2] * a1[2] + a1[3] * a1[3]);
                    s += __shfl_xor(s, 16); s += __shfl_xor(s, 32);
                    if (fq == 0) P[(rt * 2 + bj) * 4 + wc] = s; } }
        LDS_WAIT(); __builtin_amdgcn_s_barrier(); asm volatile("" ::: "memory");
#pragma unroll
        for (int bj = 0; bj < 2; ++bj) { const int col = col0 + bj * 128;
            const f32x4 g0 = *(const GAS f32x4*)(gain + col), g1 = *(const GAS f32x4*)(gain + col + 4);
#pragma unroll
            for (int ai = 0; ai < 2; ++ai)
#pragma unroll
                for (int m = 0; m < 4; ++m) { const int row = row0 + ai * 128 + m * 16, rt = ai * 128 + wr * 64 + m * 16 + fr;
                    const f32x4 p = *(const LAS f32x4*)(P + (rt * 2 + bj) * 4);
                    const float rs = 1.0f / sqrtf(((p[0] + p[1]) + (p[2] + p[3])) * (1.0f / 128.0f) + EPS);
                    const f32x4 a0 = acc[ai][bj][m][0] * rs * g0, a1 = acc[ai][bj][m][1] * rs * g1;
                    v4u w; w.x = pg8::cvt_pk_bf16(a0[0], a0[1]); w.y = pg8::cvt_pk_bf16(a0[2], a0[3]); w.z = pg8::cvt_pk_bf16(a1[0], a1[1]); w.w = pg8::cvt_pk_bf16(a1[2], a1[3]);
                    *(GAS v4u*)(concat + (size_t)row * DM + DCONV + col) = w; } }
    }
};
template <bool XBF16> struct EpiOut {
    static constexpr bool PERM = true, AFTER_DRAIN = false;
    const void* xlat; const void* xctx; const float* mod; bf16* xm;
    __device__ __forceinline__ void operator()(const f32x4 (&acc)[2][2][4][2], const Unit& u, int wr, int wc, int fr, int fq) const {
        const int rb = u.pm < 64 ? (u.pm >> 3) : 8; const float* g1 = mod + (size_t)(rb * 6 + 2) * DM;
        const size_t rowoff = u.pm < 64 ? (size_t)u.pm * 256 * DM : (size_t)(u.pm - 64) * 256 * DM; const void* xbase = u.pm < 64 ? xlat : xctx;
        bf16* xo = xm + (size_t)u.pm * 256 * DM;
        const int r0 = wr * 64 + fr, col0 = u.pn * 256 + wc * 32 + 8 * fq;
        f32x4 gv[2][2];
#pragma unroll
        for (int bj = 0; bj < 2; ++bj)
#pragma unroll
            for (int n = 0; n < 2; ++n) gv[bj][n] = *(const GAS f32x4*)(g1 + col0 + bj * 128 + n * 4);
#pragma unroll
        for (int am = 0; am < 4; ++am) { const int ai = am >> 1, m0 = (am & 1) * 2; f32x4 xv[2][2][2];
#pragma unroll
            for (int mm = 0; mm < 2; ++mm) { const size_t off = rowoff + (size_t)(r0 + ai * 128 + (m0 + mm) * 16) * DM + col0;
#pragma unroll
                for (int bj = 0; bj < 2; ++bj) {
                    if constexpr (XBF16) { const v4u w = *(const GAS v4u*)((const bf16*)xbase + off + bj * 128); xv[mm][bj][0] = (f32x4){bflo(w.x), bfhi(w.x), bflo(w.y), bfhi(w.y)}; xv[mm][bj][1] = (f32x4){bflo(w.z), bfhi(w.z), bflo(w.w), bfhi(w.w)}; }
                    else { xv[mm][bj][0] = *(const GAS f32x4*)((const float*)xbase + off + bj * 128); xv[mm][bj][1] = *(const GAS f32x4*)((const float*)xbase + off + bj * 128 + 4); } } }
#pragma unroll
            for (int mm = 0; mm < 2; ++mm) { const int m = m0 + mm; const size_t off = (size_t)(r0 + ai * 128 + m * 16) * DM + col0;
#pragma unroll
                for (int bj = 0; bj < 2; ++bj) { const f32x4 o0 = xv[mm][bj][0] + gv[bj][0] * acc[ai][bj][m][0], o1 = xv[mm][bj][1] + gv[bj][1] * acc[ai][bj][m][1];
                    v4u w; w.x = pg8::cvt_pk_bf16(o0[0], o0[1]); w.y = pg8::cvt_pk_bf16(o0[2], o0[3]); w.z = pg8::cvt_pk_bf16(o1[0], o1[1]); w.w = pg8::cvt_pk_bf16(o1[2], o1[3]);
                    *(GAS v4u*)(xo + off + bj * 128) = w; } }
            asm volatile("" ::: "memory"); }
    }
};
constexpr float FP8_SW = 64.f, FP8_SH = 16.f, FP8_SA = 8.f;
__device__ __forceinline__ unsigned pk4_fp8(float a, float b, float c, float d) {
    a = __builtin_amdgcn_fmed3f(a, -448.f, 448.f); b = __builtin_amdgcn_fmed3f(b, -448.f, 448.f); c = __builtin_amdgcn_fmed3f(c, -448.f, 448.f); d = __builtin_amdgcn_fmed3f(d, -448.f, 448.f);
    unsigned w = (unsigned)__builtin_amdgcn_cvt_pk_fp8_f32(a, b, 0, false); return (unsigned)__builtin_amdgcn_cvt_pk_fp8_f32(c, d, (int)w, true); }
struct EpiMoe1 {
    static constexpr bool PERM = true, AFTER_DRAIN = false;
    unsigned char* act;
    __device__ __forceinline__ void operator()(const f32x4 (&acc)[2][2][4][2], const Unit& u, int wr, int wc, int fr, int fq) const {
        const int row0 = u.pm * 256 + wr * 64 + fr, f0 = u.pn * 128 + wc * 32 + 8 * fq; constexpr float sg = 1.0f / (FP8_SW * FP8_SH);
#pragma unroll
        for (int ai = 0; ai < 2; ++ai)
#pragma unroll
            for (int m = 0; m < 4; ++m) { const f32x4 g0 = acc[ai][0][m][0] * sg, g1 = acc[ai][0][m][1] * sg, u0 = acc[ai][1][m][0] * (sg * FP8_SA), u1 = acc[ai][1][m][1] * (sg * FP8_SA);
                float r[8];
#pragma unroll
                for (int j = 0; j < 4; ++j) { r[j] = g0[j] * sigmoidf_(g0[j]) * u0[j]; r[4 + j] = g1[j] * sigmoidf_(g1[j]) * u1[j]; }
                v2u w; w.x = pk4_fp8(r[0], r[1], r[2], r[3]); w.y = pk4_fp8(r[4], r[5], r[6], r[7]);
                *(GAS v2u*)(act + (size_t)(row0 + ai * 128 + m * 16) * DF + f0) = w; }
    }
};
constexpr float FP8_SY = 16.f;
struct EpiY8 {
    static constexpr bool PERM = true, AFTER_DRAIN = false;
    unsigned char* O; float scale;
    __device__ __forceinline__ void operator()(const f32x4 (&acc)[2][2][4][2], const Unit& u, int wr, int wc, int fr, int fq) const {
        const int row0 = u.pm * 256 + wr * 64 + fr, col0 = u.pn * 256 + wc * 32 + 8 * fq;
#pragma unroll
        for (int ai = 0; ai < 2; ++ai)
#pragma unroll
            for (int m = 0; m < 4; ++m) { unsigned char* rowp = O + (size_t)(row0 + ai * 128 + m * 16) * DM + col0;
#pragma unroll
                for (int bj = 0; bj < 2; ++bj) { const f32x4 v0 = acc[ai][bj][m][0] * scale, v1 = acc[ai][bj][m][1] * scale;
                    v2u w; w.x = pk4_fp8(v0[0], v0[1], v0[2], v0[3]); w.y = pk4_fp8(v1[0], v1[1], v1[2], v1[3]);
                    *(GAS v2u*)(rowp + bj * 128) = w; } }
    }
};

struct SchedProj {
    const char* A; const char* B; int G, c, layer;
    __device__ __forceinline__ bool next(int i, Unit& u) const {
        const int L = i * G + c; int rt, ct;
        if (layer == 0) { if (L >= 1440) return false; rt = (L / 160) * 8 + (L & 7); ct = (L % 160) >> 3; }
        else { if (L >= 1280) return false; rt = (L / 160) * 8 + (L & 7); ct = (L % 160) >> 3; }
        u.pm = rt; u.pn = ct; u.aux = 0; u.a = A + (size_t)rt * 256 * DM * 2; u.b = B + (size_t)ct * 256 * DM * 2; return true; }
};
struct SchedCtxU {
    const char* A; const char* B; int c;
    __device__ __forceinline__ bool next(int i, Unit& u) const {
        if (i != 0 || c >= 16) return false;
        const int rt = 64 + (c & 7), ct = 18 + (c >> 3); u.pm = rt; u.pn = ct; u.aux = 0; u.a = A + (size_t)rt * 256 * DM * 2; u.b = B + (size_t)ct * 256 * DM * 2; return true; }
};
struct SchedF {
    const char* A; const char* B; int G, c;
    __device__ __forceinline__ bool next(int i, Unit& u) const {
        const int j = c - (G - 64); if (i != 0 || j < 0) return false;
        const int g = j >> 1, rt = j & 1; u.pm = rt; u.pn = 0; u.aux = g; u.a = A + (size_t)(g * NINST + rt * 256) * KS2 * 2; u.b = B + (size_t)g * 256 * 1024 * 2; return true; }
};
struct SchedS2 {
    const char* A; const char* B; int G, c, layer;
    __device__ __forceinline__ bool next(int i, Unit& u) const {
        const int L = i * G + c; int g, rt, ct;
        if (layer == 0) { if (L >= 256) return false; g = L >> 3; rt = (L >> 2) & 1; ct = L & 3; } else { if (L >= 128) return false; g = L >> 2; rt = 0; ct = L & 3; }
        u.pm = rt; u.pn = ct; u.aux = g; u.a = A + (size_t)(g * NINST + rt * 256) * KS2 * 2; u.b = B + (size_t)(g * 1024 + ct * 256) * KS2 * 2; return true; }
};
struct SchedGlu {
    const char* A; const char* B; int G, c, nrt;
    __device__ __forceinline__ bool next(int i, Unit& u) const {
        const int L = i * G + c; if (L >= nrt * 2) return false;
        u.pm = L >> 1; u.pn = L & 1; u.aux = 0; u.a = A + (size_t)u.pm * 256 * DSSM * 2; u.b = B + (size_t)u.pn * 256 * DSSM * 2; return true; }
};
struct SchedOut {
    const char* A; const char* B; int G, c, nrt;
    __device__ __forceinline__ bool next(int i, Unit& u) const {
        const int L = i * G + c; if (L >= nrt * 8) return false;
        u.pm = (L >> 6) * 8 + (L & 7); u.pn = (L & 63) >> 3; u.aux = 0; u.a = A + (size_t)u.pm * 256 * DM * 2; u.b = B + (size_t)u.pn * 256 * DM * 2; return true; }
};
struct SchedMoe {
    const char* A; const char* B; int G, c, nct, layer, gather;
    __device__ __forceinline__ bool next(int i, Unit& u) const {
        const int L = i * G + c, per = 8 * nct, nlat = NE * per; int e, rtile, ct;
        if (L < nlat) { e = L / per; const int w = L % per; ct = (w >> 5) * 4 + (w & 3); rtile = e * 8 + ((w & 31) >> 2); }
        else { const int j = L - nlat; if (layer != 0 || j >= NE * nct) return false; e = j / nct; ct = j % nct; rtile = NE * 8 + e; }
        u.pm = rtile; u.pn = ct; u.aux = e; u.a = gather ? A : A + (size_t)rtile * 256 * 2048; u.b = B + ((size_t)e * nct + ct) * 256 * 2048; return true; }
};

struct CvtItem { const float* src; unsigned char* dst; int N, ldwt, fp8; };
__device__ __forceinline__ void cvt_decode(Frame& F, long it, CvtItem& d) {
    constexpr long I_EXP = 32 * 64;
    constexpr long N_GATE = 2L * NE * I_EXP, N_WIN = 2L * 32 * 160, N_WOUT = 2L * I_EXP;
    long r = it;
    if (r < 2 * N_GATE) {
        const int kind = r >= N_GATE; if (kind) r -= N_GATE;
        const int le = (int)(r / I_EXP), q = (int)(r % I_EXP), kb = q >> 6, n0 = (q & 63) * 32;
        d.src = F.in[kind ? I_WU : I_WG] + (size_t)le * DM * DF + (size_t)(kb * 64) * DF + n0; d.N = DF; d.ldwt = DM; d.fp8 = 1;
        d.dst = WSP(unsigned char, WS_WGU) + ((size_t)le * 4096 + (n0 >> 7) * 256 + kind * 128 + (n0 & 127)) * DM + kb * 64; return; }
    r -= 2 * N_GATE;
    if (r < N_GATE) { const int le = (int)(r / I_EXP), q = (int)(r % I_EXP), kb = q >> 6, n0 = (q & 63) * 32;
        d.src = F.in[I_WD] + (size_t)le * DF * DM + (size_t)(kb * 64) * DM + n0; d.N = DM; d.ldwt = DF; d.fp8 = 1;
        d.dst = WSP(unsigned char, WS_WDN) + ((size_t)le * DM + n0) * DF + kb * 64; return; }
    r -= N_GATE; d.fp8 = 0;
    if (r < N_WIN) { const int l = (int)(r / (32 * 160)), q = (int)(r % (32 * 160)), kb = q / 160, n0 = (q % 160) * 32;
        d.src = F.in[I_WIN] + (size_t)l * DM * DINP + (size_t)(kb * 64) * DINP + n0; d.N = DINP; d.ldwt = DM * 2;
        d.dst = (unsigned char*)(WSP(bf16, WS_WIN) + ((size_t)l * DINP + n0) * DM + kb * 64); return; }
    r -= N_WIN;
    if (r < N_WOUT) { const int l = (int)(r / I_EXP), q = (int)(r % I_EXP), kb = q >> 6, n0 = (q & 63) * 32;
        d.src = F.in[I_WOUT] + (size_t)l * DM * DM + (size_t)(kb * 64) * DM + n0; d.N = DM; d.ldwt = DM * 2;
        d.dst = (unsigned char*)(WSP(bf16, WS_WOUT) + ((size_t)l * DM + n0) * DM + kb * 64); return; }
    r -= N_WOUT;
    { const int l = (int)(r / 128), q = (int)(r % 128), kb = q >> 4, n0 = (q & 15) * 32;
        d.src = F.in[I_WGLU] + (size_t)l * DSSM * DSSM + (size_t)(kb * 64) * DSSM + n0; d.N = DSSM; d.ldwt = DSSM * 2;
        d.dst = (unsigned char*)(WSP(bf16, WS_WGLU) + ((size_t)l * DSSM + n0) * DSSM + kb * 64); }
}
__device__ __forceinline__ void cvt_load(const CvtItem& d, int lane, float (&t)[32]) {
    const float* src = d.src + (size_t)(lane >> 5) * d.N + (lane & 31);
#pragma unroll
    for (int i = 0; i < 32; ++i) t[i] = *(const GAS float*)(src + (size_t)(2 * i) * d.N);
}
template <bool FP8>
__device__ __forceinline__ void cvt_store(const CvtItem& d, LAS float* scr, int lane, const float (&t)[32]) {
    constexpr float sc = FP8 ? FP8_SW : 1.0f;
#pragma unroll
    for (int i = 0; i < 32; ++i) scr[(2 * i + (lane >> 5)) * 33 + (lane & 31)] = t[i] * sc;
    LDS_WAIT(); asm volatile("" ::: "memory");
    const int c = lane & 7;
#pragma unroll
    for (int j = 0; j < 4; ++j) { const int n = (lane >> 3) + 8 * j; const LAS float* s = scr + (8 * c) * 33 + n;
        const float v0 = s[0 * 33], v1 = s[1 * 33], v2 = s[2 * 33], v3 = s[3 * 33], v4 = s[4 * 33], v5 = s[5 * 33], v6 = s[6 * 33], v7 = s[7 * 33];
        if constexpr (FP8) { v2u o; o.x = pk4_fp8(v0, v1, v2, v3); o.y = pk4_fp8(v4, v5, v6, v7); *(GAS v2u*)(d.dst + (size_t)n * d.ldwt + 8 * c) = o; }
        else { v4u o; o.x = pk2(v0, v1); o.y = pk2(v2, v3); o.z = pk2(v4, v5); o.w = pk2(v6, v7); *(GAS v4u*)(d.dst + (size_t)n * d.ldwt + 16 * c) = o; } }
    LDS_WAIT(); asm volatile("" ::: "memory");
}
constexpr long CVT_NFP8 = 3L * (2L * NE * 2048), CVT_NITEMS = CVT_NFP8 + 2L * 32 * 160 + 2L * 2048 + 2L * 128;
constexpr unsigned CVT_CHUNK = 8;
struct CvtQ { unsigned next, left; };
__device__ __forceinline__ long cvt_pull(Frame& F, CvtQ& q, unsigned* ctr, long lo, long hi) {
    if (q.left == 0u) { unsigned b = 0u; if (F.lane == 0) b = __hip_atomic_fetch_add(ctr, CVT_CHUNK, __ATOMIC_RELAXED, __HIP_MEMORY_SCOPE_AGENT);
        q.next = (unsigned)__builtin_amdgcn_readfirstlane((int)b); q.left = CVT_CHUNK; }
    const long it = lo + (long)q.next; ++q.next; --q.left; return it < hi ? it : -1;
}
template <bool FP8>
__device__ __forceinline__ void cvt_run(Frame& F, LAS float* scr, int rep) {
    unsigned* ctr = (unsigned*)(F.ws + WS_CTL) + (FP8 ? 64 : 128) + 256 * rep;     const long lo = FP8 ? 0 : CVT_NFP8, hi = FP8 ? CVT_NFP8 : CVT_NITEMS;
    CvtItem A, B; float ta[32], tb[32]; CvtQ q{0u, 0u};
    long ia = cvt_pull(F, q, ctr, lo, hi);
    if (ia < 0) return;
    cvt_decode(F, ia, A); cvt_load(A, F.lane, ta);
    for (;;) {
        long ib = cvt_pull(F, q, ctr, lo, hi); const bool vb = ib >= 0; ib = vb ? ib : ia;
        cvt_decode(F, ib, B); cvt_load(B, F.lane, tb);
        cvt_store<FP8>(A, scr, F.lane, ta);
        if (!vb) break;
        ia = cvt_pull(F, q, ctr, lo, hi); const bool va = ia >= 0; ia = va ? ia : ib;
        cvt_decode(F, ia, A); cvt_load(A, F.lane, ta);
        cvt_store<FP8>(B, scr, F.lane, tb);
        if (!va) break;
    }
}
constexpr int CVT_NTILES = 96 * 128;
struct CvtTile { const float* src; unsigned char* dst; int kind, n0; };
__device__ __forceinline__ void cvt_tile_decode(Frame& F, int T, CvtTile& d) {
    const int m = T >> 7, q = T & 127, kt = q >> 3, nt = q & 7, kind = m >> 5, le = m & 31;
    d.kind = kind; d.n0 = nt * 256;
    d.src = F.in[kind == 0 ? I_WG : (kind == 1 ? I_WU : I_WD)] + (size_t)le * DM * DF + (size_t)(kt * 128) * 2048 + nt * 256;
    d.dst = (kind < 2 ? WSP(unsigned char, WS_WGU) + (size_t)le * 4096 * DM : WSP(unsigned char, WS_WDN) + (size_t)le * DM * DF) + kt * 128;
}
__device__ __forceinline__ void cvt_tile_load(const CvtTile& d, int wave, int lane, f32x4 (&v)[16]) {
#pragma unroll
    for (int i = 0; i < 4; ++i)
#pragma unroll
        for (int r = 0; r < 4; ++r) v[4 * i + r] = *(const GAS f32x4*)(d.src + (size_t)(4 * (wave + 8 * i) + r) * 2048 + 4 * lane);
}
__device__ __forceinline__ void cvt_tile_put(LAS unsigned char* buf, int wave, int lane, const f32x4 (&v)[16]) {
#pragma unroll
    for (int i = 0; i < 4; ++i) { const int kq = wave + 8 * i; unsigned d[4];
#pragma unroll
        for (int r = 0; r < 4; ++r) { const f32x4 x = v[4 * i + r] * FP8_SW; d[r] = pk4_fp8(x[0], x[1], x[2], x[3]); }
        const unsigned t01l = __builtin_amdgcn_perm(d[1], d[0], 0x05010400u), t01h = __builtin_amdgcn_perm(d[1], d[0], 0x07030602u);
        const unsigned t23l = __builtin_amdgcn_perm(d[3], d[2], 0x05010400u), t23h = __builtin_amdgcn_perm(d[3], d[2], 0x07030602u);
        unsigned o[4]; o[0] = __builtin_amdgcn_perm(t23l, t01l, 0x05040100u); o[1] = __builtin_amdgcn_perm(t23l, t01l, 0x07060302u);
        o[2] = __builtin_amdgcn_perm(t23h, t01h, 0x05040100u); o[3] = __builtin_amdgcn_perm(t23h, t01h, 0x07060302u);
        const int goff = ((((kq >> 2) ^ (lane & 7)) << 4) + ((kq & 3) << 2));
#pragma unroll
        for (int j = 0; j < 4; ++j) *(LAS unsigned*)(buf + (4 * lane + j) * 128 + goff) = o[j]; }
}
__device__ __forceinline__ void cvt_tile_get(const CvtTile& d, const LAS unsigned char* buf, int tid) {
#pragma unroll
    for (int i = 0; i < 4; ++i) { const int q = tid + 512 * i, n = q >> 3, c = q & 7, f = d.n0 + n;
        const v4u w = *(const LAS v4u*)(buf + n * 128 + ((c ^ ((n >> 2) & 7)) << 4));
        const int row = d.kind < 2 ? ((f >> 7) * 256 + d.kind * 128 + (f & 127)) : f;
        *(GAS v4u*)(d.dst + (size_t)row * 2048 + c * 16) = w; }
}
__device__ __forceinline__ void cvt_tiles(Frame& F, int rep) {
    unsigned* ctr = (unsigned*)(F.ws + WS_CTL) + 64 + 256 * rep;
    volatile LAS int* slot = (volatile LAS int*)(F.lds + MISC_OFF) + 16;
    LAS unsigned char* buf0 = F.lds; LAS unsigned char* buf1 = F.lds + 32768;
    if (F.tid == 0) { slot[0] = (int)__hip_atomic_fetch_add(ctr, 1u, __ATOMIC_RELAXED, __HIP_MEMORY_SCOPE_AGENT); slot[1] = (int)__hip_atomic_fetch_add(ctr, 1u, __ATOMIC_RELAXED, __HIP_MEMORY_SCOPE_AGENT); }
    __syncthreads();
    int ia = slot[0];
    if (ia >= CVT_NTILES) { __syncthreads(); return; }
    CvtTile A, B; f32x4 va[16], vb[16];
    cvt_tile_decode(F, ia, A); cvt_tile_load(A, F.wave, F.lane, va);
    for (int it = 0;; it += 2) {
        int ib = slot[(it + 1) & 3]; const bool vbv = ib < CVT_NTILES; ib = vbv ? ib : ia;
        if (F.tid == 0) slot[(it + 2) & 3] = (int)__hip_atomic_fetch_add(ctr, 1u, __ATOMIC_RELAXED, __HIP_MEMORY_SCOPE_AGENT);
        cvt_tile_decode(F, ib, B); cvt_tile_load(B, F.wave, F.lane, vb);
        cvt_tile_put(buf0, F.wave, F.lane, va);
        LDS_WAIT(); __syncthreads();
        cvt_tile_get(A, buf0, F.tid);
        if (!vbv) break;
        ia = slot[(it + 2) & 3]; const bool vav = ia < CVT_NTILES; ia = vav ? ia : ib;
        if (F.tid == 0) slot[(it + 3) & 3] = (int)__hip_atomic_fetch_add(ctr, 1u, __ATOMIC_RELAXED, __HIP_MEMORY_SCOPE_AGENT);
        cvt_tile_decode(F, ia, A); cvt_tile_load(A, F.wave, F.lane, va);
        cvt_tile_put(buf1, F.wave, F.lane, vb);
        LDS_WAIT(); __syncthreads();
        cvt_tile_get(B, buf1, F.tid);
        if (!vav) break;
    }
    LDS_WAIT(); __syncthreads();
}
__device__ __forceinline__ void p0_convert_weights(Frame& F, int rep) {
    cvt_tiles(F, rep);
    LAS float* scr = (LAS float*)(F.lds + F.wave * 16384);
    cvt_run<false>(F, scr, rep);
    __syncthreads();
}
__device__ __forceinline__ void p0_mod_task(Frame& F, int task) {
    const int l = task / 96, n0 = (task % 96) * 128;
    LAS float* sc = (LAS float*)F.lds;
    LAS float* red = (LAS float*)(F.lds + 9 * 2048 * 4);
    for (int i = F.tid; i < 9 * DM; i += 512) { const int r = i >> 11, k = i & 2047; const float v = r < 8 ? F.in[I_C][r * DM + k] : F.in[I_CCTX][k]; sc[i] = v * sigmoidf_(v); }
    __syncthreads();
    const float* W = F.in[I_ADAW] + (size_t)l * DM * 6 * DM + n0 + 2 * F.lane;
    float acc[9][2];
#pragma unroll
    for (int r = 0; r < 9; ++r) { acc[r][0] = 0.f; acc[r][1] = 0.f; }
    const int kbase = F.wave * 256;
#pragma unroll 8
    for (int kk = 0; kk < 256; ++kk) { const int k = kbase + kk; const f32x2 w = *(const GAS f32x2*)(W + (size_t)k * (6 * DM));
#pragma unroll
        for (int r = 0; r < 9; ++r) { const float s = sc[r * DM + k]; acc[r][0] += s * w.x; acc[r][1] += s * w.y; } }
#pragma unroll
    for (int r = 0; r < 9; ++r) { red[(F.wave * 9 + r) * 128 + 2 * F.lane] = acc[r][0]; red[(F.wave * 9 + r) * 128 + 2 * F.lane + 1] = acc[r][1]; }
    __syncthreads();
    float* mod = WSP(float, WS_MOD) + (size_t)l * 9 * 6 * DM;
    for (int i = F.tid; i < 9 * 128; i += 512) { const int r = i >> 7, n = i & 127; float s = F.in[I_ADAB][(size_t)l * 6 * DM + n0 + n];
#pragma unroll
        for (int w = 0; w < 8; ++w) s += red[(w * 9 + r) * 128 + n];
        mod[(size_t)r * 6 * DM + n0 + n] = s; }
    __syncthreads();
}
__device__ __forceinline__ void p0_s5_task(Frame& F, int task) {
    const int l = task >> 5, g = task & 31;
    LAS f32x2* PW = (LAS f32x2*)F.lds;
    LAS f32x2* BB = (LAS f32x2*)(F.lds + 33280);
    LAS f32x2* CC = (LAS f32x2*)(F.lds + 41472);
    LAS float* KD = (LAS float*)(F.lds + 49664);
    LAS bf16* KT = (LAS bf16*)(F.lds + 50688);
    bf16* WF = WSP(bf16, WS_WF) + (size_t)(l * NG + g) * 256 * 1024;
    bf16* W2 = WSP(bf16, WS_W2) + (size_t)(l * NG + g) * 1024 * KS2;
    for (int d = 0; d < 2; ++d) {
        const int ldg = (l * 2 + d) * NG + g;
        if (F.tid < 64) { const int p = F.tid;
            const double lr = (double)F.in[I_LRE][ldg * SP + p], li = (double)F.in[I_LIM][ldg * SP + p], dt = exp((double)F.in[I_LDT][ldg]);
            const double mag = exp(lr * dt), ar = mag * cos(li * dt), ai = mag * sin(li * dt), den = lr * lr + li * li, nr = ar - 1.0;
            const double kr = (nr * lr + ai * li) / den, ki = (ai * lr - nr * li) / den;
            double pr = 1.0, pi = 0.0;
            for (int e = 0; e <= 64; ++e) { PW[e * 64 + p] = (f32x2){(float)pr, (float)pi}; const double t = pr * ar - pi * ai; pi = pr * ai + pi * ar; pr = t; }
            if (true) { const f32x2 lt = PW[64 * 64 + p]; WSP(f32x2, WS_LT)[((l * NG + g) * 2 + d) * 64 + p] = lt; }
            for (int i = 0; i < SG; ++i) { const double br = (double)F.in[I_BRE][((size_t)ldg * SP + p) * SG + i], bi = (double)F.in[I_BIM][((size_t)ldg * SP + p) * SG + i];
                BB[p * 16 + i] = (f32x2){(float)(kr * br - ki * bi), (float)(kr * bi + ki * br)}; } }
        for (int i = F.tid; i < 1024; i += 512) CC[i] = (f32x2){F.in[I_CRE][(size_t)ldg * 1024 + i], F.in[I_CIM][(size_t)ldg * 1024 + i]};
        __syncthreads();
        { const int ph = F.tid & 1, q = F.tid >> 1, o = q >> 4, i = q & 15;
            float cbr[32], cbi[32];
#pragma unroll
            for (int p = 0; p < 32; ++p) { const f32x2 c = CC[o * 64 + ph * 32 + p], b = BB[(ph * 32 + p) * 16 + i]; cbr[p] = c.x * b.x - c.y * b.y; cbi[p] = c.x * b.y + c.y * b.x; }
#pragma unroll 1
            for (int j = 0; j < 64; ++j) { float s = 0.f;
#pragma unroll
                for (int p = 0; p < 32; p += 2) { const f32x4 P = *(const LAS f32x4*)(PW + j * 64 + ph * 32 + p); s += (cbr[p] * P[0] - cbi[p] * P[1]) + (cbr[p + 1] * P[2] - cbi[p + 1] * P[3]); }
                s += __shfl_xor(s, 1);
                if (ph == 0) { if (j == 0) { if (d == 0) KD[q] = s; else { s += KD[q]; KT[q] = (bf16)f2bf(s); } }
                               else KT[(d * 64 + j) * 256 + q] = (bf16)f2bf(s); } } }
        for (int it = F.tid; it < 128 * 128; it += 512) { const int n = it >> 7, k8 = it & 127, ri = n >> 6, p = n & 63, s = k8 >> 1, i0 = (k8 & 1) * 8, e = d == 0 ? 63 - s : s;
            const f32x2 P = PW[e * 64 + p]; float v[8];
#pragma unroll
            for (int j = 0; j < 8; ++j) { const f32x2 b = BB[p * 16 + i0 + j]; v[j] = ri == 0 ? (P.x * b.x - P.y * b.y) : (P.x * b.y + P.y * b.x); }
            v4u o; o.x = pk2(v[0], v[1]); o.y = pk2(v[2], v[3]); o.z = pk2(v[4], v[5]); o.w = pk2(v[6], v[7]);
            *(GAS v4u*)(WF + (size_t)(d * 128 + n) * 1024 + k8 * 8) = o; }
        for (int it = F.tid; it < 1024 * 16; it += 512) { const int n = it >> 4, c8 = it & 15, ri = c8 >> 3, p0 = (c8 & 7) * 8, t = n >> 4, o = n & 15, e = d == 0 ? t + 1 : 64 - t; float v[8];
#pragma unroll
            for (int j = 0; j < 8; ++j) { const f32x2 c = CC[o * 64 + p0 + j], P = PW[e * 64 + p0 + j]; v[j] = ri == 0 ? (c.x * P.x - c.y * P.y) : -(c.x * P.y + c.y * P.x); }
            v4u ov; ov.x = pk2(v[0], v[1]); ov.y = pk2(v[2], v[3]); ov.z = pk2(v[4], v[5]); ov.w = pk2(v[6], v[7]);
            *(GAS v4u*)(W2 + (size_t)n * KS2 + 1024 + d * 128 + c8 * 8) = ov; }
        __syncthreads();
    }
    for (int it = F.tid; it < 1024 * 128; it += 512) { const int n = it >> 7, k8 = it & 127, t = n >> 4, o = n & 15, s = k8 >> 1, i0 = (k8 & 1) * 8;
        const int dsel = s <= t ? 0 : 1, j = s <= t ? t - s : s - t;
        const v4u kv = *(const LAS v4u*)(KT + (dsel * 64 + j) * 256 + o * 16 + i0);
        *(GAS v4u*)(W2 + (size_t)n * KS2 + k8 * 8) = kv; }
    __syncthreads();
}
__device__ __forceinline__ void p0_router_t(Frame& F) {
    for (int i = (F.vcu * 512 + F.tid); i < 2 * 16 * DM; i += F.G * 512) { const int l = i >> 15, e = (i >> 11) & 15, k = i & 2047; WSP(float, WS_RWT)[i] = F.in[I_RW][((size_t)l * DM + k) * NE + e]; }
}

__device__ __forceinline__ int mbcnt64(unsigned long long m) { return (int)__builtin_amdgcn_mbcnt_hi((unsigned)(m >> 32), __builtin_amdgcn_mbcnt_lo((unsigned)m, 0u)); }
__device__ __forceinline__ void combine_row(Frame& F, int r, const float* g2, f32x4 (&x)[8]) {
    const int* sel = WSP(int, WS_SEL) + (size_t)r * NE; const float* vals = WSP(float, WS_VALS); const unsigned char* Y = WSP(unsigned char, WS_R1);
    const int mysel = F.lane < NE ? *(const GAS int*)(sel + F.lane) : -1;
    unsigned long long m = __ballot(mysel >= 0);
    f32x4 macc[8];
#pragma unroll
    for (int j = 0; j < 8; ++j) macc[j] = (f32x4){0.f, 0.f, 0.f, 0.f};
    while (m) { const int e = __builtin_ctzll(m); m &= m - 1;
        const int y = __builtin_amdgcn_readlane(mysel, e); const float val = *(const GAS float*)(vals + y) * (1.0f / FP8_SY); const unsigned char* yr = Y + (size_t)y * DM + 4 * F.lane;
#pragma unroll
        for (int j = 0; j < 8; ++j) { const unsigned w = *(const GAS unsigned*)(yr + j * 256); const f32x2 lo = __builtin_amdgcn_cvt_pk_f32_fp8((int)w, false), hi = __builtin_amdgcn_cvt_pk_f32_fp8((int)w, true);
            macc[j] += val * (f32x4){lo.x, lo.y, hi.x, hi.y}; } }
#pragma unroll
    for (int j = 0; j < 8; ++j) x[j] += *(const GAS f32x4*)(g2 + j * 256 + 4 * F.lane) * macc[j];
}
__device__ __forceinline__ f32x4 ld_bf4(const bf16* p) { const v2u w = *(const GAS v2u*)p; return (f32x4){bflo(w.x), bfhi(w.x), bflo(w.y), bfhi(w.y)}; }
__device__ __forceinline__ float row_rs(const f32x4 (&x)[8]) {
    float s = 0.f;
#pragma unroll
    for (int j = 0; j < 8; ++j) s += (x[j][0] * x[j][0] + x[j][1] * x[j][1]) + (x[j][2] * x[j][2] + x[j][3] * x[j][3]);
    return 1.0f / sqrtf(wave_sum(s) * (1.0f / DM) + EPS);
}
constexpr int CW_CTXROWS = 512;
__device__ __forceinline__ void phase_norm1(Frame& F, int l, int nskip) {
    const float* modl = WSP(float, WS_MOD) + (size_t)l * 9 * 6 * DM; const float* gn = F.in[I_N1G] + (size_t)l * DM;
    for (int v = (F.vcu - nskip) * NWAVES + F.wave; v < MT; v += (F.G - nskip) * NWAVES) {
        const int r = v < MC ? ML + v : v - MC;
        const int rb = r < ML ? (r >> 11) : 8;
        f32x4 x[8];
        if (l == 0) { const float* xr = r < ML ? F.in[I_X] + (size_t)r * DM : F.in[I_CTX] + (size_t)(r - ML) * DM;
#pragma unroll
            for (int j = 0; j < 8; ++j) x[j] = *(const GAS f32x4*)(xr + j * 256 + 4 * F.lane); }
        else { const bf16* xr = WSP(bf16, WS_XM) + (size_t)r * DM;
#pragma unroll
            for (int j = 0; j < 8; ++j) x[j] = ld_bf4(xr + j * 256 + 4 * F.lane); }
        if (l == 1) { combine_row(F, r, WSP(float, WS_MOD) + (size_t)(rb * 6 + 5) * DM, x);
            bf16* xo = WSP(bf16, WS_XL) + (size_t)r * DM;
#pragma unroll
            for (int j = 0; j < 8; ++j) { v2u w; w.x = pk2(x[j][0], x[j][1]); w.y = pk2(x[j][2], x[j][3]); *(GAS v2u*)(xo + j * 256 + 4 * F.lane) = w; } }
        const float rs = row_rs(x); const float* sh = modl + (size_t)(rb * 6 + 0) * DM; const float* sc = modl + (size_t)(rb * 6 + 1) * DM;
        bf16* ho = WSP(bf16, WS_H) + (size_t)r * DM;
        const bool publish = nskip > 0 && r >= ML;
#pragma unroll
        for (int j = 0; j < 8; ++j) { const int c = j * 256 + 4 * F.lane; const f32x4 g = *(const GAS f32x4*)(gn + c), s1 = *(const GAS f32x4*)(sc + c), s0 = *(const GAS f32x4*)(sh + c);
            const f32x4 h = x[j] * rs * g * (1.0f + s1) + s0; v2u w; w.x = pk2(h[0], h[1]); w.y = pk2(h[2], h[3]);
            if (publish) __hip_atomic_store((unsigned long long*)(ho + c), ((unsigned long long)w.y << 32) | w.x, __ATOMIC_RELAXED, __HIP_MEMORY_SCOPE_AGENT);
            else *(GAS v2u*)(ho + c) = w; }
        if (publish) { asm volatile("s_waitcnt vmcnt(0)" ::: "memory"); if (F.lane == 0) __hip_atomic_fetch_add((unsigned*)(F.ws + WS_CTL) + CW_CTXROWS, 1u, __ATOMIC_RELAXED, __HIP_MEMORY_SCOPE_AGENT); }
    }
}
__device__ __forceinline__ void wait_ctx_rows(Frame& F) {
    if (F.wave == 0) { unsigned* cnt = (unsigned*)(F.ws + WS_CTL) + CW_CTXROWS; unsigned sp = 0;
        while ((unsigned)__builtin_amdgcn_readfirstlane((int)__hip_atomic_load(cnt, __ATOMIC_RELAXED, __HIP_MEMORY_SCOPE_AGENT)) < (unsigned)MC) { __builtin_amdgcn_s_sleep(2); if (++sp > (1u << 22)) break; }
        __builtin_amdgcn_fence(__ATOMIC_ACQUIRE, "agent");
        asm volatile("s_waitcnt vmcnt(0)" ::: "memory"); }
    __syncthreads();
}
__device__ __forceinline__ void phase_final(Frame& F) {
    const float* gn = F.in[I_FNG];
    for (int r = F.vcu * NWAVES + F.wave; r < ML; r += F.G * NWAVES) {
        const int rb = r >> 11; const bf16* xr = WSP(bf16, WS_XM) + (size_t)r * DM;
        f32x4 x[8];
#pragma unroll
        for (int j = 0; j < 8; ++j) x[j] = ld_bf4(xr + j * 256 + 4 * F.lane);
        combine_row(F, r, WSP(float, WS_MOD) + (size_t)((9 + rb) * 6 + 5) * DM, x);
        const float rs = row_rs(x); float* o = F.out + (size_t)r * DM;
#pragma unroll
        for (int j = 0; j < 8; ++j) { const int c = j * 256 + 4 * F.lane; *(GAS f32x4*)(o + c) = x[j] * rs * *(const GAS f32x4*)(gn + c); }
    }
}
__device__ __forceinline__ void phase_norm2(Frame& F, int l) {
    LAS float* rwt = (LAS float*)F.lds;
    { const float* src = WSP(float, WS_RWT) + (size_t)l * NE * DM;
        for (int i = F.tid; i < NE * DM / 4; i += 512) *(LAS f32x4*)(rwt + 4 * i) = *(const GAS f32x4*)(src + 4 * i); }
    __syncthreads();
    const float* modl = WSP(float, WS_MOD) + (size_t)l * 9 * 6 * DM; const float* gn = F.in[I_N2G] + (size_t)l * DM;
    const int nrows = l == 0 ? MT : ML;
    for (int r = F.vcu * NWAVES + F.wave; r < nrows; r += F.G * NWAVES) {
        const int rb = r < ML ? (r >> 11) : 8; const bf16* xr = WSP(bf16, WS_XM) + (size_t)r * DM;
        f32x4 x[8];
#pragma unroll
        for (int j = 0; j < 8; ++j) x[j] = ld_bf4(xr + j * 256 + 4 * F.lane);
        const float rs = row_rs(x); const float* sh = modl + (size_t)(rb * 6 + 3) * DM; const float* sc = modl + (size_t)(rb * 6 + 4) * DM;
        unsigned char* ho = WSP(unsigned char, WS_H) + (size_t)r * DM;
#pragma unroll
        for (int j = 0; j < 8; ++j) { const int c = j * 256 + 4 * F.lane; const f32x4 g = *(const GAS f32x4*)(gn + c), s1 = *(const GAS f32x4*)(sc + c), s0 = *(const GAS f32x4*)(sh + c);
            x[j] = x[j] * rs * g * (1.0f + s1) + s0; *(GAS unsigned*)(ho + c) = pk4_fp8(x[j][0] * FP8_SH, x[j][1] * FP8_SH, x[j][2] * FP8_SH, x[j][3] * FP8_SH); }
        float p[NE];
#pragma unroll
        for (int eg = 0; eg < NE; eg += 2) { float s0 = 0.f, s1 = 0.f;
#pragma unroll
            for (int j = 0; j < 8; ++j) { const f32x4 w0 = *(const LAS f32x4*)(rwt + eg * DM + j * 256 + 4 * F.lane), w1 = *(const LAS f32x4*)(rwt + (eg + 1) * DM + j * 256 + 4 * F.lane);
                s0 += (x[j][0] * w0[0] + x[j][1] * w0[1]) + (x[j][2] * w0[2] + x[j][3] * w0[3]); s1 += (x[j][0] * w1[0] + x[j][1] * w1[1]) + (x[j][2] * w1[2] + x[j][3] * w1[3]); }
            p[eg] = s0; p[eg + 1] = s1; __builtin_amdgcn_sched_barrier(0); }
        const bool b5 = (F.lane & 32) != 0, b4 = (F.lane & 16) != 0, b3 = (F.lane & 8) != 0, b2 = (F.lane & 4) != 0;
        float q8[8], q4[4], q2[2];
#pragma unroll
        for (int i = 0; i < 8; ++i) { const float keep = b5 ? p[i + 8] : p[i], give = b5 ? p[i] : p[i + 8]; q8[i] = keep + __shfl_xor(give, 32); }
#pragma unroll
        for (int i = 0; i < 4; ++i) { const float keep = b4 ? q8[i + 4] : q8[i], give = b4 ? q8[i] : q8[i + 4]; q4[i] = keep + __shfl_xor(give, 16); }
#pragma unroll
        for (int i = 0; i < 2; ++i) { const float keep = b3 ? q4[i + 2] : q4[i], give = b3 ? q4[i] : q4[i + 2]; q2[i] = keep + __shfl_xor(give, 8); }
        float lg; { const float keep = b2 ? q2[1] : q2[0], give = b2 ? q2[0] : q2[1]; lg = keep + __shfl_xor(give, 4); }
        lg += __shfl_xor(lg, 2); lg += __shfl_xor(lg, 1);
        float mx = lg;
        mx = fmaxf(mx, __shfl_xor(mx, 4)); mx = fmaxf(mx, __shfl_xor(mx, 8)); mx = fmaxf(mx, __shfl_xor(mx, 16)); mx = fmaxf(mx, __shfl_xor(mx, 32));
        const float ex = __expf(lg - mx); float den = ex;
        den += __shfl_xor(den, 4); den += __shfl_xor(den, 8); den += __shfl_xor(den, 16); den += __shfl_xor(den, 32);
        const float mine = ex / den; const int ex_id = (F.lane >> 2) & 15;
        if ((F.lane & 3) == 0) { if (r < ML) WSP(float, WS_AFF)[((size_t)(rb * NE + ex_id) << 11) + (r & 2047)] = mine;
                                 else { const int q = r - ML; WSP(float, WS_AFFC)[((size_t)((q >> 8) * NE + ex_id) << 8) + (q & 255)] = mine; } }
    }
    __syncthreads();
}
__device__ __forceinline__ void unpack8(const v4u w, f32x4& lo, f32x4& hi) { lo = (f32x4){bflo(w.x), bfhi(w.x), bflo(w.y), bfhi(w.y)}; hi = (f32x4){bflo(w.z), bfhi(w.z), bflo(w.w), bfhi(w.w)}; }
__device__ __forceinline__ void phase_conv(Frame& F, int l, int nblk) {
    const bf16* P = WSP(bf16, WS_R1); bf16* cc = WSP(bf16, WS_R2);
    const float* cw = F.in[I_CONVW] + (size_t)l * 3 * DCONV; const float* gn = F.in[I_ONCG] + (size_t)l * DCONV;
    f32x4 w[3][3][2], g[3][2];
#pragma unroll
    for (int ch = 0; ch < 3; ++ch) { const int c0 = ch * 512 + 8 * F.lane;
#pragma unroll
        for (int t = 0; t < 3; ++t) { w[ch][t][0] = *(const GAS f32x4*)(cw + t * DCONV + c0); w[ch][t][1] = *(const GAS f32x4*)(cw + t * DCONV + c0 + 4); }
        g[ch][0] = *(const GAS f32x4*)(gn + c0); g[ch][1] = *(const GAS f32x4*)(gn + c0 + 4); }
    const int nrows = l == 0 ? MT : ML;
    for (int r = F.vcu * NWAVES + F.wave; r < nrows; r += nblk * NWAVES) {
        bool hp, hn; if (r < ML) { const int x = r & 63; hp = x > 0; hn = x < 63; } else { const int t = (r - ML) & 255; hp = t > 0; hn = t < 255; }
        const float mp = hp ? 1.f : 0.f, mn = hn ? 1.f : 0.f;
        const bf16* p0 = P + (size_t)r * (3 * DCONV); const bf16* pp = hp ? p0 - 3 * DCONV : p0; const bf16* pn = hn ? p0 + 3 * DCONV : p0;
        v4u raw[3][7];
#pragma unroll
        for (int ch = 0; ch < 3; ++ch) { const int c0 = ch * 512 + 8 * F.lane;
            raw[ch][0] = *(const GAS v4u*)(p0 + c0); raw[ch][1] = *(const GAS v4u*)(p0 + DCONV + c0); raw[ch][2] = *(const GAS v4u*)(p0 + 2 * DCONV + c0);
            raw[ch][3] = *(const GAS v4u*)(pp + DCONV + c0); raw[ch][4] = *(const GAS v4u*)(pp + 2 * DCONV + c0);
            raw[ch][5] = *(const GAS v4u*)(pn + DCONV + c0); raw[ch][6] = *(const GAS v4u*)(pn + 2 * DCONV + c0); }
#pragma unroll
        for (int ch = 0; ch < 3; ++ch) { const int c0 = ch * 512 + 8 * F.lane;
            f32x4 b0, b1, c0v, c1v, v0, v1, cp0, cp1, vp0, vp1, cn0, cn1, vn0, vn1;
            unpack8(raw[ch][0], b0, b1); unpack8(raw[ch][1], c0v, c1v); unpack8(raw[ch][2], v0, v1); unpack8(raw[ch][3], cp0, cp1); unpack8(raw[ch][4], vp0, vp1); unpack8(raw[ch][5], cn0, cn1); unpack8(raw[ch][6], vn0, vn1);
            const f32x4 y0 = b0 * (w[ch][0][0] * (mp * (cp0 * vp0)) + w[ch][1][0] * (c0v * v0) + w[ch][2][0] * (mn * (cn0 * vn0)));
            const f32x4 y1 = b1 * (w[ch][0][1] * (mp * (cp1 * vp1)) + w[ch][1][1] * (c1v * v1) + w[ch][2][1] * (mn * (cn1 * vn1)));
            float ss = (y0[0] * y0[0] + y0[1] * y0[1]) + (y0[2] * y0[2] + y0[3] * y0[3]) + (y1[0] * y1[0] + y1[1] * y1[1]) + (y1[2] * y1[2] + y1[3] * y1[3]);
            ss += __shfl_xor(ss, 1); ss += __shfl_xor(ss, 2); ss += __shfl_xor(ss, 4); ss += __shfl_xor(ss, 8);
            const float rs = 1.0f / sqrtf(ss * (1.0f / 128.0f) + EPS);
            const f32x4 o0 = y0 * rs * g[ch][0], o1 = y1 * rs * g[ch][1];
            v4u o; o.x = pk2(o0[0], o0[1]); o.y = pk2(o0[2], o0[3]); o.z = pk2(o1[0], o1[1]); o.w = pk2(o1[2], o1[3]);
            *(GAS v4u*)(cc + (size_t)r * DM + c0) = o; }
    }
}
__device__ __forceinline__ void phase_carry(Frame& F, int l) {
    const int gt = F.vcu * 512 + F.tid; if (gt >= NB * NG * 2 * SP) return;
    const int p = gt & 63, d = (gt >> 6) & 1, g = (gt >> 7) & 31, b = gt >> 12;
    const f32x2 lt = WSP(f32x2, WS_LT)[((l * NG + g) * 2 + d) * 64 + p];
    const float* Fb = WSP(float, WS_F); bf16* u2 = WSP(bf16, WS_U2);
    float hr = 0.f, hi = 0.f;
    for (int step = 0; step < 36; ++step) {
        int inst; if (step < 4) inst = 256 + b * 4 + (d == 0 ? step : 3 - step); else inst = b * 32 + (d == 0 ? step - 4 : 35 - step);
        const size_t row = (size_t)g * NINST + inst;
        u2[row * KS2 + 1024 + d * 128 + p] = (bf16)f2bf(hr); u2[row * KS2 + 1024 + d * 128 + 64 + p] = (bf16)f2bf(hi);
        const float fr = *(const GAS float*)(Fb + row * 256 + d * 128 + p), fi = *(const GAS float*)(Fb + row * 256 + d * 128 + 64 + p);
        const float nr = lt.x * hr - lt.y * hi + fr; hi = lt.x * hi + lt.y * hr + fi; hr = nr; }
}
template <int NJ>
__device__ __forceinline__ void topk_wave(Frame& F, const float* aff, int k, int srcrow0, int yrow0, int e, LAS unsigned* av) {
#pragma unroll 1
    for (int j = 0; j < NJ; ++j) av[j * 64 + F.lane] = __builtin_bit_cast(unsigned, *(const GAS float*)(aff + j * 64 + F.lane));
    LDS_WAIT();
    unsigned T = 0u;
#pragma unroll 1
    for (int bit = 30; bit >= 0; --bit) { const unsigned cand = T | (1u << bit); int cnt = 0;
#pragma unroll 4
        for (int j = 0; j < NJ; ++j) cnt += __popcll(__ballot(av[j * 64 + F.lane] >= cand));
        if (cnt >= k) T = cand; }
    int ngt = 0, neq = 0;
#pragma unroll 2
    for (int j = 0; j < NJ; ++j) { const unsigned a = av[j * 64 + F.lane]; ngt += (a > T) ? 1 : 0; neq += (a == T) ? 1 : 0; }
    const int packed = (ngt << 16) | neq; int incl = packed;
#pragma unroll
    for (int o = 1; o < 64; o <<= 1) { const int t = __shfl_up(incl, o); incl += (F.lane >= o) ? t : 0; }
    const int excl = incl - packed, pgt = excl >> 16, peq = excl & 0xffff;
    const int need = k - (__builtin_amdgcn_readlane(incl, 63) >> 16);
    int slot = pgt + (peq < need ? peq : need), eqr = peq;
    int* IDX = WSP(int, WS_IDX); float* VALS = WSP(float, WS_VALS); int* SEL = WSP(int, WS_SEL);
#pragma unroll 1
    for (int j = 0; j < NJ; ++j) { const unsigned a = av[j * 64 + F.lane]; const bool gt = a > T, eq = a == T; const bool sl = gt || (eq && eqr < need); eqr += eq ? 1 : 0;
        const int src = srcrow0 + j * 64 + F.lane;
        if (sl) { IDX[yrow0 + slot] = src; VALS[yrow0 + slot] = __builtin_bit_cast(float, a); }
        SEL[(size_t)src * NE + e] = sl ? yrow0 + slot : -1;
        slot += sl ? 1 : 0; }
}
__device__ __forceinline__ void phase_topk(Frame& F, int l) {
    const int ntask = l == 0 ? 256 : 128;
    LAS unsigned* av = (LAS unsigned*)(F.lds + F.wave * 8192);
    for (int task = F.wave * F.G + F.vcu; task < ntask; task += F.G * NWAVES) {
        const bool isctx = task >= 128; const int q = task & 127, b = q >> 4, e = q & 15;
        const int yrow0 = isctx ? NE * NB * CAPL + e * (NB * CAPC) + b * CAPC : (e * NB + b) * CAPL;
        if (isctx) topk_wave<4>(F, WSP(float, WS_AFFC) + (size_t)(b * NE + e) * CTXL, CAPC, ML + b * CTXL, yrow0, e, av);
        else topk_wave<32>(F, WSP(float, WS_AFF) + (size_t)(b * NE + e) * SEQL, CAPL, b * SEQL, yrow0, e, av);
    }
}
template <class T> __device__ __forceinline__ T* opaque_ptr(T* p) { unsigned long long v = (unsigned long long)p; unsigned lo = (unsigned)v, hi = (unsigned)(v >> 32); asm volatile("" : "+v"(lo), "+v"(hi));
    lo = __builtin_amdgcn_readfirstlane(lo); hi = __builtin_amdgcn_readfirstlane(hi); return (T*)(((unsigned long long)hi << 32) | lo); }
__device__ __forceinline__ void launder(Frame& F) { F.ws = opaque_ptr(F.ws); F.out = opaque_ptr(F.out);
    int t = F.tid; asm volatile("" : "+v"(t)); F.tid = t; F.lane = t & 63; F.wave = __builtin_amdgcn_readfirstlane(t >> 6);
    int g = gridDim.x, bx = blockIdx.x; asm volatile("" : "+v"(g), "+v"(bx)); g = __builtin_amdgcn_readfirstlane(g); bx = __builtin_amdgcn_readfirstlane(bx);
    F.G = g; F.vcu = (g % 8 == 0) ? (bx % 8) * (g / 8) + bx / 8 : bx; }
__device__ __forceinline__ void grid_seam(Frame& F) {
    XcdBarrier b; b.bar = (unsigned*)(F.ws + WS_CTL) + CW_BAR; b.x = xb_xcc_id(); b.st = (volatile LAS unsigned*)(F.lds + MISC_OFF) + 8;
    xcd_barrier(b);
}
constexpr int NPHASE = 24;
struct Args { const float* in[27]; float* out; unsigned char* ws; };
#define IN(k) (LO <= (k) && (k) < HI)
#ifndef PROBE_SUB
#define PROBE_SUB 0
#endif
#ifndef PROBE_MASK
#define PROBE_MASK 0u
#endif
#define PHASE(k) if constexpr (IN(k)) for (int rep_ = 0; rep_ < (((PROBE_MASK >> (k)) & 1u) ? 2 : 1); ++rep_)
#define SEAM(k) do { if constexpr (IN(k) && IN((k) + 1)) grid_seam(F); } while (0)
template <int LO, int HI, int l>
__device__ __forceinline__ void layer_phases(Frame& F) {
    constexpr int pb = 1 + 11 * l;
    PHASE(pb + 0) { launder(F);
        if constexpr (l == 0) phase_norm1(F, 0, 0);
        else { if (F.vcu >= 16) phase_norm1(F, 1, 16);
            else { wait_ctx_rows(F);
                SchedCtxU S{(const char*)WSP(bf16, WS_H), (const char*)(WSP(bf16, WS_WIN) + (size_t)DINP * DM), F.vcu};
                EpiProj E{WSP(bf16, WS_R1), WSP(bf16, WS_U2)};
                pg8::gemm_phase<EpiProj, SchedCtxU, false>(F.lds, F.tid, pg8::Dims{DM * 2, DM * 2, DM * 2, nullptr}, S, E); } } }
    SEAM(pb + 0);
    PHASE(pb + 1) {
        launder(F);
        SchedProj S{(const char*)WSP(bf16, WS_H), (const char*)(WSP(bf16, WS_WIN) + (size_t)l * DINP * DM), F.G, F.vcu, l};
        EpiProj E{WSP(bf16, WS_R1), WSP(bf16, WS_U2)};
        pg8::gemm_phase<EpiProj, SchedProj, true>(F.lds, F.tid, pg8::Dims{DM * 2, DM * 2, DM * 2, nullptr}, S, E);
    }
    SEAM(pb + 1);
    PHASE(pb + 2) {
        launder(F);
        if (F.vcu < F.G - 64) phase_conv(F, l, F.G - 64);
        else { SchedF S{(const char*)WSP(bf16, WS_U2), (const char*)(WSP(bf16, WS_WF) + (size_t)l * NG * 256 * 1024), F.G, F.vcu};
            EpiF32 E{WSP(float, WS_F), 256, (size_t)NINST * 256};
            pg8::gemm_phase<EpiF32, SchedF, false>(F.lds, F.tid, pg8::Dims{KS2 * 2, 1024 * 2, 1024 * 2, nullptr}, S, E); }
    }
    SEAM(pb + 2);
    PHASE(pb + 3) { launder(F); phase_carry(F, l); }
    SEAM(pb + 3);
    PHASE(pb + 4) {
        launder(F);
        SchedS2 S{(const char*)WSP(bf16, WS_U2), (const char*)(WSP(bf16, WS_W2) + (size_t)l * NG * 1024 * KS2), F.G, F.vcu, l};
        EpiS2 E{WSP(bf16, WS_U2), F.in[I_SSMD] + (size_t)l * DSSM, WSP(bf16, WS_Z)};
        pg8::gemm_phase<EpiS2, SchedS2, true>(F.lds, F.tid, pg8::Dims{KS2 * 2, KS2 * 2, KS2 * 2, nullptr}, S, E);
    }
    SEAM(pb + 4);
    PHASE(pb + 5) {
        launder(F);
        SchedGlu S{(const char*)WSP(bf16, WS_Z), (const char*)(WSP(bf16, WS_WGLU) + (size_t)l * DSSM * DSSM), F.G, F.vcu, l == 0 ? 72 : 64};
        EpiGlu E{WSP(bf16, WS_Z), F.in[I_ONSG] + (size_t)l * DSSM, WSP(bf16, WS_R2)};
        if (F.G >= 144) pg8::gemm_phase<EpiGlu, SchedGlu, false>(F.lds, F.tid, pg8::Dims{DSSM * 2, DSSM * 2, DSSM * 2, nullptr}, S, E);
    }
    SEAM(pb + 5);
    PHASE(pb + 6) {
        launder(F);
        SchedOut S{(const char*)WSP(bf16, WS_R2), (const char*)(WSP(bf16, WS_WOUT) + (size_t)l * DM * DM), F.G, F.vcu, l == 0 ? 72 : 64};
        EpiOut<l == 1> E{l == 0 ? (const void*)F.in[I_X] : (const void*)WSP(bf16, WS_XL), l == 0 ? (const void*)F.in[I_CTX] : (const void*)(WSP(bf16, WS_XL) + (size_t)ML * DM), WSP(float, WS_MOD) + (size_t)l * 9 * 6 * DM, WSP(bf16, WS_XM)};
        pg8::gemm_phase<EpiOut<l == 1>, SchedOut, true>(F.lds, F.tid, pg8::Dims{DM * 2, DM * 2, DM * 2, nullptr}, S, E);
    }
    SEAM(pb + 6);
    PHASE(pb + 7) { launder(F); phase_norm2(F, l); }
    SEAM(pb + 7);
    PHASE(pb + 8) { launder(F); phase_topk(F, l); }
    SEAM(pb + 8);
    PHASE(pb + 9) {
        launder(F);
        SchedMoe S{(const char*)WSP(unsigned char, WS_H), (const char*)(WSP(unsigned char, WS_WGU) + (size_t)l * NE * 4096 * DM), F.G, F.vcu, 16, l, 1};
        EpiMoe1 E{WSP(unsigned char, WS_R2)};
        pg8::gemm_phase<EpiMoe1, SchedMoe, true, true, true>(F.lds, F.tid, pg8::Dims{DM, DM, DM, WSP(int, WS_IDX)}, S, E);
    }
    SEAM(pb + 9);
    PHASE(pb + 10) {
        launder(F);
        SchedMoe S{(const char*)WSP(unsigned char, WS_R2), (const char*)(WSP(unsigned char, WS_WDN) + (size_t)l * NE * DM * DF), F.G, F.vcu, 8, l, 0};
        EpiY8 E{WSP(unsigned char, WS_R1), FP8_SY / (FP8_SW * FP8_SA)};
        pg8::gemm_phase<EpiY8, SchedMoe, true, true>(F.lds, F.tid, pg8::Dims{DF, DF, DF, nullptr}, S, E);
    }
    SEAM(pb + 10);
}
template <int LO, int HI>
__global__ void __launch_bounds__(NWAVES * 64, 2) trunk_fwd(Args args) {
    extern __shared__ __attribute__((aligned(16))) unsigned char lds[];
    Frame F;
    F.lds = (LAS unsigned char*)lds;
    F.tid = threadIdx.x; F.lane = F.tid & 63; F.wave = __builtin_amdgcn_readfirstlane(F.tid >> 6);
    F.G = gridDim.x; { const int bx = blockIdx.x; F.vcu = (F.G % 8 == 0) ? (bx % 8) * (F.G / 8) + bx / 8 : bx; }
    F.ws = args.ws; F.out = args.out; F.in = args.in;
    for (int u = F.tid; u < (LDS_BYTES - LDSCTL_OFF) / 4; u += NWAVES * 64) ((LAS unsigned*)(F.lds + LDSCTL_OFF))[u] = 0u;
    __syncthreads();
    if constexpr (HI - LO > 1) (void)xcd_barrier_post((unsigned*)(F.ws + WS_CTL) + CW_BAR, (volatile LAS unsigned*)(F.lds + MISC_OFF) + 8);

    PHASE(0) {
        launder(F);
        for (int q_ = 0; q_ < ((PROBE_SUB & 1) ? 2 : 1); ++q_) if (F.vcu < 192) { for (int t = F.vcu; t < 192; t += 192) p0_mod_task(F, t); }
        for (int q_ = 0; q_ < ((PROBE_SUB & 2) ? 2 : 1); ++q_) if (F.vcu >= 192) { for (int t = F.vcu - 192; t < 64; t += F.G - 192) p0_s5_task(F, t); }
        p0_router_t(F);
        for (int q_ = 0; q_ < ((PROBE_SUB & 4) ? 2 : 1); ++q_) p0_convert_weights(F, 2 * rep_ + q_);
    }
    SEAM(0);
    layer_phases<LO, HI, 0>(F);
    layer_phases<LO, HI, 1>(F);
    PHASE(23) { launder(F); phase_final(F); }
}
#undef IN
#undef PHASE
#undef SEAM

template <int P> static void launch_phase(int grid, hipStream_t stream, const Args& a) {
    hipLaunchKernelGGL((trunk_fwd<P, P + 1>), dim3(grid), dim3(NWAVES * 64), LDS_BYTES, stream, a);
}
template <int P> static void set_attr_phase() { (void)hipFuncSetAttribute((const void*)trunk_fwd<P, P + 1>, hipFuncAttributeMaxDynamicSharedMemorySize, LDS_BYTES); }
template <int... Ps> static void launch_all(std::integer_sequence<int, Ps...>, int grid, hipStream_t stream, const Args& a) { (launch_phase<Ps>(grid, stream, a), ...); }
template <int... Ps> static void set_attr_all(std::integer_sequence<int, Ps...>) { (set_attr_phase<Ps>(), ...); }
extern "C" void kernel_launch(void* const* d_in, const int* in_sizes, int n_in, void* d_out, int out_size, void* d_ws, size_t ws_size, hipStream_t stream) {
    static int grid = 0;
    if (grid == 0) {
        if (n_in != 27 || out_size != ML * DM || ws_size < WS_END) { fprintf(stderr, "kernel_launch: expected 27 inputs, %d outputs, >= %zu workspace bytes; got %d, %d, %zu\n", ML * DM, (size_t)WS_END, n_in, out_size, ws_size); grid = -1; return; }
        int dev = 0, cus = 0, per_cu = 0;
        if (hipGetDevice(&dev) != hipSuccess || hipDeviceGetAttribute(&cus, hipDeviceAttributeMultiprocessorCount, dev) != hipSuccess) { grid = -1; return; }
#if MK_N_LAUNCHES == 1
        if (hipFuncSetAttribute((const void*)trunk_fwd<0, NPHASE>, hipFuncAttributeMaxDynamicSharedMemorySize, LDS_BYTES) != hipSuccess) { fprintf(stderr, "kernel_launch: hipFuncSetAttribute failed\n"); grid = -1; return; }
        if (hipOccupancyMaxActiveBlocksPerMultiprocessor(&per_cu, (const void*)trunk_fwd<0, NPHASE>, NWAVES * 64, LDS_BYTES) != hipSuccess || per_cu < 1) fprintf(stderr, "kernel_launch: occupancy query reports %d\n", per_cu);
#else
        set_attr_all(std::make_integer_sequence<int, NPHASE>{});
#endif
        (void)hipGetLastError();
        grid = cus;
        if (grid < 256 || grid % 8 != 0) { fprintf(stderr, "kernel_launch: unexpected CU count %d\n", cus); }
    }
    if (grid < 0) return;
    (void)hipMemsetAsync((char*)d_ws + WS_CTL, 0, CTL_ZERO_BYTES, stream);
    Args a{};
    for (int i = 0; i < 27; ++i) a.in[i] = (const float*)d_in[i];
    a.out = (float*)d_out; a.ws = (unsigned char*)d_ws;
#if MK_N_LAUNCHES == 1
    hipLaunchKernelGGL((trunk_fwd<0, NPHASE>), dim3(grid), dim3(NWAVES * 64), LDS_BYTES, stream, a);
#else
    launch_all(std::make_integer_sequence<int, NPHASE>{}, grid, stream, a);
#endif
    const hipError_t le = hipPeekAtLastError();
    if (le != hipSuccess) fprintf(stderr, "kernel_launch: launch failed: %s\n", hipGetErrorName(le));
}
```
